# Optimizing an MI355X kernel written in HIP

```python
import math
import jax, jax.numpy as jnp
from jax import lax
import numpy as np

D_MODEL = 1024
BATCH = 1
SEQ = 16384
DEPTH = 4

HEAD_DIM = 64
BLOCK_Q = 128
NEG_INF = -1e30
RMS_EPS = 1e-6
MLA_HEADS = 8
MLA_NOPE_DIM = 64
MLA_ROPE_DIM = 32
MLA_V_DIM = 64
MLA_Q_RANK = 256
MLA_KV_RANK = 128
ROPE_THETA = 10000.0
FOX_HEADS = 8
DIL_GROUPS = ((128, 1), (512, 4), (2048, 16))
DIL_HEADS = 4
DIL_WIDTH = 3 * DIL_HEADS * HEAD_DIM
NSA_HEADS = 4
NSA_CMP_LEN = 32
NSA_CMP_STRIDE = 16
NSA_CMP_HIDDEN = 256
NSA_SEL_BLOCK = 64
NSA_TOPK = 16
NSA_WINDOW = 512
NSA_FORCE_SCORE = 1e9
T5_BUCKETS = 32
T5_MAX_DIST = 2048
T5_HEADS = 3 * DIL_HEADS + NSA_HEADS
D_FF = 4 * D_MODEL
PLE_DIM = 256

EVEN_IN_SIZES = (MLA_Q_RANK, MLA_KV_RANK, MLA_ROPE_DIM,
                 FOX_HEADS * HEAD_DIM, FOX_HEADS * HEAD_DIM, FOX_HEADS * HEAD_DIM, FOX_HEADS)
EVEN_IN_WIDTH = MLA_Q_RANK + MLA_KV_RANK + MLA_ROPE_DIM + 3 * FOX_HEADS * HEAD_DIM + FOX_HEADS
EVEN_OUT_WIDTH = MLA_HEADS * MLA_V_DIM + FOX_HEADS * HEAD_DIM
ODD_IN_SIZES = (DIL_WIDTH, DIL_WIDTH, DIL_WIDTH, NSA_HEADS * HEAD_DIM,
                HEAD_DIM, HEAD_DIM, HEAD_DIM, HEAD_DIM, HEAD_DIM, HEAD_DIM, NSA_HEADS * 3)
ODD_IN_WIDTH = 3 * DIL_WIDTH + NSA_HEADS * HEAD_DIM + 6 * HEAD_DIM + NSA_HEADS * 3
ODD_OUT_WIDTH = DIL_HEADS * HEAD_DIM + NSA_HEADS * HEAD_DIM
N_EVEN = (DEPTH + 1) // 2
N_ODD = DEPTH // 2

kernel_name = "hybrid_mla_fox_dilated_nsa_trunk"


def rms_norm(x, g):
    x32 = x.astype(jnp.float32)
    y = x32 * lax.rsqrt(jnp.mean(x32 * x32, axis=-1, keepdims=True) + RMS_EPS)
    return (y * g.astype(jnp.float32)).astype(x.dtype)


def split_cols(y, sizes):
    idx, acc = [], 0
    for s in sizes[:-1]:
        acc += s
        idx.append(acc)
    return jnp.split(y, idx, axis=-1)


def t5_bucket(dist):
    n = jnp.maximum(dist, 0)
    max_exact = T5_BUCKETS // 2
    ratio = jnp.log(jnp.maximum(n, 1).astype(jnp.float32) / max_exact) / math.log(T5_MAX_DIST / max_exact)
    large = jnp.minimum(max_exact + (ratio * (T5_BUCKETS - max_exact)).astype(jnp.int32), T5_BUCKETS - 1)
    return jnp.where(n < max_exact, n, large)


def apply_rope(x, cos, sin):
    x1, x2 = jnp.split(x, 2, axis=-1)
    return jnp.concatenate([x1 * cos - x2 * sin, x2 * cos + x1 * sin], axis=-1).astype(x.dtype)


def dense_causal_attention(q, k, v, scale, cum_log_forget=None):
    B, S, H, _ = q.shape
    Dv = v.shape[-1]
    s_pos = jnp.arange(S)
    cum_k = None if cum_log_forget is None else jnp.transpose(cum_log_forget, (0, 2, 1))

    def one_block(i):
        q0 = i * BLOCK_Q
        t = q0 + jnp.arange(BLOCK_Q)
        qb = lax.dynamic_slice_in_dim(q, q0, BLOCK_Q, axis=1)
        logits = jnp.einsum('bqhd,bkhd->bhqk', qb, k, preferred_element_type=jnp.float32) * scale
        if cum_k is not None:
            cq = lax.dynamic_slice_in_dim(cum_k, q0, BLOCK_Q, axis=2)
            logits = logits + cq[..., None] - cum_k[:, :, None, :]
        logits = jnp.where(s_pos[None, :] <= t[:, None], logits, NEG_INF)
        p = jax.nn.softmax(logits, axis=-1)
        return jnp.einsum('bhqk,bkhd->bqhd', p.astype(v.dtype), v)

    out = lax.map(one_block, jnp.arange(S // BLOCK_Q))
    return jnp.moveaxis(out, 0, 1).reshape(B, S, H, Dv)


def dilated_attention(q, k, v, bias_table):
    B, S, G, H, Dh = q.shape
    scale = Dh ** -0.5
    k_groups = [k[:, :, g] for g in range(G)]
    v_groups = [v[:, :, g] for g in range(G)]
    offsets, group_bias = [], []
    for g, (w, d) in enumerate(DIL_GROUPS):
        offs = d * jnp.arange(w // d + 1)
        offsets.append(offs)
        group_bias.append(bias_table[t5_bucket(offs), g * H:(g + 1) * H].T)

    def one_block(i):
        q0 = i * BLOCK_Q
        t = q0 + jnp.arange(BLOCK_Q)
        qb = lax.dynamic_slice_in_dim(q, q0, BLOCK_Q, axis=1)
        outs, lses = [], []
        for g in range(G):
            idx = t[:, None] - offsets[g][None, :]
            valid = idx >= 0
            idx = jnp.maximum(idx, 0)
            kg = k_groups[g][:, idx]
            vg = v_groups[g][:, idx]
            logits = jnp.einsum('bqhd,bqkhd->bhqk', qb[:, :, g], kg, preferred_element_type=jnp.float32) * scale
            logits = logits + group_bias[g][None, :, None, :].astype(jnp.float32)
            logits = jnp.where(valid[None, None], logits, NEG_INF)
            lse = jax.nn.logsumexp(logits, axis=-1)
            p = jnp.exp(logits - lse[..., None])
            outs.append(jnp.einsum('bhqk,bqkhd->bqhd', p.astype(v.dtype), vg))
            lses.append(lse)
        wts = jax.nn.softmax(jnp.stack(lses, axis=0), axis=0)
        return jnp.einsum('gbhq,gbqhd->bqhd', wts.astype(v.dtype), jnp.stack(outs, axis=0))

    out = lax.map(one_block, jnp.arange(S // BLOCK_Q))
    return jnp.moveaxis(out, 0, 1).reshape(B, S, H, Dh)


def nsa_attention(q, k_cmp_src, v_cmp_src, k_sel, v_sel, k_win, v_win, gates, bias_table,
                  cmp_pos_k, cmp_pos_v, w1_k, w2_k, w1_v, w2_v):
    B, S, H, Dh = q.shape
    scale = Dh ** -0.5
    n_cmp = (S - NSA_CMP_LEN) // NSA_CMP_STRIDE + 1
    n_sel = S // NSA_SEL_BLOCK
    topk = min(NSA_TOPK, n_sel)
    cmp_start = jnp.arange(n_cmp) * NSA_CMP_STRIDE
    blk_idx = cmp_start[:, None] + jnp.arange(NSA_CMP_LEN)[None, :]

    def compress(src, pos, w1, w2):
        blocks = src[:, blk_idx] + pos
        return jax.nn.gelu(blocks.reshape(B, n_cmp, NSA_CMP_LEN * Dh) @ w1) @ w2

    kc = compress(k_cmp_src, cmp_pos_k, w1_k, w2_k)
    vc = compress(v_cmp_src, cmp_pos_v, w1_v, w2_v)
    cmp_end = cmp_start + NSA_CMP_LEN - 1
    sel_start = jnp.arange(n_sel) * NSA_SEL_BLOCK
    overlap = ((cmp_start[:, None] < sel_start[None, :] + NSA_SEL_BLOCK) &
               (cmp_start[:, None] + NSA_CMP_LEN > sel_start[None, :])).astype(jnp.float32)
    k_win_pad = jnp.pad(k_win, ((0, 0), (NSA_WINDOW, 0), (0, 0)))
    v_win_pad = jnp.pad(v_win, ((0, 0), (NSA_WINDOW, 0), (0, 0)))
    win_len = BLOCK_Q + NSA_WINDOW
    gather_rows = jax.vmap(lambda a, i: a[i])

    def one_block(i):
        q0 = i * BLOCK_Q
        t = q0 + jnp.arange(BLOCK_Q)
        qb = lax.dynamic_slice_in_dim(q, q0, BLOCK_Q, axis=1)
        gb = lax.dynamic_slice_in_dim(gates, q0, BLOCK_Q, axis=1)
        c_mask = cmp_end[None, :] <= t[:, None]
        logits = jnp.einsum('bqhd,bnd->bhqn', qb, kc, preferred_element_type=jnp.float32) * scale
        p_cmp = jax.nn.softmax(jnp.where(c_mask, logits, NEG_INF), axis=-1) * c_mask
        o_cmp = jnp.einsum('bhqn,bnd->bqhd', p_cmp.astype(vc.dtype), vc)
        importance = jnp.einsum('bhqn,nj->bqj', p_cmp, overlap)
        tb = t // NSA_SEL_BLOCK
        j = jnp.arange(n_sel)
        forced = (j[None, :] == 0) | (j[None, :] == tb[:, None]) | (j[None, :] == tb[:, None] - 1)
        causal_blk = sel_start[None, :] <= t[:, None]
        score = jnp.where(forced, NSA_FORCE_SCORE, jnp.where(causal_blk, importance, -NSA_FORCE_SCORE))
        _, sel = lax.top_k(score, topk)
        tok = (sel[..., None] * NSA_SEL_BLOCK + jnp.arange(NSA_SEL_BLOCK)).reshape(B, BLOCK_Q, topk * NSA_SEL_BLOCK)
        ks = gather_rows(k_sel, tok)
        vs = gather_rows(v_sel, tok)
        dist = t[None, :, None] - tok
        logits = jnp.einsum('bqhd,bqkd->bhqk', qb, ks, preferred_element_type=jnp.float32) * scale
        logits = logits + jnp.moveaxis(bias_table[t5_bucket(dist)], -1, 1).astype(jnp.float32)
        logits = jnp.where((dist >= 0)[:, None], logits, NEG_INF)
        o_sel = jnp.einsum('bhqk,bqkd->bqhd', jax.nn.softmax(logits, axis=-1).astype(vs.dtype), vs)
        kw = lax.dynamic_slice_in_dim(k_win_pad, q0, win_len, axis=1)
        vw = lax.dynamic_slice_in_dim(v_win_pad, q0, win_len, axis=1)
        s = q0 - NSA_WINDOW + jnp.arange(win_len)
        dist_w = t[:, None] - s[None, :]
        w_mask = (dist_w >= 0) & (dist_w < NSA_WINDOW) & (s[None, :] >= 0)
        logits = jnp.einsum('bqhd,bkd->bhqk', qb, kw, preferred_element_type=jnp.float32) * scale
        logits = logits + jnp.transpose(bias_table[t5_bucket(dist_w)], (2, 0, 1))[None].astype(jnp.float32)
        logits = jnp.where(w_mask[None, None], logits, NEG_INF)
        o_win = jnp.einsum('bhqk,bkd->bqhd', jax.nn.softmax(logits, axis=-1).astype(vw.dtype), vw)
        return gb[..., 0:1] * o_cmp + gb[..., 1:2] * o_sel + gb[..., 2:3] * o_win

    out = lax.map(one_block, jnp.arange(S // BLOCK_Q))
    return jnp.moveaxis(out, 0, 1).reshape(B, S, H, Dh)


def even_mixer(hn, cos, sin, w_in, q_norm, w_uq, kv_norm, w_ukv, forget_bias, w_out):
    B, S, _ = hn.shape
    c_q, c_kv, k_r, fq, fk, fv, f_logit = split_cols(hn @ w_in, EVEN_IN_SIZES)
    q = (rms_norm(c_q, q_norm) @ w_uq).reshape(B, S, MLA_HEADS, MLA_NOPE_DIM + MLA_ROPE_DIM)
    q_nope, q_rope = jnp.split(q, [MLA_NOPE_DIM], axis=-1)
    q_rope = apply_rope(q_rope, cos[:, :, None], sin[:, :, None])
    kv = (rms_norm(c_kv, kv_norm) @ w_ukv).reshape(B, S, MLA_HEADS, MLA_NOPE_DIM + MLA_V_DIM)
    k_nope, v_mla = jnp.split(kv, [MLA_NOPE_DIM], axis=-1)
    k_r = apply_rope(k_r, cos, sin)
    q_mla = jnp.concatenate([q_nope, q_rope], axis=-1)
    k_mla = jnp.concatenate([k_nope, jnp.broadcast_to(k_r[:, :, None], (B, S, MLA_HEADS, MLA_ROPE_DIM))], axis=-1)
    o_mla = dense_causal_attention(q_mla, k_mla, v_mla, (MLA_NOPE_DIM + MLA_ROPE_DIM) ** -0.5)
    log_f = jax.nn.log_sigmoid((f_logit + forget_bias).astype(jnp.float32))
    cum = jnp.cumsum(log_f, axis=1)
    shp = (B, S, FOX_HEADS, HEAD_DIM)
    o_fox = dense_causal_attention(fq.reshape(shp), fk.reshape(shp), fv.reshape(shp), HEAD_DIM ** -0.5, cum)
    o = jnp.concatenate([o_mla.reshape(B, S, -1), o_fox.reshape(B, S, -1)], axis=-1)
    return o @ w_out


def odd_mixer(hn, t5_bias, w_in, cmp_pos_k, cmp_pos_v, cmp_w1_k, cmp_w2_k, cmp_w1_v, cmp_w2_v, w_out):
    B, S, _ = hn.shape
    (dq, dk, dv, nq, k_cmp_src, v_cmp_src, k_sel, v_sel, k_win, v_win,
     gate_logit) = split_cols(hn @ w_in, ODD_IN_SIZES)
    G = len(DIL_GROUPS)
    shp = (B, S, G, DIL_HEADS, HEAD_DIM)
    o_dil = dilated_attention(dq.reshape(shp), dk.reshape(shp), dv.reshape(shp), t5_bias[:, :G * DIL_HEADS])
    gates = jax.nn.sigmoid(gate_logit.reshape(B, S, NSA_HEADS, 3))
    o_nsa = nsa_attention(nq.reshape(B, S, NSA_HEADS, HEAD_DIM), k_cmp_src, v_cmp_src, k_sel, v_sel,
                          k_win, v_win, gates, t5_bias[:, G * DIL_HEADS:],
                          cmp_pos_k, cmp_pos_v, cmp_w1_k, cmp_w2_k, cmp_w1_v, cmp_w2_v)
    o = jnp.concatenate([o_dil.reshape(B, S, -1), o_nsa.reshape(B, S, -1)], axis=-1)
    return o @ w_out


def setup_inputs(seed: int = 0) -> dict:
    key = jax.random.key(seed)
    ks = iter(jax.random.split(key, 40))

    def dense(shape, fan_in):
        return jax.random.normal(next(ks), shape, jnp.float32) * fan_in ** -0.5

    def gain(shape):
        return 1.0 + 0.05 * jax.random.normal(next(ks), shape, jnp.float32)

    x = jax.random.normal(next(ks), (BATCH, SEQ, D_MODEL), jnp.float32)
    p = jax.random.normal(next(ks), (DEPTH, BATCH, SEQ, PLE_DIM), jnp.float32)
    offset = jax.random.randint(next(ks), (BATCH, 1), 0, 1024, jnp.int32)
    positions = offset + jnp.arange(SEQ, dtype=jnp.int32)[None, :]
    return {
        "x": x,
        "p": p,
        "positions": positions,
        "t5_bias": 0.5 * jax.random.normal(next(ks), (T5_BUCKETS, T5_HEADS), jnp.float32),
        "ev_w_in": dense((N_EVEN, D_MODEL, EVEN_IN_WIDTH), D_MODEL),
        "ev_q_norm": gain((N_EVEN, MLA_Q_RANK)),
        "ev_w_uq": dense((N_EVEN, MLA_Q_RANK, MLA_HEADS * (MLA_NOPE_DIM + MLA_ROPE_DIM)), MLA_Q_RANK),
        "ev_kv_norm": gain((N_EVEN, MLA_KV_RANK)),
        "ev_w_ukv": dense((N_EVEN, MLA_KV_RANK, MLA_HEADS * (MLA_NOPE_DIM + MLA_V_DIM)), MLA_KV_RANK),
        "ev_forget_bias": jax.random.uniform(next(ks), (N_EVEN, FOX_HEADS), jnp.float32, 2.0, 5.0),
        "ev_w_out": dense((N_EVEN, EVEN_OUT_WIDTH, D_MODEL), EVEN_OUT_WIDTH),
        "od_w_in": dense((N_ODD, D_MODEL, ODD_IN_WIDTH), D_MODEL),
        "od_cmp_pos_k": 0.1 * jax.random.normal(next(ks), (N_ODD, NSA_CMP_LEN, HEAD_DIM), jnp.float32),
        "od_cmp_pos_v": 0.1 * jax.random.normal(next(ks), (N_ODD, NSA_CMP_LEN, HEAD_DIM), jnp.float32),
        "od_cmp_w1_k": dense((N_ODD, NSA_CMP_LEN * HEAD_DIM, NSA_CMP_HIDDEN), NSA_CMP_LEN * HEAD_DIM),
        "od_cmp_w2_k": dense((N_ODD, NSA_CMP_HIDDEN, HEAD_DIM), NSA_CMP_HIDDEN),
        "od_cmp_w1_v": dense((N_ODD, NSA_CMP_LEN * HEAD_DIM, NSA_CMP_HIDDEN), NSA_CMP_LEN * HEAD_DIM),
        "od_cmp_w2_v": dense((N_ODD, NSA_CMP_HIDDEN, HEAD_DIM), NSA_CMP_HIDDEN),
        "od_w_out": dense((N_ODD, ODD_OUT_WIDTH, D_MODEL), ODD_OUT_WIDTH),
        "norm_mix_pre": gain((DEPTH, D_MODEL)),
        "norm_mix_post": gain((DEPTH, D_MODEL)),
        "norm_mlp_pre": gain((DEPTH, D_MODEL)),
        "norm_mlp_post": gain((DEPTH, D_MODEL)),
        "w_mlp_up": dense((DEPTH, D_MODEL, D_FF), D_MODEL),
        "w_mlp_down": dense((DEPTH, D_FF, D_MODEL), D_FF),
        "ple_norm": gain((DEPTH, D_MODEL)),
        "w_ple_gate": dense((DEPTH, D_MODEL, D_MODEL), D_MODEL),
        "w_ple_proj": dense((DEPTH, PLE_DIM, D_MODEL), PLE_DIM),
    }


def reference(x, p, positions, t5_bias, ev_w_in, ev_q_norm, ev_w_uq, ev_kv_norm, ev_w_ukv, ev_forget_bias,
              ev_w_out, od_w_in, od_cmp_pos_k, od_cmp_pos_v, od_cmp_w1_k, od_cmp_w2_k, od_cmp_w1_v, od_cmp_w2_v,
              od_w_out, norm_mix_pre, norm_mix_post, norm_mlp_pre, norm_mlp_post, w_mlp_up, w_mlp_down,
              ple_norm, w_ple_gate, w_ple_proj):
    inv_freq = ROPE_THETA ** (-jnp.arange(0, MLA_ROPE_DIM, 2, dtype=jnp.float32) / MLA_ROPE_DIM)
    angles = positions.astype(jnp.float32)[..., None] * inv_freq
    cos, sin = jnp.cos(angles), jnp.sin(angles)
    h = x
    for i in range(DEPTH):
        j = i // 2
        hn = rms_norm(h, norm_mix_pre[i])
        if i % 2 == 0:
            mix = even_mixer(hn, cos, sin, ev_w_in[j], ev_q_norm[j], ev_w_uq[j], ev_kv_norm[j], ev_w_ukv[j],
                             ev_forget_bias[j], ev_w_out[j])
        else:
            mix = odd_mixer(hn, t5_bias, od_w_in[j], od_cmp_pos_k[j], od_cmp_pos_v[j], od_cmp_w1_k[j],
                            od_cmp_w2_k[j], od_cmp_w1_v[j], od_cmp_w2_v[j], od_w_out[j])
        h = h + rms_norm(mix, norm_mix_post[i])
        hn = rms_norm(h, norm_mlp_pre[i])
        m = jnp.square(jax.nn.relu(hn @ w_mlp_up[i])) @ w_mlp_down[i]
        h = h + rms_norm(m, norm_mlp_post[i])
        gate = jax.nn.sigmoid(rms_norm(h, ple_norm[i]) @ w_ple_gate[i])
        h = h + gate * (p[i] @ w_ple_proj[i])
    return h
```

```cpp
#include <hip/hip_runtime.h>
#include <cstdio>
#include <cstdint>

#define GAS __attribute__((address_space(1)))
#define LAS __attribute__((address_space(3)))
typedef unsigned short u16;
typedef unsigned v4u __attribute__((ext_vector_type(4)));
typedef unsigned v2u __attribute__((ext_vector_type(2)));
typedef float v4f __attribute__((ext_vector_type(4)));
typedef float v2f __attribute__((ext_vector_type(2)));

constexpr int S = 16384, DM = 1024, DFF = 4096, PLE = 256, DEPTH = 4;
constexpr int NWAVES = 8, NTHREADS = 512;
constexpr int EV_IN = 1960, OD_IN = 2956;
constexpr float RMS_EPS = 1e-6f, LOG2E = 1.4426950408889634f;
constexpr float QS64 = 0.125f * LOG2E;
constexpr float QS96 = 0.10206207261596575f * LOG2E;

constexpr size_t MiB = 1u << 20;
constexpr size_t WS_CTL = 0, CTL_ZERO_BYTES = 1 * MiB;
constexpr size_t WS_CS = 1 * MiB;
constexpr size_t WS_LUT = 3 * MiB;
constexpr size_t LUT_N = 0;
constexpr size_t LUT_D = 32768;
constexpr size_t OFF_RSA = 65536, OFF_RSB = 131072;
constexpr size_t OFF_LOGF = 262144;
constexpr size_t OFF_CT = 786432;
constexpr size_t WS_W = 4 * MiB;
constexpr size_t W_IN = 0, W_OUT = 6 * MiB, W_UP = 8 * MiB, W_DN = 16 * MiB, W_PG = 24 * MiB, W_PP = 26 * MiB, W_UQ = 26 * MiB + 512 * 1024, W_UKV = 27 * MiB;
constexpr size_t WS_PB = 32 * MiB;
constexpr size_t WS_HB = 40 * MiB;
constexpr size_t WS_MIX = 72 * MiB;
constexpr size_t WS_A = 136 * MiB;
constexpr size_t A_FQ = 0, A_FK = 16 * MiB, A_FV = 32 * MiB, A_CQN = 48 * MiB, A_CKVN = 56 * MiB, A_QM = 60 * MiB, A_KM = 84 * MiB, A_VM = 108 * MiB, A_OA = 124 * MiB, A_CUM = 156 * MiB;
constexpr size_t A_DQ = 0, A_DK = 24 * MiB, A_DV = 48 * MiB, A_NQ = 72 * MiB, A_SM1 = 80 * MiB, A_SM2 = 88 * MiB, A_GATE = 96 * MiB, A_KC = 97 * MiB, A_VC = 97 * MiB + 256 * 1024;
constexpr size_t WS_HB2 = 293 * MiB;
constexpr size_t WS_RSP = 325 * MiB;
constexpr size_t WS_END = 326 * MiB;
constexpr int CW_BAR = 4096;

constexpr int RING_BYTES = 131072;
constexpr int MISC_OFF = RING_BYTES + 320;
constexpr int LDS_BYTES = 147456;

__device__ __forceinline__ unsigned f2bf(float f) { unsigned u = __builtin_bit_cast(unsigned, f); return (u + 0x7fffu + ((u >> 16) & 1u)) >> 16; }
__device__ __forceinline__ unsigned pk2(float lo, float hi) { return f2bf(lo) | (f2bf(hi) << 16); }
__device__ __forceinline__ float bf2f(u16 h) { return __builtin_bit_cast(float, (unsigned)h << 16); }
__device__ __forceinline__ float bflo(unsigned u) { return __builtin_bit_cast(float, u << 16); }
__device__ __forceinline__ float bfhi(unsigned u) { return __builtin_bit_cast(float, u & 0xffff0000u); }
__device__ __forceinline__ float wave_sum(float v) {
#pragma unroll
    for (int o = 1; o < 64; o <<= 1) v += __shfl_xor(v, o);
    return v;
}
__device__ __forceinline__ float wave_max(float v) {
#pragma unroll
    for (int o = 1; o < 64; o <<= 1) v = fmaxf(v, __shfl_xor(v, o));
    return v;
}
__device__ __forceinline__ float rdlane_f(float v, int l) { return __builtin_bit_cast(float, __builtin_amdgcn_readlane(__builtin_bit_cast(int, v), l)); }
#define LDS_WAIT() asm volatile("s_waitcnt lgkmcnt(0)" ::: "memory")

#define XB_TMO      128
#define XB_XCNT(j)  (256  + 64 * (j))
#define XB_XSUB(j)  (1280 + 64 * (j))
#define XB_XGEN(j)  (2304 + 64 * (j))
#define XB_TOP      3328
#define XB_TOPGEN   3392
#define XCD_BAR_WORDS 3456
#define XB_SPIN_CAP (1u << 18)

__device__ __forceinline__ unsigned xb_ld(unsigned* p)              { return __hip_atomic_load(p, __ATOMIC_RELAXED, __HIP_MEMORY_SCOPE_AGENT); }
__device__ __forceinline__ unsigned xb_add(unsigned* p, unsigned v) { return __hip_atomic_fetch_add(p, v, __ATOMIC_RELAXED, __HIP_MEMORY_SCOPE_AGENT); }
__device__ __forceinline__ unsigned xb_xcc_id() { return (unsigned)__builtin_amdgcn_s_getreg((3 << 11) | 20) & 0xFu; }
#define XB_SPIN(cond, bar) do { unsigned _sp = 0; while (cond) { __builtin_amdgcn_s_sleep(1); \
    if ((++_sp & 255u) == 0u) { if (xb_ld(&(bar)[XB_TMO])) break; if (_sp > XB_SPIN_CAP) { atomicAdd(&(bar)[XB_TMO], 1u); break; } } } } while (0)

struct XcdBarrier {
    unsigned* bar; unsigned x;
    volatile LAS unsigned* st;
};

__device__ __forceinline__ XcdBarrier xcd_barrier_post(unsigned* bar, volatile LAS unsigned* st) {
    XcdBarrier b; b.bar = bar; b.x = xb_xcc_id(); b.st = st;
    if (threadIdx.x == 0) (void)xb_add(&bar[XB_XCNT(b.x)], 1u);
    return b;
}
__device__ __forceinline__ void xcd_barrier_complete(unsigned* bar, unsigned x, unsigned& nloc, unsigned& nx) {
    const unsigned G = gridDim.x * gridDim.y * gridDim.z;
    unsigned sum, cnt, mine, sp = 0u;
    for (;;) {
        sum = 0u; cnt = 0u; mine = 0u;
#pragma unroll
        for (unsigned j = 0; j < 16; ++j) { const unsigned c = xb_ld(&bar[XB_XCNT(j)]); sum += c; cnt += (c > 0u) ? 1u : 0u; mine = (j == x) ? c : mine; }
        if (sum == G) break;
        __builtin_amdgcn_s_sleep(1);
        if ((++sp & 255u) == 0u) { if (xb_ld(&bar[XB_TMO])) break; if (sp > XB_SPIN_CAP) { atomicAdd(&bar[XB_TMO], 1u); break; } }
    }
    nloc = mine > 0u ? mine : 1u; nx = cnt > 0u ? cnt : 1u;
}

__device__ __forceinline__ void xcd_barrier(const XcdBarrier& b) {
    asm volatile("s_waitcnt vmcnt(0)" ::: "memory");
    __syncthreads();
    if (threadIdx.x == 0) {
        unsigned* bar = b.bar;
        __builtin_amdgcn_s_waitcnt(0);
        unsigned nloc = b.st[0], nx = b.st[1];
        if (nloc == 0u) { xcd_barrier_complete(bar, b.x, nloc, nx); b.st[0] = nloc; b.st[1] = nx; }
        const unsigned old = xb_add(&bar[XB_XSUB(b.x)], 1u);
        const unsigned gen = old / nloc;
        if (old + 1u == (gen + 1u) * nloc) {
            __builtin_amdgcn_fence(__ATOMIC_RELEASE, "agent");
            asm volatile("s_waitcnt vmcnt(0)" ::: "memory");
            const unsigned og = xb_add(&bar[XB_TOP], 1u);
            const unsigned tg = og / nx;
            if (og + 1u == (tg + 1u) * nx) xb_add(&bar[XB_TOPGEN], 1u);
            else XB_SPIN(xb_ld(&bar[XB_TOPGEN]) == tg, bar);
            __builtin_amdgcn_fence(__ATOMIC_ACQUIRE, "agent");
            xb_add(&bar[XB_XGEN(b.x)], 1u);
            asm volatile("s_waitcnt vmcnt(0)" ::: "memory");
        } else {
            XB_SPIN(xb_ld(&bar[XB_XGEN(b.x)]) == gen, bar);
            __builtin_amdgcn_fence(__ATOMIC_ACQUIRE, "agent");
            asm volatile("s_waitcnt vmcnt(0)" ::: "memory");
        }
    }
    __syncthreads();
}

namespace pg8 {
#define PG8_LAS __attribute__((address_space(3)))
typedef unsigned short bf16_t;
typedef short bf16x8 __attribute__((ext_vector_type(8)));
typedef float f32x4 __attribute__((ext_vector_type(4)));
typedef unsigned u32x4 __attribute__((ext_vector_type(4)));
constexpr int BM = 256, BK = 64, HALF = 128, HTB = HALF * BK * 2  , STAGE_BYTES = 8 * HTB, NXCD = 8, WGM = 8;

__host__ __device__ __forceinline__ int lds_byte(int r, int c) { const int st = (r >> 4) * 2 + (c >> 5), rr = r & 15, cc = c & 31, ob = rr * 64 + cc * 2; return st * 1024 + (ob ^ (((ob >> 9) & 1) << 5)); }
__host__ __device__ __forceinline__ void stage_rc(int b, int& R, int& C) { const int st = b / 1024, sb = b % 1024, swz = sb ^ (((sb >> 9) & 1) << 5); R = (st >> 1) * 16 + swz / 64; C = (st & 1) * 32 + (swz % 64) / 2; }
__host__ __device__ __forceinline__ int perm32(int rho) { const int n = rho >> 4, i = rho & 15; return 8 * (i >> 2) + 4 * n + (i & 3); }

struct Unit { int pm, pn; };
struct Gemm { const bf16_t* A; const bf16_t* Bt; int M, N, K; };

struct StaticOrder {
    int nM, nN, nwg, G, c;
    __host__ __device__ void init(int M, int N, int G_, int c_) { nM = M / BM; nN = N / BM; nwg = nM * nN; G = G_; c = c_; }
    __host__ __device__ bool next(int i, Unit& u) const {
        const long L = (long)i * G + c; if (L >= nwg) return false;
        int wgid = (int)L; { const int q = nwg / NXCD, r = nwg % NXCD, xcd = wgid % NXCD, off = wgid / NXCD; wgid = (xcd < r ? xcd * (q + 1) : r * (q + 1) + (xcd - r) * q) + off; }
        const int nig = WGM * nN, gid = wgid / nig, fm = gid * WGM, gsz = (nM - fm) < WGM ? (nM - fm) : WGM;
        u.pm = fm + ((wgid % nig) % gsz); u.pn = (wgid % nig) / gsz; return true;
    }
    __device__ __forceinline__ void a_ready(const Unit&) const {}
    __device__ __forceinline__ void done(const Unit&) const {}
};

__device__ __forceinline__ unsigned cvt_pk_bf16(float lo, float hi) { unsigned r; asm volatile("v_cvt_pk_bf16_f32 %0, %1, %2" : "=v"(r) : "v"(lo), "v"(hi)); return r; }
typedef float f32x2 __attribute__((ext_vector_type(2)));
template <class Epi, class Sched, bool ALIGN_EPI = false, bool SP2 = false>
__device__ __forceinline__ void gemm_phase(PG8_LAS unsigned char* lds, const Gemm g, const Sched& S, const Epi& E) {
    int tid_ = threadIdx.x; asm volatile("" : "+v"(tid_));
    const int tid = tid_, wid = __builtin_amdgcn_readfirstlane(tid >> 6), lane = tid & 63, wr = wid >> 2, wc = wid & 3, fr = lane & 15, fq = lane >> 4;
    int K_ = g.K; asm volatile("" : "+s"(K_));
    const int K = K_, nt = K / BK;
    unsigned voffA[2], voffB[2];
#pragma unroll
    for (int i = 0; i < 2; ++i) { int R, C; stage_rc(tid * 16 + i * 8192, R, C); const int Rb = Epi::PERM ? ((R & ~31) + perm32(R & 31)) : R;
        voffA[i] = (unsigned)(R * K + C) * 2u; voffB[i] = (unsigned)(Rb * K + C) * 2u; }
    const size_t kstep = (size_t)(BK * 2);
    const size_t hstep = (size_t)HALF * K * 2;
    const size_t tstep = 2 * hstep;
    const unsigned ldsw = (unsigned)wid * 1024u;
    const int aoff = lds_byte(wr * 64 + fr, fq * 8), boff = lds_byte(wc * 32 + fr, fq * 8);
#define PG8_SA(b, h) (((b) * 2 + (h)) * HTB)
#define PG8_SB(b, h) ((4 + (b) * 2 + (h)) * HTB)
#define PG8_STAGE(bufoff, gbase, voff) do { _Pragma("unroll") for (int _i = 0; _i < 2; ++_i) \
        __builtin_amdgcn_global_load_lds((const unsigned*)((const char*)(gbase) + (voff)[_i]), (PG8_LAS unsigned*)(lds + (bufoff) + ldsw + _i * 8192), 16, 0, 0); } while (0)
#define PG8_LDA(dst, b, h) do { _Pragma("unroll") for (int m = 0; m < 4; ++m) _Pragma("unroll") for (int k = 0; k < 2; ++k) dst[m][k] = *(const PG8_LAS bf16x8*)(lds + PG8_SA(b, h) + aoff + m * 2048 + k * 1024); } while (0)
#define PG8_LDB(dst, b, h) do { _Pragma("unroll") for (int n = 0; n < 2; ++n) _Pragma("unroll") for (int k = 0; k < 2; ++k) dst[n][k] = *(const PG8_LAS bf16x8*)(lds + PG8_SB(b, h) + boff + n * 2048 + k * 1024); } while (0)
#define PG8_MMA(ai, bj, At, Bt) do { __builtin_amdgcn_s_setprio(1); _Pragma("unroll") for (int m = 0; m < 4; ++m) _Pragma("unroll") for (int n = 0; n < 2; ++n) _Pragma("unroll") for (int k = 0; k < 2; ++k) \
        acc[ai][bj][m][n] = __builtin_amdgcn_mfma_f32_16x16x32_bf16(Bt[n][k], At[m][k], acc[ai][bj][m][n], 0, 0, 0); __builtin_amdgcn_s_setprio(0); } while (0)
#define PG8_WAIT_V(n) asm volatile("s_waitcnt vmcnt(" #n ")" ::: "memory")
#define PG8_WAIT_L(n) asm volatile("s_waitcnt lgkmcnt(" #n ")" ::: "memory")
#define PG8_BAR __builtin_amdgcn_s_barrier()
#define PG8_SCHED __builtin_amdgcn_sched_barrier(0)
    Unit cur, nxt; int ui = 0;
    if (!S.next(0, cur)) return;
    f32x4 acc[2][2][4][2];
#pragma unroll
    for (int a = 0; a < 2; ++a)
#pragma unroll
        for (int b = 0; b < 2; ++b)
#pragma unroll
            for (int m = 0; m < 4; ++m)
#pragma unroll
                for (int n = 0; n < 2; ++n) acc[a][b][m][n] = (f32x4){0.f, 0.f, 0.f, 0.f};
    bf16x8 At[4][2], B0[2][2], B1[2][2];
    const char* cA = (const char*)g.A + (size_t)cur.pm * tstep; const char* cB = (const char*)g.Bt + (size_t)cur.pn * tstep;
    S.a_ready(cur);
    if constexpr (SP2) {
        PG8_STAGE(PG8_SB(0, 0), cB, voffB); PG8_STAGE(PG8_SB(0, 1), cB + hstep, voffB); PG8_STAGE(PG8_SA(0, 0), cA, voffA); PG8_STAGE(PG8_SA(0, 1), cA + hstep, voffA);
        if (wr == 1) PG8_BAR;
        PG8_WAIT_V(2); PG8_BAR;
        PG8_STAGE(PG8_SB(1, 0), cB + kstep, voffB); PG8_STAGE(PG8_SA(1, 0), cA + kstep, voffA); PG8_STAGE(PG8_SB(1, 1), cB + hstep + kstep, voffB);
        PG8_WAIT_V(6); PG8_BAR;
    } else {
        PG8_STAGE(PG8_SB(0, 0), cB, voffB); PG8_STAGE(PG8_SA(0, 0), cA, voffA); PG8_STAGE(PG8_SB(0, 1), cB + hstep, voffB); PG8_STAGE(PG8_SA(0, 1), cA + hstep, voffA);
        if (wr == 1) PG8_BAR;
        PG8_WAIT_V(4); PG8_BAR;
        PG8_STAGE(PG8_SB(1, 0), cB + kstep, voffB); PG8_STAGE(PG8_SA(1, 0), cA + kstep, voffA); PG8_STAGE(PG8_SB(1, 1), cB + hstep + kstep, voffB);
        PG8_WAIT_V(6); PG8_BAR;
    }
    for (;;) {
        const bool has_next = S.next(ui + 1, nxt);
        const char* nA = has_next ? (const char*)g.A + (size_t)nxt.pm * tstep : cA; const char* nB = has_next ? (const char*)g.Bt + (size_t)nxt.pn * tstep : cB;
        for (int t = 0; t < nt; t += 2) {
            const bool last = (t == nt - 2);
            const char* a1 = cA + (size_t)(t + 1) * kstep;
            const char* a2 = last ? nA : cA + (size_t)(t + 2) * kstep; const char* b2 = last ? nB : cB + (size_t)(t + 2) * kstep;
            const char* a3 = a2 + kstep; const char* b3 = b2 + kstep;
            if (last && has_next) S.a_ready(nxt);
            if constexpr (SP2) {
            PG8_LDB(B0, 0, 0); PG8_LDB(B1, 0, 1); PG8_SCHED; PG8_LDA(At, 0, 0); PG8_STAGE(PG8_SA(1, 1), a1 + hstep, voffA);
            PG8_WAIT_V(8); PG8_WAIT_L(0); PG8_BAR; PG8_MMA(0, 0, At, B0); PG8_MMA(0, 1, At, B1); PG8_BAR; PG8_SCHED;
            PG8_LDA(At, 0, 1); PG8_STAGE(PG8_SB(0, 0), b2, voffB); PG8_STAGE(PG8_SB(0, 1), b2 + hstep, voffB); PG8_STAGE(PG8_SA(0, 0), a2, voffA);
            PG8_WAIT_V(8); PG8_WAIT_L(0); PG8_BAR; PG8_MMA(1, 0, At, B0); PG8_MMA(1, 1, At, B1); PG8_BAR; PG8_SCHED;
            PG8_LDB(B0, 1, 0); PG8_LDB(B1, 1, 1); PG8_SCHED; PG8_LDA(At, 1, 0); PG8_STAGE(PG8_SA(0, 1), a2 + hstep, voffA);
            PG8_WAIT_V(8); PG8_WAIT_L(0); PG8_BAR; PG8_MMA(0, 0, At, B0); PG8_MMA(0, 1, At, B1); PG8_BAR; PG8_SCHED;
            PG8_LDA(At, 1, 1); PG8_STAGE(PG8_SB(1, 0), b3, voffB); PG8_STAGE(PG8_SB(1, 1), b3 + hstep, voffB); PG8_STAGE(PG8_SA(1, 0), a3, voffA);
            PG8_WAIT_V(8); PG8_WAIT_L(0); PG8_BAR; PG8_MMA(1, 0, At, B0); PG8_MMA(1, 1, At, B1); PG8_BAR; PG8_SCHED;
            } else {
            PG8_LDB(B0, 0, 0); PG8_SCHED; PG8_LDA(At, 0, 0); PG8_STAGE(PG8_SA(1, 1), a1 + hstep, voffA);
            PG8_WAIT_L(8); PG8_BAR; PG8_WAIT_L(0); PG8_MMA(0, 0, At, B0); PG8_BAR; PG8_SCHED;
            PG8_LDB(B1, 0, 1); PG8_STAGE(PG8_SB(0, 0), b2, voffB);
            PG8_BAR; PG8_WAIT_L(0); PG8_MMA(0, 1, At, B1); PG8_BAR;
            PG8_LDA(At, 0, 1); PG8_STAGE(PG8_SA(0, 0), a2, voffA);
            PG8_BAR; PG8_WAIT_L(0); PG8_MMA(1, 0, At, B0); PG8_BAR; PG8_SCHED;
            PG8_STAGE(PG8_SB(0, 1), b2 + hstep, voffB);
            PG8_WAIT_V(6); PG8_BAR; PG8_MMA(1, 1, At, B1); PG8_BAR;
            PG8_LDB(B0, 1, 0); PG8_SCHED; PG8_LDA(At, 1, 0); PG8_STAGE(PG8_SA(0, 1), a2 + hstep, voffA);
            PG8_WAIT_L(8); PG8_BAR; PG8_WAIT_L(0); PG8_MMA(0, 0, At, B0); PG8_BAR; PG8_SCHED;
            PG8_LDB(B1, 1, 1); PG8_STAGE(PG8_SB(1, 0), b3, voffB);
            PG8_BAR; PG8_WAIT_L(0); PG8_MMA(0, 1, At, B1); PG8_BAR;
            PG8_LDA(At, 1, 1); PG8_STAGE(PG8_SA(1, 0), a3, voffA);
            PG8_BAR; PG8_WAIT_L(0); PG8_MMA(1, 0, At, B0); PG8_BAR; PG8_SCHED;
            PG8_STAGE(PG8_SB(1, 1), b3 + hstep, voffB);
            PG8_WAIT_V(6); PG8_BAR; PG8_MMA(1, 1, At, B1); PG8_BAR;
            }
        }
        if constexpr (ALIGN_EPI) { if (wr == 0) PG8_BAR; }
        if constexpr (!Epi::AFTER_DRAIN) { E(acc, cur, wr, wc, fr, fq); S.done(cur); }
        if (!has_next) break;
#pragma unroll
        for (int a = 0; a < 2; ++a)
#pragma unroll
            for (int b = 0; b < 2; ++b)
#pragma unroll
                for (int m = 0; m < 4; ++m)
#pragma unroll
                    for (int n = 0; n < 2; ++n) acc[a][b][m][n] = (f32x4){0.f, 0.f, 0.f, 0.f};
        cur = nxt; cA = nA; cB = nB; ++ui;
        if constexpr (ALIGN_EPI) { if (wr == 1) PG8_BAR; }
    }
    PG8_WAIT_V(0);
    if constexpr (!ALIGN_EPI) { if (wr == 0) PG8_BAR; }
    PG8_BAR;
    if constexpr (Epi::AFTER_DRAIN) { E.fused(acc, cur, wr, wc, fr, fq, lds, wid, lane); S.done(cur); }
#undef PG8_SA
#undef PG8_SB
#undef PG8_STAGE
#undef PG8_LDA
#undef PG8_LDB
#undef PG8_MMA
#undef PG8_WAIT_V
#undef PG8_WAIT_L
#undef PG8_BAR
#undef PG8_SCHED
}
}

using pg8::Unit;
typedef pg8::f32x4 f32x4;
__device__ __forceinline__ float sigmoidf_(float x) { return 1.f / (1.f + __expf(-x)); }
__device__ __forceinline__ v4u pack8(f32x4 a, f32x4 b) { v4u w; w.x = pk2(a[0], a[1]); w.y = pk2(a[2], a[3]); w.z = pk2(b[0], b[1]); w.w = pk2(b[2], b[3]); return w; }

struct EpiF32 { static constexpr bool PERM = true, AFTER_DRAIN = false;
    float* O; int ldc;
    __device__ __forceinline__ void operator()(const f32x4 (&acc)[2][2][4][2], const Unit& u, int wr, int wc, int fr, int fq) const {
        const int row0 = u.pm * 256 + wr * 64 + fr, col0 = u.pn * 256 + wc * 32 + 8 * fq;
#pragma unroll
        for (int ai = 0; ai < 2; ++ai)
#pragma unroll
            for (int m = 0; m < 4; ++m) { float* rp = O + (size_t)(row0 + ai * 128 + m * 16) * ldc + col0;
#pragma unroll
                for (int bj = 0; bj < 2; ++bj) { *(f32x4*)(rp + bj * 128) = acc[ai][bj][m][0]; *(f32x4*)(rp + bj * 128 + 4) = acc[ai][bj][m][1]; } }
    }
};
__device__ __forceinline__ float row_ss(const float* RS, int row, bool slots) { if (!slots) return RS[row];
    const v4f* p = (const v4f*)(RS + (size_t)row * 16); const v4f a = p[0], b = p[1], c = p[2], d = p[3];
    return (((a.x + a.y) + (a.z + a.w)) + ((b.x + b.y) + (b.z + b.w))) + (((c.x + c.y) + (c.z + c.w)) + ((d.x + d.y) + (d.z + d.w))); }
struct EpiEvenIn { static constexpr bool PERM = true, AFTER_DRAIN = false;
    float* CQKV; u16* FQ; const float* RS; bool slots;
    __device__ __forceinline__ void operator()(const f32x4 (&acc)[2][2][4][2], const Unit& u, int wr, int wc, int fr, int fq) const {
        const int row0 = u.pm * 256 + wr * 64 + fr, c0 = wc * 32 + 8 * fq;
#pragma unroll
        for (int ai = 0; ai < 2; ++ai)
#pragma unroll
            for (int m = 0; m < 4; ++m) { const int row = row0 + ai * 128 + m * 16; const float rs = rsqrtf(row_ss(RS, row, slots) * (1.f / DM) + RMS_EPS);
#pragma unroll
                for (int bj = 0; bj < 2; ++bj) { const int c = c0 + bj * 128; f32x4 v0 = acc[ai][bj][m][0] * rs, v1 = acc[ai][bj][m][1] * rs;
                    if (u.pn < 2) { float* p = CQKV + (size_t)row * 512 + u.pn * 256 + c; *(f32x4*)p = v0; *(f32x4*)(p + 4) = v1; }
                    else { const int t = u.pn - 2, which = t >> 1; const float sc = which == 0 ? QS64 : 1.f;
                        u16* p = FQ + (size_t)which * ((size_t)S * 512) + (size_t)row * 512 + (t & 1) * 256 + c; *(v4u*)p = pack8(v0 * sc, v1 * sc); } } }
    }
};
struct EpiOddIn { static constexpr bool PERM = true, AFTER_DRAIN = false;
    u16* DQ; u16* NQ; u16* SM1; u16* SM2; float* GATE; const float* RS; bool slots;
    __device__ __forceinline__ void operator()(const f32x4 (&acc)[2][2][4][2], const Unit& u, int wr, int wc, int fr, int fq) const {
        const int row0 = u.pm * 256 + wr * 64 + fr, c0 = wc * 32 + 8 * fq;
#pragma unroll
        for (int ai = 0; ai < 2; ++ai)
#pragma unroll
            for (int m = 0; m < 4; ++m) { const int row = row0 + ai * 128 + m * 16; const float rs = rsqrtf(row_ss(RS, row, slots) * (1.f / DM) + RMS_EPS);
#pragma unroll
                for (int bj = 0; bj < 2; ++bj) { const int c = c0 + bj * 128; f32x4 v0 = acc[ai][bj][m][0] * rs, v1 = acc[ai][bj][m][1] * rs;
                    if (u.pn < 9) { const int which = u.pn / 3; const float sc = which == 0 ? QS64 : 1.f;
                        u16* p = DQ + (size_t)which * ((size_t)S * 768) + (size_t)row * 768 + (u.pn - which * 3) * 256 + c; *(v4u*)p = pack8(v0 * sc, v1 * sc); }
                    else if (u.pn == 9) { *(v4u*)(NQ + (size_t)row * 256 + c) = pack8(v0 * QS64, v1 * QS64); }
                    else if (u.pn == 10) { *(v4u*)(SM1 + (size_t)row * 256 + c) = pack8(v0, v1); }
                    else { *(v4u*)(SM2 + (size_t)row * 256 + c) = pack8(v0, v1);
                        if (c >= 128 && c < 144) {
#pragma unroll
                            for (int e = 0; e < 8; ++e) { const int gi = c + e - 128; const float v = e < 4 ? v0[e & 3] : v1[e & 3]; if (gi < 12) GATE[(size_t)row * 16 + gi] = sigmoidf_(v); } } } } }
    }
};
struct EpiUq { static constexpr bool PERM = true, AFTER_DRAIN = false;
    u16* QM; const float* CS;
    __device__ __forceinline__ void operator()(const f32x4 (&acc)[2][2][4][2], const Unit& u, int wr, int wc, int fr, int fq) const {
        const int row0 = u.pm * 256 + wr * 64 + fr, c0 = wc * 32 + 8 * fq;
#pragma unroll
        for (int ai = 0; ai < 2; ++ai)
#pragma unroll
            for (int m = 0; m < 4; ++m) { const int row = row0 + ai * 128 + m * 16;
#pragma unroll
                for (int bj = 0; bj < 2; ++bj) { const int c = c0 + bj * 128; f32x4 v0 = acc[ai][bj][m][0], v1 = acc[ai][bj][m][1];
                    if (u.pn < 2) { const int cc = u.pn * 256 + c, head = cc >> 6, d = cc & 63; *(v4u*)(QM + (size_t)row * 768 + head * 96 + d) = pack8(v0 * QS96, v1 * QS96); }
                    else { const int head = c >> 5, grp = (c & 31) >> 3;
                        const f32x4 cs = *(const f32x4*)(CS + (size_t)row * 32 + 4 * grp), sn = *(const f32x4*)(CS + (size_t)row * 32 + 16 + 4 * grp);
                        const f32x4 o1 = (v0 * cs - v1 * sn) * QS96, o2 = (v1 * cs + v0 * sn) * QS96;
                        v2u w1, w2; w1.x = pk2(o1[0], o1[1]); w1.y = pk2(o1[2], o1[3]); w2.x = pk2(o2[0], o2[1]); w2.y = pk2(o2[2], o2[3]);
                        u16* qp = QM + (size_t)row * 768 + head * 96 + 64 + 4 * grp; *(v2u*)qp = w1; *(v2u*)(qp + 16) = w2; } } }
    }
};
struct EpiUkv { static constexpr bool PERM = true, AFTER_DRAIN = false;
    u16* KM; u16* VM;
    __device__ __forceinline__ void operator()(const f32x4 (&acc)[2][2][4][2], const Unit& u, int wr, int wc, int fr, int fq) const {
        const int row0 = u.pm * 256 + wr * 64 + fr, c0 = wc * 32 + 8 * fq;
#pragma unroll
        for (int ai = 0; ai < 2; ++ai)
#pragma unroll
            for (int m = 0; m < 4; ++m) { const int row = row0 + ai * 128 + m * 16;
#pragma unroll
                for (int bj = 0; bj < 2; ++bj) { const int c = c0 + bj * 128; const v4u w = pack8(acc[ai][bj][m][0], acc[ai][bj][m][1]);
                    if (u.pn < 2) { const int cc = u.pn * 256 + c, head = cc >> 6, d = cc & 63; *(v4u*)(KM + (size_t)row * 768 + head * 96 + d) = w; }
                    else { *(v4u*)(VM + (size_t)row * 512 + (u.pn - 2) * 256 + c) = w; } } }
    }
};
struct EpiUp { static constexpr bool PERM = true, AFTER_DRAIN = false;
    u16* HID; const float* RS;
    __device__ __forceinline__ void operator()(const f32x4 (&acc)[2][2][4][2], const Unit& u, int wr, int wc, int fr, int fq) const {
        const int row0 = u.pm * 256 + wr * 64 + fr, col0 = u.pn * 256 + wc * 32 + 8 * fq;
#pragma unroll
        for (int ai = 0; ai < 2; ++ai)
#pragma unroll
            for (int m = 0; m < 4; ++m) { const int row = row0 + ai * 128 + m * 16; const float rs = rsqrtf(RS[row] * (1.f / DM) + RMS_EPS);
#pragma unroll
                for (int bj = 0; bj < 2; ++bj) { f32x4 v0 = acc[ai][bj][m][0] * rs, v1 = acc[ai][bj][m][1] * rs;
#pragma unroll
                    for (int e = 0; e < 4; ++e) { const float a = fmaxf(v0[e], 0.f), b = fmaxf(v1[e], 0.f); v0[e] = a * a; v1[e] = b * b; }
                    *(v4u*)(HID + (size_t)row * DFF + col0 + bj * 128) = pack8(v0, v1); } }
    }
};
struct EpiPleG { static constexpr bool PERM = true, AFTER_DRAIN = false;
    float* H; u16* HB; const float* PP; const float* RS; float* RSB;
    __device__ __forceinline__ void operator()(const f32x4 (&acc)[2][2][4][2], const Unit& u, int wr, int wc, int fr, int fq) const {
        const int row0 = u.pm * 256 + wr * 64 + fr, col0 = u.pn * 256 + wc * 32 + 8 * fq;
#pragma unroll
        for (int ai = 0; ai < 2; ++ai)
#pragma unroll
            for (int m = 0; m < 4; ++m) { const int row = row0 + ai * 128 + m * 16; const float rs = rsqrtf(RS[row] * (1.f / DM) + RMS_EPS); float ssq = 0.f;
#pragma unroll
                for (int bj = 0; bj < 2; ++bj) { const size_t off = (size_t)row * DM + col0 + bj * 128;
                    f32x4 g0 = acc[ai][bj][m][0] * rs, g1 = acc[ai][bj][m][1] * rs;
                    const f32x4 p0 = *(const f32x4*)(PP + off), p1 = *(const f32x4*)(PP + off + 4);
                    f32x4 h0 = *(const f32x4*)(H + off), h1 = *(const f32x4*)(H + off + 4);
#pragma unroll
                    for (int e = 0; e < 4; ++e) { h0[e] += sigmoidf_(g0[e]) * p0[e]; h1[e] += sigmoidf_(g1[e]) * p1[e]; ssq += h0[e] * h0[e] + h1[e] * h1[e]; }
                    *(f32x4*)(H + off) = h0; *(f32x4*)(H + off + 4) = h1; *(v4u*)(HB + off) = pack8(h0, h1); }
                ssq += __shfl_xor(ssq, 16); ssq += __shfl_xor(ssq, 32);
                if (fq == 0) RSB[(size_t)row * 16 + u.pn * 4 + wc] = ssq; }
    }
};

__device__ __forceinline__ void cvt_item(const float* __restrict__ W, int ldw, int K, int col0, int ncols, const float* __restrict__ gain, u16* __restrict__ dst, int row0,
                                         LAS float* scr, int kb, int nb, int lane) {
    const int k0 = kb * 64, n0 = nb * 32;
#pragma unroll 8
    for (int i = 0; i < 32; ++i) { const int kk = 2 * i + (lane >> 5), n = n0 + (lane & 31);
        float v = (n < ncols) ? W[(size_t)(k0 + kk) * ldw + col0 + n] : 0.f; if (gain) v *= gain[k0 + kk];
        scr[kk * 33 + (lane & 31)] = v; }
    LDS_WAIT();
    const int c = lane & 7;
#pragma unroll
    for (int j = 0; j < 4; ++j) { const int n = (lane >> 3) + 8 * j; const LAS float* s = scr + (8 * c) * 33 + n;
        v4u o; o.x = pk2(s[0 * 33], s[1 * 33]); o.y = pk2(s[2 * 33], s[3 * 33]); o.z = pk2(s[4 * 33], s[5 * 33]); o.w = pk2(s[6 * 33], s[7 * 33]);
        if (n0 + n < ncols) *(v4u*)(dst + (size_t)(row0 + n0 + n) * K + k0 + 8 * c) = o; }
    LDS_WAIT();
}
__device__ __forceinline__ void cvt_job(const float* W, int ldw, int K, int col0, int ncols, const float* gain, u16* dst, int row0, int& cursor, LAS float* scr, int gw, int NGW, int lane) {
    const int nnb = (ncols + 31) / 32, nit = (K / 64) * nnb;
    int first = gw - cursor; if (first < 0) first += NGW;
    for (int it = first; it < nit; it += NGW) cvt_item(W, ldw, K, col0, ncols, gain, dst, row0, scr, it / nnb, it % nnb, lane);
    cursor = (cursor + nit) % NGW;
}

template <int DQK, class KF>
__device__ __forceinline__ void attn_accum(const u16* __restrict__ qrow, int count, const KF kf, const u16* __restrict__ Kb, int kstride, const u16* __restrict__ Vb, int vstride,
                                           float& m, float& l, float& o, int lane) {
    unsigned qp[DQK / 2];
#pragma unroll
    for (int i = 0; i < DQK / 8; ++i) { const v4u v = *(const v4u*)(qrow + 8 * i); qp[4 * i] = v.x; qp[4 * i + 1] = v.y; qp[4 * i + 2] = v.z; qp[4 * i + 3] = v.w; }
    for (int j0 = 0; j0 < count; j0 += 64) {
        const int j = j0 + lane; int ridx = 0; float bias = 0.f;
        const bool valid = (j < count) && kf(j, ridx, bias);
        float s = -INFINITY;
        if (valid) { const u16* kr = Kb + (size_t)ridx * kstride; float a0 = 0.f, a1 = 0.f;
#pragma unroll
            for (int i = 0; i < DQK / 8; ++i) { const v4u kk = *(const v4u*)(kr + 8 * i);
                a0 += bflo(qp[4 * i]) * bflo(kk.x) + bflo(qp[4 * i + 1]) * bflo(kk.y) + bflo(qp[4 * i + 2]) * bflo(kk.z) + bflo(qp[4 * i + 3]) * bflo(kk.w);
                a1 += bfhi(qp[4 * i]) * bfhi(kk.x) + bfhi(qp[4 * i + 1]) * bfhi(kk.y) + bfhi(qp[4 * i + 2]) * bfhi(kk.z) + bfhi(qp[4 * i + 3]) * bfhi(kk.w); }
            s = a0 + a1 + bias; }
        const float cm = wave_max(s);
        if (cm == -INFINITY) continue;
        const float mn = fmaxf(m, cm), alpha = exp2f(m - mn), p = valid ? exp2f(s - mn) : 0.f;
        l = l * alpha + wave_sum(p); o *= alpha; m = mn;
        if (!valid) ridx = 0;
#pragma unroll 2
        for (int jj = 0; jj < 64; ++jj) { const float pj = rdlane_f(p, jj);
            if (pj != 0.f) { const int rj = __builtin_amdgcn_readlane(ridx, jj); o += pj * bf2f(Vb[(size_t)rj * vstride + lane]); } }
    }
}
struct KfCausal { int t; __device__ __forceinline__ bool operator()(int j, int& r, float& b) const { r = j; b = 0.f; return j <= t; } };
struct KfFox { int t; const float* cum; int h; __device__ __forceinline__ bool operator()(int j, int& r, float& b) const { r = j; if (j <= t) b = -cum[(size_t)j * 8 + h] * LOG2E; return j <= t; } };
struct KfDil { int t, d; const float* lut; __device__ __forceinline__ bool operator()(int j, int& r, float& b) const { const int s = t - d * j; r = s; b = lut[j]; return s >= 0; } };
struct KfAll { __device__ __forceinline__ bool operator()(int j, int& r, float& b) const { r = j; b = 0.f; return true; } };
struct KfSel { int t; const LAS int* sel; const float* lut; __device__ __forceinline__ bool operator()(int j, int& r, float& b) const {
    const int tok = sel[j >> 6] * 64 + (j & 63), dist = t - tok; r = tok; b = lut[dist < 0 ? 0 : (dist > 2047 ? 2047 : dist)]; return dist >= 0; } };
struct KfWin { int t; const float* lut; __device__ __forceinline__ bool operator()(int j, int& r, float& b) const { const int s = t - j; r = s; b = lut[j]; return s >= 0; } };

__device__ __forceinline__ int t5_bucket(int n) {
    if (n < 16) return n;
    int b = 16;
    b += (n >= 22) + (n >= 30) + (n >= 40) + (n >= 54) + (n >= 73) + (n >= 99) + (n >= 134) + (n >= 182) + (n >= 246) + (n >= 332) + (n >= 450) + (n >= 609) + (n >= 825) + (n >= 1117) + (n >= 1513);
    return b;
}
__device__ __forceinline__ float gelu_tanh(float x) { return 0.5f * x * (1.f + tanhf(0.7978845608028654f * (x + 0.044715f * x * x * x))); }

__device__ __forceinline__ void finalize_row(float* __restrict__ h, const float* __restrict__ mix, const float* __restrict__ g, u16* __restrict__ hb, float* __restrict__ rs, int row, int lane) {
    const v4f* mr = (const v4f*)(mix + (size_t)row * DM) + lane; v4f* hr = (v4f*)(h + (size_t)row * DM) + lane; const v4f* gr = (const v4f*)g + lane;
    v4f mv[4]; float ss = 0.f;
#pragma unroll
    for (int j = 0; j < 4; ++j) { mv[j] = mr[64 * j]; ss += mv[j].x * mv[j].x + mv[j].y * mv[j].y + mv[j].z * mv[j].z + mv[j].w * mv[j].w; }
    const float rstd = rsqrtf(wave_sum(ss) * (1.f / DM) + RMS_EPS); float s2 = 0.f;
    v2u* o8 = (v2u*)(hb + (size_t)row * DM) + lane;
#pragma unroll
    for (int j = 0; j < 4; ++j) { v4f hv = hr[64 * j]; const v4f gv = gr[64 * j]; hv = hv + mv[j] * rstd * gv; hr[64 * j] = hv;
        s2 += hv.x * hv.x + hv.y * hv.y + hv.z * hv.z + hv.w * hv.w; v2u w; w.x = pk2(hv.x, hv.y); w.y = pk2(hv.z, hv.w); o8[64 * j] = w; }
    s2 = wave_sum(s2); if (lane == 0) rs[row] = s2;
}


typedef short bf16x8_t __attribute__((ext_vector_type(8)));
typedef short s16x4_t __attribute__((ext_vector_type(4)));
typedef float f32x16 __attribute__((ext_vector_type(16)));
__device__ __forceinline__ s16x4_t lds_tr16(const LAS unsigned char* p) { return __builtin_bit_cast(s16x4_t, __builtin_amdgcn_ds_read_tr16_b64_v4i16((LAS s16x4_t*)p)); }
__device__ __forceinline__ float xhalf_max(float v) { auto rr = __builtin_amdgcn_permlane32_swap(__float_as_uint(v), __float_as_uint(v), false, false);
    const unsigned a = rr[0], b = rr[1]; return fmaxf(__uint_as_float(a), __uint_as_float(b)); }
__device__ __forceinline__ float xhalf_sum(float v) { auto rr = __builtin_amdgcn_permlane32_swap(__float_as_uint(v), __float_as_uint(v), false, false);
    const unsigned a = rr[0], b = rr[1]; return __uint_as_float(a) + __uint_as_float(b); }
constexpr int ATT_BUF = 24576;

template <int DQK, bool KBIAS>
__device__ __forceinline__ void attn_unit(LAS unsigned char* lds, const u16* __restrict__ Qh, int qpitch, const u16* __restrict__ Kh, int kpitch, const u16* __restrict__ Vh, int vpitch,
                                          u16* __restrict__ Oh, int opitch, int qb, const float* __restrict__ cumh, int tid) {
    constexpr int NCH = DQK / 8, KS = DQK / 16, NKL = (64 * NCH + 511) / 512;
    const int lane = tid & 63, wid = __builtin_amdgcn_readfirstlane(tid >> 6), r32 = lane & 31, hi = lane >> 5;
    const int q0 = qb * 256, NT = 4 * (qb + 1), row0w = q0 + 32 * wid;
    bf16x8_t qf[KS];
#pragma unroll
    for (int d0 = 0; d0 < KS; ++d0) qf[d0] = *(const bf16x8_t*)(Qh + (size_t)(row0w + r32) * qpitch + 16 * d0 + 8 * hi);
    f32x16 o0, o1;
#pragma unroll
    for (int r = 0; r < 16; ++r) { o0[r] = 0.f; o1[r] = 0.f; }
    float m = -INFINITY, l = 0.f;
    const int vdt = tid >> 8, vkey = (tid & 255) >> 2, vpart = tid & 3;
    const u16* vsrc = Vh + (size_t)vkey * vpitch + vdt * 32 + vpart * 8;
    const int vdst = 12288 + vdt * 4096 + vkey * 64 + vpart * 16;
    v4u kreg[NKL]; v4u vreg; float breg = 0.f;
#define ATT_LOAD(kt) do { _Pragma("unroll") for (int i_ = 0; i_ < NKL; ++i_) { const int idx_ = tid + 512 * i_; if (idx_ < 64 * NCH) kreg[i_] = *(const v4u*)(Kh + (size_t)((kt) * 64 + (idx_ & 63)) * kpitch + (idx_ >> 6) * 8); } \
        vreg = *(const v4u*)(vsrc + (size_t)(kt) * 64 * vpitch); if (KBIAS && tid < 64) breg = -cumh[(size_t)((kt) * 64 + tid) * 8] * LOG2E; } while (0)
#define ATT_STORE(buf) do { LAS unsigned char* b_ = lds + (buf) * ATT_BUF; _Pragma("unroll") for (int i_ = 0; i_ < NKL; ++i_) { const int idx_ = tid + 512 * i_; if (idx_ < 64 * NCH) *(LAS v4u*)(b_ + (idx_ >> 6) * 1024 + (idx_ & 63) * 16) = kreg[i_]; } \
        *(LAS v4u*)(b_ + vdst) = vreg; if (KBIAS && tid < 64) *(LAS float*)(b_ + 20480 + tid * 4) = breg; } while (0)
    ATT_LOAD(0); ATT_STORE(0);
    __syncthreads();
    const int kfo = hi * 1024 + r32 * 16;
    const int vfo = 12288 + (4 * hi + ((lane & 15) >> 2)) * 64 + ((lane >> 4) & 1) * 32 + (lane & 3) * 8;
    for (int kt = 0; kt < NT; ++kt) {
        const LAS unsigned char* bf = lds + (kt & 1) * ATT_BUF;
        if (kt + 1 < NT) ATT_LOAD(kt + 1);
        const int kbase = 64 * kt;
        if (kbase <= row0w + 31) {
            f32x16 p0, p1;
            if (KBIAS) {
#pragma unroll
                for (int a4 = 0; a4 < 4; ++a4) { const v4f b0 = *(const LAS v4f*)(bf + 20480 + (8 * a4 + 4 * hi) * 4), b1 = *(const LAS v4f*)(bf + 20480 + (32 + 8 * a4 + 4 * hi) * 4);
                    p0[4 * a4] = b0.x; p0[4 * a4 + 1] = b0.y; p0[4 * a4 + 2] = b0.z; p0[4 * a4 + 3] = b0.w; p1[4 * a4] = b1.x; p1[4 * a4 + 1] = b1.y; p1[4 * a4 + 2] = b1.z; p1[4 * a4 + 3] = b1.w; }
            } else {
#pragma unroll
                for (int r = 0; r < 16; ++r) { p0[r] = 0.f; p1[r] = 0.f; }
            }
#pragma unroll
            for (int d0 = 0; d0 < KS; ++d0) { const bf16x8_t k0 = *(const LAS bf16x8_t*)(bf + kfo + d0 * 2048), k1 = *(const LAS bf16x8_t*)(bf + kfo + d0 * 2048 + 512);
                p0 = __builtin_amdgcn_mfma_f32_32x32x16_bf16(k0, qf[d0], p0, 0, 0, 0); p1 = __builtin_amdgcn_mfma_f32_32x32x16_bf16(k1, qf[d0], p1, 0, 0, 0); }
            if (kbase + 63 > row0w) {
                const int qrow = row0w + r32;
#pragma unroll
                for (int r = 0; r < 16; ++r) { const int key = kbase + (r & 3) + 8 * (r >> 2) + 4 * hi; if (key > qrow) p0[r] = -INFINITY; if (key + 32 > qrow) p1[r] = -INFINITY; }
            }
            float mx = fmaxf(p0[0], p1[0]);
#pragma unroll
            for (int r = 1; r < 16; ++r) mx = fmaxf(mx, fmaxf(p0[r], p1[r]));
            mx = xhalf_max(mx);
            const float mn = fmaxf(m, mx), alpha = exp2f(m - mn); m = mn;
            float ps = 0.f;
#pragma unroll
            for (int r = 0; r < 16; ++r) { p0[r] = exp2f(p0[r] - mn); p1[r] = exp2f(p1[r] - mn); ps += p0[r] + p1[r]; }
            l = l * alpha + ps;
#pragma unroll
            for (int r = 0; r < 16; ++r) { o0[r] *= alpha; o1[r] *= alpha; }
            bf16x8_t pw[4];
#pragma unroll
            for (int ks = 0; ks < 4; ++ks) { v4u w;
                if (ks < 2) { w.x = pk2(p0[8 * ks], p0[8 * ks + 1]); w.y = pk2(p0[8 * ks + 2], p0[8 * ks + 3]); w.z = pk2(p0[8 * ks + 4], p0[8 * ks + 5]); w.w = pk2(p0[8 * ks + 6], p0[8 * ks + 7]); }
                else { const int k2 = ks - 2; w.x = pk2(p1[8 * k2], p1[8 * k2 + 1]); w.y = pk2(p1[8 * k2 + 2], p1[8 * k2 + 3]); w.z = pk2(p1[8 * k2 + 4], p1[8 * k2 + 5]); w.w = pk2(p1[8 * k2 + 6], p1[8 * k2 + 7]); }
                pw[ks] = __builtin_bit_cast(bf16x8_t, w); }
#pragma unroll
            for (int ks = 0; ks < 4; ++ks) {
#pragma unroll
                for (int dt = 0; dt < 2; ++dt) { const s16x4_t a = lds_tr16(bf + vfo + dt * 4096 + ks * 1024), b = lds_tr16(bf + vfo + dt * 4096 + ks * 1024 + 512);
                    bf16x8_t vf; vf[0] = a[0]; vf[1] = a[1]; vf[2] = a[2]; vf[3] = a[3]; vf[4] = b[0]; vf[5] = b[1]; vf[6] = b[2]; vf[7] = b[3];
                    if (dt == 0) o0 = __builtin_amdgcn_mfma_f32_32x32x16_bf16(vf, pw[ks], o0, 0, 0, 0); else o1 = __builtin_amdgcn_mfma_f32_32x32x16_bf16(vf, pw[ks], o1, 0, 0, 0); } }
        }
        if (kt + 1 < NT) ATT_STORE((kt + 1) & 1);
        __syncthreads();
    }
#undef ATT_LOAD
#undef ATT_STORE
    const float inv = 1.f / xhalf_sum(l);
    u16* orow = Oh + (size_t)(row0w + r32) * opitch;
#pragma unroll
    for (int a4 = 0; a4 < 4; ++a4) { v2u w0, w1; w0.x = pk2(o0[4 * a4] * inv, o0[4 * a4 + 1] * inv); w0.y = pk2(o0[4 * a4 + 2] * inv, o0[4 * a4 + 3] * inv);
        w1.x = pk2(o1[4 * a4] * inv, o1[4 * a4 + 1] * inv); w1.y = pk2(o1[4 * a4 + 2] * inv, o1[4 * a4 + 3] * inv);
        *(v2u*)(orow + 8 * a4 + 4 * hi) = w0; *(v2u*)(orow + 32 + 8 * a4 + 4 * hi) = w1; }
}

struct Args { const void* in[28]; float* out; unsigned char* ws; int ph_lo, ph_hi; };
typedef const __attribute__((address_space(4))) Args* KArgP;
__device__ __forceinline__ KArgP kargs() { KArgP p = (KArgP)__builtin_amdgcn_kernarg_segment_ptr(); asm volatile("" : "+s"(p)); return p; }
#define WSP(T, off) ((T*)(ws + (off)))
#define INP(k) ((const float*)ap->in[k])

#define IN(k) (kargs()->ph_lo <= (k) && (k) < kargs()->ph_hi)
#define SEAM(k) do { if (IN((k) + 1)) { XcdBarrier b_; b_.bar = (unsigned*)(kargs()->ws + WS_CTL) + CW_BAR; b_.x = xb_xcc_id(); b_.st = (volatile LAS unsigned*)(lds + MISC_OFF) + 8; xcd_barrier(b_); } } while (0)
#define PHASE_IDS() int tid_l = threadIdx.x, bid_l = blockIdx.x, G_l = gridDim.x; asm volatile("" : "+v"(tid_l), "+s"(bid_l), "+s"(G_l)); \
    const int tid = tid_l, bid = bid_l, G = G_l, NGW = G * NWAVES, lane = tid & 63, wave = __builtin_amdgcn_readfirstlane(tid >> 6), gw = bid * NWAVES + wave; (void)NGW; \
    LAS float* wscr = (LAS float*)(lds + wave * 16384); (void)wscr; (void)gw; (void)lane; (void)tid
#define GEMM_IDS() int bid_l = blockIdx.x, G_l = gridDim.x; asm volatile("" : "+s"(bid_l), "+s"(G_l)); const int bid = bid_l, G = G_l


template <int li> __device__ __forceinline__ void layer_body(LAS unsigned char* lds) {
    constexpr int pb = 1 + li * 12, lj = li >> 1; constexpr bool even = (li & 1) == 0;
    constexpr size_t HBC = (li & 1) ? WS_HB2 : WS_HB, HBN = (li & 1) ? WS_HB : WS_HB2;
        if (IN(pb + 0)) {
            KArgP ap = kargs(); unsigned char* ws = ap->ws; PHASE_IDS();
            u16* W_in = WSP(u16, WS_W + W_IN); u16* W_out = WSP(u16, WS_W + W_OUT);
            int cursor = 0; const int gt = bid * NTHREADS + tid, NGT = G * NTHREADS;
            const float* g_pre = INP(19) + (size_t)li * DM;
            if (even) {
                const float* W = INP(4) + (size_t)lj * DM * EV_IN;
                ap = kargs(); cvt_job(W, EV_IN, DM, 0, 256, g_pre, W_in, 0, cursor, wscr, gw, NGW, lane);
                ap = kargs(); cvt_job(W, EV_IN, DM, 256, 128, g_pre, W_in, 256, cursor, wscr, gw, NGW, lane);
                ap = kargs(); cvt_job(W, EV_IN, DM, 384, 32, g_pre, W_in, 384, cursor, wscr, gw, NGW, lane);
                ap = kargs(); cvt_job(W, EV_IN, DM, 1952, 8, g_pre, W_in, 416, cursor, wscr, gw, NGW, lane);
                ap = kargs(); cvt_job(W, EV_IN, DM, 416, 512, g_pre, W_in, 512, cursor, wscr, gw, NGW, lane);
                ap = kargs(); cvt_job(W, EV_IN, DM, 928, 512, g_pre, W_in, 1024, cursor, wscr, gw, NGW, lane);
                ap = kargs(); cvt_job(W, EV_IN, DM, 1440, 512, g_pre, W_in, 1536, cursor, wscr, gw, NGW, lane);
                for (int idx = gt; idx < (512 - 424) * DM / 8; idx += NGT) ((v4u*)(W_in + (size_t)424 * DM))[idx] = (v4u){0u, 0u, 0u, 0u};
                ap = kargs(); cvt_job(INP(10) + (size_t)lj * DM * DM, DM, DM, 0, DM, nullptr, W_out, 0, cursor, wscr, gw, NGW, lane);
                u16* W_uq = WSP(u16, WS_W + W_UQ); u16* W_ukv = WSP(u16, WS_W + W_UKV);
                const float* wuq = INP(6) + (size_t)lj * 256 * 768; const float* qn = INP(5) + lj * 256;
                for (int idx = gt; idx < 768 * 256; idx += NGT) { const int n = idx >> 8, k = idx & 255; int col;
                    if (n < 512) col = (n >> 6) * 96 + (n & 63); else { const int r = n - 512, hh = r >> 5, grp = (r & 31) >> 3, e = r & 7; col = hh * 96 + 64 + (e < 4 ? 4 * grp + e : 16 + 4 * grp + e - 4); }
                    W_uq[idx] = (u16)f2bf(wuq[(size_t)k * 768 + col] * qn[k]); }
                const float* wukv = INP(8) + (size_t)lj * 128 * 1024; const float* kvn = INP(7) + lj * 128;
                for (int idx = gt; idx < 1024 * 128; idx += NGT) { const int n = idx >> 7, k = idx & 127; int col;
                    if (n < 512) col = (n >> 6) * 128 + (n & 63); else { const int r = n - 512; col = (r >> 6) * 128 + 64 + (r & 63); }
                    W_ukv[idx] = (u16)f2bf(wukv[(size_t)k * 1024 + col] * kvn[k]); }
            } else {
                const float* W = INP(11) + (size_t)lj * DM * OD_IN;
                ap = kargs(); cvt_job(W, OD_IN, DM, 0, OD_IN, g_pre, W_in, 0, cursor, wscr, gw, NGW, lane);
                for (int idx = gt; idx < (3072 - OD_IN) * DM / 8; idx += NGT) ((v4u*)(W_in + (size_t)OD_IN * DM))[idx] = (v4u){0u, 0u, 0u, 0u};
                ap = kargs(); cvt_job(INP(18) + (size_t)lj * 512 * DM, DM, 512, 0, DM, nullptr, W_out, 0, cursor, wscr, gw, NGW, lane);
            }
            ap = kargs(); cvt_job(INP(23) + (size_t)li * DM * DFF, DFF, DM, 0, DFF, INP(21) + (size_t)li * DM, WSP(u16, WS_W + W_UP), 0, cursor, wscr, gw, NGW, lane);
            ap = kargs(); cvt_job(INP(24) + (size_t)li * DFF * DM, DM, DFF, 0, DM, nullptr, WSP(u16, WS_W + W_DN), 0, cursor, wscr, gw, NGW, lane);
            ap = kargs(); cvt_job(INP(26) + (size_t)li * DM * DM, DM, DM, 0, DM, INP(25) + (size_t)li * DM, WSP(u16, WS_W + W_PG), 0, cursor, wscr, gw, NGW, lane);
            ap = kargs(); cvt_job(INP(27) + (size_t)li * PLE * DM, DM, PLE, 0, DM, nullptr, WSP(u16, WS_W + W_PP), 0, cursor, wscr, gw, NGW, lane);
            const v4f* ps = (const v4f*)(INP(1) + (size_t)li * S * PLE); v2u* PB2 = WSP(v2u, WS_PB);
            for (int idx = gt; idx < S * PLE / 4; idx += NGT) { const v4f v = ps[idx]; v2u w; w.x = pk2(v.x, v.y); w.y = pk2(v.z, v.w); PB2[idx] = w; }
            SEAM(pb + 0);
        }
        if (even) {
            if (IN(pb + 1)) {
                KArgP ap = kargs(); unsigned char* ws = ap->ws; GEMM_IDS();
                pg8::Gemm g{WSP(u16, HBC), WSP(u16, WS_W + W_IN), S, 2048, DM}; pg8::StaticOrder So; So.init(S, 2048, G, bid);
                EpiEvenIn E{WSP(float, WS_MIX), WSP(u16, WS_A + A_FQ), li == 0 ? WSP(float, WS_LUT + OFF_RSA) : WSP(float, WS_RSP), li != 0};
                pg8::gemm_phase<EpiEvenIn, pg8::StaticOrder, true, true>(lds, g, So, E);
                SEAM(pb + 1);
            }
            if (IN(pb + 2)) {
                KArgP ap = kargs(); unsigned char* ws = ap->ws; PHASE_IDS();
                const float* CQKV = WSP(float, WS_MIX); const float* CS = WSP(float, WS_CS); u16* CQN = WSP(u16, WS_A + A_CQN); u16* CKVN = WSP(u16, WS_A + A_CKVN); u16* KM = WSP(u16, WS_A + A_KM);
                float* LOGF = WSP(float, WS_LUT + OFF_LOGF); float* CT = WSP(float, WS_LUT + OFF_CT);
                const float* fb = INP(9) + lj * 8;
                LAS float* lf = (LAS float*)(lds + 131072 - 4096);
                for (int c = bid; c < S / 64; c += G) {
                    for (int jr = 0; jr < 8; ++jr) { const int rl = wave * 8 + jr, t = c * 64 + rl; const float* cr = CQKV + (size_t)t * 512;
                        { const v4f v = *((const v4f*)cr + lane); const float ss = wave_sum(v.x * v.x + v.y * v.y + v.z * v.z + v.w * v.w); const float r = rsqrtf(ss * (1.f / 256) + RMS_EPS);
                          v2u w; w.x = pk2(v.x * r, v.y * r); w.y = pk2(v.z * r, v.w * r); *((v2u*)(CQN + (size_t)t * 256) + lane) = w; }
                        { const v2f v = *((const v2f*)(cr + 256) + lane); const float ss = wave_sum(v.x * v.x + v.y * v.y); const float r = rsqrtf(ss * (1.f / 128) + RMS_EPS);
                          *((unsigned*)(CKVN + (size_t)t * 128) + lane) = pk2(v.x * r, v.y * r); }
                        if (lane < 16) { const float x1 = cr[384 + lane], x2 = cr[400 + lane], cs = CS[(size_t)t * 32 + lane], sn = CS[(size_t)t * 32 + 16 + lane];
                            const u16 o1 = (u16)f2bf(x1 * cs - x2 * sn), o2 = (u16)f2bf(x2 * cs + x1 * sn);
#pragma unroll
                            for (int hh = 0; hh < 8; ++hh) { KM[(size_t)t * 768 + hh * 96 + 64 + lane] = o1; KM[(size_t)t * 768 + hh * 96 + 80 + lane] = o2; } }
                        if (lane < 8) { const float z = cr[416 + lane] + fb[lane]; lf[rl * 8 + lane] = fminf(z, 0.f) - log1pf(__expf(-fabsf(z))); } }
                    __syncthreads();
                    if (tid < 8) { float acc = 0.f; for (int r = 0; r < 64; ++r) { acc += lf[r * 8 + tid]; LOGF[(size_t)(c * 64 + r) * 8 + tid] = acc; } CT[c * 8 + tid] = acc; }
                    __syncthreads();
                }
                SEAM(pb + 2);
            }
            if (IN(pb + 3)) {
                { KArgP ap = kargs(); unsigned char* ws = ap->ws; PHASE_IDS();
                  const float* LOGF = WSP(float, WS_LUT + OFF_LOGF); const float* CT = WSP(float, WS_LUT + OFF_CT); float* CUM = WSP(float, WS_A + A_CUM);
                  for (int c = bid; c < S / 64; c += G) {
                      if (wave == 0) { float pre = 0.f; const int hh = lane & 7;
                          for (int cc = lane >> 3; cc < c; cc += 8) pre += CT[cc * 8 + hh];
                          pre += __shfl_xor(pre, 8); pre += __shfl_xor(pre, 16); pre += __shfl_xor(pre, 32);
                          for (int r = lane >> 3; r < 64; r += 8) { const size_t o = (size_t)(c * 64 + r) * 8 + hh; CUM[o] = LOGF[o] + pre; } }
                  } }
                { KArgP ap = kargs(); unsigned char* ws = ap->ws; GEMM_IDS();
                  pg8::Gemm g{WSP(u16, WS_A + A_CKVN), WSP(u16, WS_W + W_UKV), S, 1024, 128}; pg8::StaticOrder So; So.init(S, 1024, G, bid); EpiUkv E{WSP(u16, WS_A + A_KM), WSP(u16, WS_A + A_VM)};
                  pg8::gemm_phase<EpiUkv, pg8::StaticOrder, true, true>(lds, g, So, E); }
                { KArgP ap = kargs(); unsigned char* ws = ap->ws; GEMM_IDS();
                  pg8::Gemm g{WSP(u16, WS_A + A_CQN), WSP(u16, WS_W + W_UQ), S, 768, 256}; pg8::StaticOrder So; So.init(S, 768, G, bid); EpiUq E{WSP(u16, WS_A + A_QM), WSP(float, WS_CS)};
                  pg8::gemm_phase<EpiUq, pg8::StaticOrder, true, true>(lds, g, So, E); }
                SEAM(pb + 3);
            }
            if (IN(pb + 4)) {
                KArgP ap = kargs(); unsigned char* ws = ap->ws; PHASE_IDS();
                const u16* FQ = WSP(u16, WS_A + A_FQ); const u16* FK = WSP(u16, WS_A + A_FK); const u16* FV = WSP(u16, WS_A + A_FV);
                const u16* QM = WSP(u16, WS_A + A_QM); const u16* KM = WSP(u16, WS_A + A_KM); const u16* VM = WSP(u16, WS_A + A_VM); u16* OA = WSP(u16, WS_A + A_OA); const float* CUM = WSP(float, WS_A + A_CUM);
                for (int pid = bid; pid < 256; pid += G) { const int hh = pid & 7, pr = pid >> 3;
                    for (int sub = 0; sub < 2; ++sub) { const int qb = sub ? 63 - pr : pr;
                        attn_unit<96, false>(lds, QM + hh * 96, 768, KM + hh * 96, 768, VM + hh * 64, 512, OA + hh * 64, DM, qb, nullptr, tid);
                        attn_unit<64, true>(lds, FQ + hh * 64, 512, FK + hh * 64, 512, FV + hh * 64, 512, OA + 512 + hh * 64, DM, qb, CUM + hh, tid); } }
                SEAM(pb + 4);
            }
            if (IN(pb + 5)) {
                KArgP ap = kargs(); unsigned char* ws = ap->ws; GEMM_IDS();
                pg8::Gemm g{WSP(u16, WS_A + A_OA), WSP(u16, WS_W + W_OUT), S, DM, DM}; pg8::StaticOrder So; So.init(S, DM, G, bid); EpiF32 E{WSP(float, WS_MIX), DM};
                pg8::gemm_phase<EpiF32, pg8::StaticOrder, true, true>(lds, g, So, E);
                SEAM(pb + 5);
            }
        } else {
            if (IN(pb + 1)) {
                KArgP ap = kargs(); unsigned char* ws = ap->ws; GEMM_IDS();
                pg8::Gemm g{WSP(u16, HBC), WSP(u16, WS_W + W_IN), S, 3072, DM}; pg8::StaticOrder So; So.init(S, 3072, G, bid);
                EpiOddIn E{WSP(u16, WS_A + A_DQ), WSP(u16, WS_A + A_NQ), WSP(u16, WS_A + A_SM1), WSP(u16, WS_A + A_SM2), WSP(float, WS_A + A_GATE), WSP(float, WS_RSP), true};
                pg8::gemm_phase<EpiOddIn, pg8::StaticOrder, true, true>(lds, g, So, E);
                SEAM(pb + 1);
            }
            if (IN(pb + 2)) {
                KArgP ap = kargs(); unsigned char* ws = ap->ws; PHASE_IDS();
                const u16* SM1 = WSP(u16, WS_A + A_SM1); u16* KC = WSP(u16, WS_A + A_KC); u16* VC = WSP(u16, WS_A + A_VC);
                LAS float* abuf = (LAS float*)lds;
                LAS float* hbuf = abuf + 4096;
                LAS float* rbuf = hbuf + 512;
                const float* posk = INP(12) + (size_t)lj * 2048; const float* posv = INP(13) + (size_t)lj * 2048;
                const float* w1k = INP(14) + (size_t)lj * 2048 * 256; const float* w2k = INP(15) + (size_t)lj * 256 * 64;
                const float* w1v = INP(16) + (size_t)lj * 2048 * 256; const float* w2v = INP(17) + (size_t)lj * 256 * 64;
                for (int i = bid; i < 1023; i += G) {
                    for (int e = tid; e < 4096; e += NTHREADS) { const int c = e >> 11, idx = e & 2047, l = idx >> 6, d = idx & 63;
                        abuf[e] = bf2f(SM1[(size_t)(16 * i + l) * 256 + c * 64 + d]) + (c ? posv[idx] : posk[idx]); }
                    __syncthreads();
                    { const int c = tid >> 8, n = tid & 255; const float* w1 = c ? w1v : w1k; const LAS float* ab = abuf + c * 2048; float acc = 0.f;
#pragma unroll 8
                      for (int k = 0; k < 2048; ++k) acc += ab[k] * w1[(size_t)k * 256 + n];
                      hbuf[tid] = gelu_tanh(acc); }
                    __syncthreads();
                    { const int c = tid >> 8, r = tid & 255, d = r & 63, part = r >> 6; const float* w2 = c ? w2v : w2k; const LAS float* hb2 = hbuf + c * 256; float acc = 0.f;
#pragma unroll 8
                      for (int n = part * 64; n < part * 64 + 64; ++n) acc += hb2[n] * w2[n * 64 + d];
                      rbuf[(c * 4 + part) * 64 + d] = acc; }
                    __syncthreads();
                    if (tid < 128) { const int c = tid >> 6, d = tid & 63; const float v = rbuf[(c * 4 + 0) * 64 + d] + rbuf[(c * 4 + 1) * 64 + d] + rbuf[(c * 4 + 2) * 64 + d] + rbuf[(c * 4 + 3) * 64 + d];
                        (c ? VC : KC)[(size_t)i * 64 + d] = (u16)f2bf(v); }
                    __syncthreads();
                }
                SEAM(pb + 2);
            }
            if (IN(pb + 3)) { SEAM(pb + 3); }
            if (IN(pb + 4)) {
                KArgP ap = kargs(); unsigned char* ws = ap->ws; PHASE_IDS();
                const u16* DQ = WSP(u16, WS_A + A_DQ); const u16* DK = WSP(u16, WS_A + A_DK); const u16* DV = WSP(u16, WS_A + A_DV); const u16* NQ = WSP(u16, WS_A + A_NQ);
                const u16* SM1 = WSP(u16, WS_A + A_SM1); const u16* SM2 = WSP(u16, WS_A + A_SM2); const float* GATE = WSP(float, WS_A + A_GATE);
                const u16* KC = WSP(u16, WS_A + A_KC); const u16* VC = WSP(u16, WS_A + A_VC); u16* OA = WSP(u16, WS_A + A_OA);
                const float* LUTN = WSP(float, WS_LUT + LUT_N); const float* LUTD = WSP(float, WS_LUT + LUT_D);
                LAS float* phs = wscr;
                LAS int* sel = (LAS int*)(wscr + 1040);
                for (int t = gw; t < S; t += NGW) {
                    for (int hh = 0; hh < 4; ++hh) { float m = -INFINITY, l = 0.f, o = 0.f;
                        for (int g = 0; g < 3; ++g) { const int d = g == 0 ? 1 : (g == 1 ? 4 : 16); KfDil kf{t, d, LUTD + (g * 4 + hh) * 132};
                            attn_accum<64, KfDil>(DQ + (size_t)t * 768 + g * 256 + hh * 64, 129, kf, DK + g * 256 + hh * 64, 768, DV + g * 256 + hh * 64, 768, m, l, o, lane); }
                        OA[(size_t)t * 512 + hh * 64 + lane] = (u16)f2bf(o / l); }
                    const int ncv = t >= 31 ? ((t - 31) >> 4) + 1 : 0;
                    float ocmp[4], mc[4], lc[4];
#pragma unroll
                    for (int hh = 0; hh < 4; ++hh) { float m = -INFINITY, l = 0.f, o = 0.f; KfAll kf;
                        attn_accum<64, KfAll>(NQ + (size_t)t * 256 + hh * 64, ncv, kf, KC, 64, VC, 64, m, l, o, lane);
                        ocmp[hh] = l > 0.f ? o / l : 0.f; mc[hh] = m; lc[hh] = l; }
                    for (int i = lane; i < 1040; i += 64) phs[i] = 0.f;
                    LDS_WAIT();
                    for (int j0 = 0; j0 < ncv; j0 += 64) { const int j = j0 + lane;
                        if (j < ncv) { const u16* kr = KC + (size_t)j * 64; float ps = 0.f;
#pragma unroll
                            for (int hh = 0; hh < 4; ++hh) { const u16* qr = NQ + (size_t)t * 256 + hh * 64; float acc = 0.f;
#pragma unroll
                                for (int i = 0; i < 8; ++i) { const v4u kk = *(const v4u*)(kr + 8 * i), qq = *(const v4u*)(qr + 8 * i);
                                    acc += bflo(qq.x) * bflo(kk.x) + bfhi(qq.x) * bfhi(kk.x) + bflo(qq.y) * bflo(kk.y) + bfhi(qq.y) * bfhi(kk.y)
                                         + bflo(qq.z) * bflo(kk.z) + bfhi(qq.z) * bfhi(kk.z) + bflo(qq.w) * bflo(kk.w) + bfhi(qq.w) * bfhi(kk.w); }
                                ps += exp2f(acc - mc[hh]) / lc[hh]; }
                            phs[j + 4] = ps; } }
                    LDS_WAIT();
                    const int tb = t >> 6; float sc[4];
#pragma unroll
                    for (int k = 0; k < 4; ++k) { const int j = lane + 64 * k; float imp = 0.f;
#pragma unroll
                        for (int e = 0; e < 5; ++e) imp += phs[4 * j + 3 + e];
                        const bool forced = (j == 0) || (j == tb) || (j == tb - 1);
                        sc[k] = forced ? 1e9f : (j <= tb ? imp : -1e9f); }
                    for (int r = 0; r < 16; ++r) { float bv = sc[0]; int bi = lane;
#pragma unroll
                        for (int k = 1; k < 4; ++k) if (sc[k] > bv) { bv = sc[k]; bi = lane + 64 * k; }
#pragma unroll
                        for (int off = 1; off < 64; off <<= 1) { const float ov = __shfl_xor(bv, off); const int oi = __shfl_xor(bi, off); if (ov > bv || (ov == bv && oi < bi)) { bv = ov; bi = oi; } }
                        if (lane == 0) sel[r] = bi;
#pragma unroll
                        for (int k = 0; k < 4; ++k) if (bi == lane + 64 * k) sc[k] = -INFINITY; }
                    LDS_WAIT();
#pragma unroll
                    for (int hh = 0; hh < 4; ++hh) { const u16* qr = NQ + (size_t)t * 256 + hh * 64;
                        float m = -INFINITY, l = 0.f, o = 0.f; KfSel ks{t, sel, LUTN + hh * 2048};
                        attn_accum<64, KfSel>(qr, 1024, ks, SM1 + 128, 256, SM1 + 192, 256, m, l, o, lane);
                        const float osel = o / l;
                        m = -INFINITY; l = 0.f; o = 0.f; KfWin kw{t, LUTN + hh * 2048};
                        attn_accum<64, KfWin>(qr, 512, kw, SM2, 256, SM2 + 64, 256, m, l, o, lane);
                        const float owin = o / l;
                        const float* gp = GATE + (size_t)t * 16 + hh * 3;
                        OA[(size_t)t * 512 + 256 + hh * 64 + lane] = (u16)f2bf(gp[0] * ocmp[hh] + gp[1] * osel + gp[2] * owin); }
                    LDS_WAIT();
                }
                SEAM(pb + 4);
            }
            if (IN(pb + 5)) {
                KArgP ap = kargs(); unsigned char* ws = ap->ws; GEMM_IDS();
                pg8::Gemm g{WSP(u16, WS_A + A_OA), WSP(u16, WS_W + W_OUT), S, DM, 512}; pg8::StaticOrder So; So.init(S, DM, G, bid); EpiF32 E{WSP(float, WS_MIX), DM};
                pg8::gemm_phase<EpiF32, pg8::StaticOrder, true, true>(lds, g, So, E);
                SEAM(pb + 5);
            }
        }
        if (IN(pb + 6)) {
            KArgP ap = kargs(); unsigned char* ws = ap->ws; PHASE_IDS();
            const float* gpost = INP(20) + (size_t)li * DM; float* H = ap->out;
            for (int row = gw; row < S; row += NGW) finalize_row(H, WSP(float, WS_MIX), gpost, WSP(u16, HBC), WSP(float, WS_LUT + OFF_RSA), row, lane);
            SEAM(pb + 6);
        }
        if (IN(pb + 7)) {
            KArgP ap = kargs(); unsigned char* ws = ap->ws; GEMM_IDS();
            pg8::Gemm g{WSP(u16, HBC), WSP(u16, WS_W + W_UP), S, DFF, DM}; pg8::StaticOrder So; So.init(S, DFF, G, bid); EpiUp E{WSP(u16, WS_A), WSP(float, WS_LUT + OFF_RSA)};
            pg8::gemm_phase<EpiUp, pg8::StaticOrder, true, true>(lds, g, So, E);
            SEAM(pb + 7);
        }
        if (IN(pb + 8)) {
            KArgP ap = kargs(); unsigned char* ws = ap->ws; GEMM_IDS();
            pg8::Gemm g{WSP(u16, WS_A), WSP(u16, WS_W + W_DN), S, DM, DFF}; pg8::StaticOrder So; So.init(S, DM, G, bid); EpiF32 E{WSP(float, WS_MIX), DM};
            pg8::gemm_phase<EpiF32, pg8::StaticOrder, true, true>(lds, g, So, E);
            SEAM(pb + 8);
        }
        if (IN(pb + 9)) {
            KArgP ap = kargs(); unsigned char* ws = ap->ws; PHASE_IDS();
            const float* gpost = INP(22) + (size_t)li * DM; float* H = ap->out;
            for (int row = gw; row < S; row += NGW) finalize_row(H, WSP(float, WS_MIX), gpost, WSP(u16, HBC), WSP(float, WS_LUT + OFF_RSA), row, lane);
            SEAM(pb + 9);
        }
        if (IN(pb + 10)) {
            KArgP ap = kargs(); unsigned char* ws = ap->ws; GEMM_IDS();
            pg8::Gemm g{WSP(u16, WS_PB), WSP(u16, WS_W + W_PP), S, DM, PLE}; pg8::StaticOrder So; So.init(S, DM, G, bid); EpiF32 E{WSP(float, WS_MIX), DM};
            pg8::gemm_phase<EpiF32, pg8::StaticOrder, true, true>(lds, g, So, E);
            SEAM(pb + 10);
        }
        if (IN(pb + 11)) {
            KArgP ap = kargs(); unsigned char* ws = ap->ws; GEMM_IDS();
            pg8::Gemm g{WSP(u16, HBC), WSP(u16, WS_W + W_PG), S, DM, DM}; pg8::StaticOrder So; So.init(S, DM, G, bid);
            EpiPleG E{ap->out, WSP(u16, HBN), WSP(float, WS_MIX), WSP(float, WS_LUT + OFF_RSA), WSP(float, WS_RSP)};
            pg8::gemm_phase<EpiPleG, pg8::StaticOrder, true, true>(lds, g, So, E);
            SEAM(pb + 11);
        }
    }

__global__ void __launch_bounds__(NTHREADS, 2) fwd(Args a) {
    extern __shared__ __attribute__((aligned(16))) unsigned char lds_raw[];
    LAS unsigned char* lds = (LAS unsigned char*)lds_raw;
    volatile LAS unsigned* MISC = (volatile LAS unsigned*)(lds + MISC_OFF);
    for (int u = threadIdx.x; u < (LDS_BYTES - RING_BYTES) / 4; u += NTHREADS) ((LAS unsigned*)(lds + RING_BYTES))[u] = 0u;
    __syncthreads();
    (void)xcd_barrier_post((unsigned*)(a.ws + WS_CTL) + CW_BAR, MISC + 8);
    if (IN(0)) {
        KArgP ap = kargs(); unsigned char* ws = ap->ws; PHASE_IDS();
        const float* x = INP(0); const int* positions = (const int*)ap->in[2]; const float* t5 = INP(3);
        float* H = ap->out; float* CS = WSP(float, WS_CS); float* LUTN = WSP(float, WS_LUT + LUT_N); float* LUTD = WSP(float, WS_LUT + LUT_D); float* RSA = WSP(float, WS_LUT + OFF_RSA); u16* HB = WSP(u16, WS_HB);
        const int gt = bid * NTHREADS + tid, NGT = G * NTHREADS;
        for (int idx = gt; idx < S * 16; idx += NGT) { const int t = idx >> 4, i = idx & 15;
            const float invf = (float)pow(10000.0, -(double)i / 16.0); const float ang = (float)positions[t] * invf;
            CS[(size_t)t * 32 + i] = (float)cos((double)ang); CS[(size_t)t * 32 + 16 + i] = (float)sin((double)ang); }
        for (int idx = gt; idx < 4 * 2048; idx += NGT) { const int h = idx >> 11, n = idx & 2047; LUTN[idx] = t5[t5_bucket(n) * 16 + 12 + h] * LOG2E; }
        for (int idx = gt; idx < 12 * 132; idx += NGT) { const int gh = idx / 132, j = idx % 132, g = gh >> 2; const int d = g == 0 ? 1 : (g == 1 ? 4 : 16);
            LUTD[idx] = j <= 128 ? t5[t5_bucket(d * j) * 16 + gh] * LOG2E : 0.f; }
        for (int row = gw; row < S; row += NGW) { const v4f* xr = (const v4f*)(x + (size_t)row * DM) + lane; v4f* hr = (v4f*)(H + (size_t)row * DM) + lane; v2u* o8 = (v2u*)(HB + (size_t)row * DM) + lane; float ss = 0.f;
#pragma unroll
            for (int j = 0; j < 4; ++j) { const v4f v = xr[64 * j]; hr[64 * j] = v; ss += v.x * v.x + v.y * v.y + v.z * v.z + v.w * v.w; v2u w; w.x = pk2(v.x, v.y); w.y = pk2(v.z, v.w); o8[64 * j] = w; }
            ss = wave_sum(ss); if (lane == 0) RSA[row] = ss; }
        SEAM(0);
    }

    layer_body<0>(lds); layer_body<1>(lds); layer_body<2>(lds); layer_body<3>(lds);
}

constexpr int N_PHASES = 1 + 12 * DEPTH;
#ifndef MK_PER_PHASE
#define MK_PER_PHASE 0
#endif
extern "C" void kernel_launch(void* const* d_in, const int* in_sizes, int n_in, void* d_out, int out_size, void* d_ws, size_t ws_size, hipStream_t stream) {
    static int grid = 0;
    if (grid == 0) {
        if (n_in != 28 || out_size != S * DM || ws_size < WS_END) { fprintf(stderr, "kernel_launch: unexpected shapes (n_in %d out %d ws %zu, need %zu)\n", n_in, out_size, ws_size, (size_t)WS_END); grid = -1; return; }
        int dev = 0, cus = 0;
        if (hipGetDevice(&dev) != hipSuccess || hipDeviceGetAttribute(&cus, hipDeviceAttributeMultiprocessorCount, dev) != hipSuccess) { grid = -1; return; }
        if (hipFuncSetAttribute((const void*)fwd, hipFuncAttributeMaxDynamicSharedMemorySize, LDS_BYTES) != hipSuccess) { fprintf(stderr, "kernel_launch: hipFuncSetAttribute failed\n"); grid = -1; return; }
        int per_cu = 0;
        if (hipOccupancyMaxActiveBlocksPerMultiprocessor(&per_cu, (const void*)fwd, NTHREADS, LDS_BYTES) != hipSuccess || per_cu < 1) fprintf(stderr, "kernel_launch: occupancy query reports %d\n", per_cu);
        (void)hipGetLastError();
        grid = cus;
    }
    if (grid < 0) return;
    (void)hipMemsetAsync((char*)d_ws + WS_CTL, 0, CTL_ZERO_BYTES, stream);
    Args a{};
    for (int i = 0; i < 28; ++i) a.in[i] = d_in[i];
    a.out = (float*)d_out; a.ws = (unsigned char*)d_ws;
#if MK_PER_PHASE
    for (int ph = 0; ph < N_PHASES; ++ph) { a.ph_lo = ph; a.ph_hi = ph + 1; hipLaunchKernelGGL(fwd, dim3(grid), dim3(NTHREADS), LDS_BYTES, stream, a); }
#else
    a.ph_lo = 0; a.ph_hi = N_PHASES;
    hipLaunchKernelGGL(fwd, dim3(grid), dim3(NTHREADS), LDS_BYTES, stream, a);
#endif
}
```

```cpp
#include <hip/hip_runtime.h>
#include <cstdio>
#include <cstdint>

#define GAS __attribute__((address_space(1)))
#define LAS __attribute__((address_space(3)))
typedef unsigned short u16;
typedef unsigned v4u __attribute__((ext_vector_type(4)));
typedef unsigned v2u __attribute__((ext_vector_type(2)));
typedef float v4f __attribute__((ext_vector_type(4)));
typedef float v2f __attribute__((ext_vector_type(2)));

constexpr int S = 16384, DM = 1024, DFF = 4096, PLE = 256, DEPTH = 4;
constexpr int NWAVES = 8, NTHREADS = 512;
constexpr int EV_IN = 1960, OD_IN = 2956;
constexpr float RMS_EPS = 1e-6f, LOG2E = 1.4426950408889634f;
constexpr float QS64 = 0.125f * LOG2E;
constexpr float QS96 = 0.10206207261596575f * LOG2E;

constexpr size_t MiB = 1u << 20;
constexpr size_t WS_CTL = 0, CTL_ZERO_BYTES = 1 * MiB;
constexpr size_t WS_CS = 1 * MiB;
constexpr size_t WS_LUT = 3 * MiB;
constexpr size_t LUT_N = 0;
constexpr size_t LUT_D = 32768;
constexpr size_t OFF_RSA = 65536, OFF_RSB = 131072;
constexpr size_t OFF_LOGF = 262144;
constexpr size_t OFF_CT = 786432;
constexpr size_t WS_W = 4 * MiB;
constexpr size_t W_IN = 0, W_OUT = 6 * MiB, W_UP = 8 * MiB, W_DN = 16 * MiB, W_PG = 24 * MiB, W_PP = 26 * MiB, W_UQ = 26 * MiB + 512 * 1024, W_UKV = 27 * MiB;
constexpr size_t WS_PB = 32 * MiB;
constexpr size_t WS_HB = 40 * MiB;
constexpr size_t WS_MIX = 72 * MiB;
constexpr size_t WS_A = 136 * MiB;
constexpr size_t A_FQ = 0, A_FK = 16 * MiB, A_FV = 32 * MiB, A_CQN = 48 * MiB, A_CKVN = 56 * MiB, A_QM = 60 * MiB, A_KM = 84 * MiB, A_VM = 108 * MiB, A_OA = 124 * MiB, A_CUM = 156 * MiB;
constexpr size_t A_DQ = 0, A_DK = 24 * MiB, A_DV = 48 * MiB, A_NQ = 72 * MiB, A_SM1 = 80 * MiB, A_SM2 = 88 * MiB, A_GATE = 96 * MiB, A_KC = 97 * MiB, A_VC = 97 * MiB + 256 * 1024;
constexpr size_t A_LSED = 98 * MiB, A_ODIL = 99 * MiB, A_OWIN = 140 * MiB;
constexpr size_t A_OCMP = 0, A_OSEL = 8 * MiB;
constexpr size_t WS_HB2 = 293 * MiB;
constexpr size_t WS_RSP = 325 * MiB;
constexpr size_t WS_END = 326 * MiB;
constexpr int CW_BAR = 4096;

constexpr int RING_BYTES = 131072;
constexpr int MISC_OFF = RING_BYTES + 320;
constexpr int LDS_BYTES = 147456;

__device__ __forceinline__ unsigned f2bf(float f) { unsigned u = __builtin_bit_cast(unsigned, f); return (u + 0x7fffu + ((u >> 16) & 1u)) >> 16; }
__device__ __forceinline__ unsigned pk2(float lo, float hi) { return f2bf(lo) | (f2bf(hi) << 16); }
__device__ __forceinline__ float bf2f(u16 h) { return __builtin_bit_cast(float, (unsigned)h << 16); }
__device__ __forceinline__ float bflo(unsigned u) { return __builtin_bit_cast(float, u << 16); }
__device__ __forceinline__ float bfhi(unsigned u) { return __builtin_bit_cast(float, u & 0xffff0000u); }
__device__ __forceinline__ float wave_sum(float v) {
#pragma unroll
    for (int o = 1; o < 64; o <<= 1) v += __shfl_xor(v, o);
    return v;
}
__device__ __forceinline__ float wave_max(float v) {
#pragma unroll
    for (int o = 1; o < 64; o <<= 1) v = fmaxf(v, __shfl_xor(v, o));
    return v;
}
__device__ __forceinline__ float rdlane_f(float v, int l) { return __builtin_bit_cast(float, __builtin_amdgcn_readlane(__builtin_bit_cast(int, v), l)); }
#define LDS_WAIT() asm volatile("s_waitcnt lgkmcnt(0)" ::: "memory")

#define XB_TMO      128
#define XB_XCNT(j)  (256  + 64 * (j))
#define XB_XSUB(j)  (1280 + 64 * (j))
#define XB_XGEN(j)  (2304 + 64 * (j))
#define XB_TOP      3328
#define XB_TOPGEN   3392
#define XCD_BAR_WORDS 3456
#define XB_SPIN_CAP (1u << 18)

__device__ __forceinline__ unsigned xb_ld(unsigned* p)              { return __hip_atomic_load(p, __ATOMIC_RELAXED, __HIP_MEMORY_SCOPE_AGENT); }
__device__ __forceinline__ unsigned xb_add(unsigned* p, unsigned v) { return __hip_atomic_fetch_add(p, v, __ATOMIC_RELAXED, __HIP_MEMORY_SCOPE_AGENT); }
__device__ __forceinline__ unsigned xb_xcc_id() { return (unsigned)__builtin_amdgcn_s_getreg((3 << 11) | 20) & 0xFu; }
#define XB_SPIN(cond, bar) do { unsigned _sp = 0; while (cond) { __builtin_amdgcn_s_sleep(1); \
    if ((++_sp & 255u) == 0u) { if (xb_ld(&(bar)[XB_TMO])) break; if (_sp > XB_SPIN_CAP) { atomicAdd(&(bar)[XB_TMO], 1u); break; } } } } while (0)

struct XcdBarrier {
    unsigned* bar; unsigned x;
    volatile LAS unsigned* st;
};

__device__ __forceinline__ XcdBarrier xcd_barrier_post(unsigned* bar, volatile LAS unsigned* st) {
    XcdBarrier b; b.bar = bar; b.x = xb_xcc_id(); b.st = st;
    if (threadIdx.x == 0) (void)xb_add(&bar[XB_XCNT(b.x)], 1u);
    return b;
}
__device__ __forceinline__ void xcd_barrier_complete(unsigned* bar, unsigned x, unsigned& nloc, unsigned& nx) {
    const unsigned G = gridDim.x * gridDim.y * gridDim.z;
    unsigned sum, cnt, mine, sp = 0u;
    for (;;) {
        sum = 0u; cnt = 0u; mine = 0u;
#pragma unroll
        for (unsigned j = 0; j < 16; ++j) { const unsigned c = xb_ld(&bar[XB_XCNT(j)]); sum += c; cnt += (c > 0u) ? 1u : 0u; mine = (j == x) ? c : mine; }
        if (sum == G) break;
        __builtin_amdgcn_s_sleep(1);
        if ((++sp & 255u) == 0u) { if (xb_ld(&bar[XB_TMO])) break; if (sp > XB_SPIN_CAP) { atomicAdd(&bar[XB_TMO], 1u); break; } }
    }
    nloc = mine > 0u ? mine : 1u; nx = cnt > 0u ? cnt : 1u;
}

__device__ __forceinline__ void xcd_barrier(const XcdBarrier& b) {
    asm volatile("s_waitcnt vmcnt(0)" ::: "memory");
    __syncthreads();
    if (threadIdx.x == 0) {
        unsigned* bar = b.bar;
        __builtin_amdgcn_s_waitcnt(0);
        unsigned nloc = b.st[0], nx = b.st[1];
        if (nloc == 0u) { xcd_barrier_complete(bar, b.x, nloc, nx); b.st[0] = nloc; b.st[1] = nx; }
        const unsigned old = xb_add(&bar[XB_XSUB(b.x)], 1u);
        const unsigned gen = old / nloc;
        if (old + 1u == (gen + 1u) * nloc) {
            __builtin_amdgcn_fence(__ATOMIC_RELEASE, "agent");
            asm volatile("s_waitcnt vmcnt(0)" ::: "memory");
            const unsigned og = xb_add(&bar[XB_TOP], 1u);
            const unsigned tg = og / nx;
            if (og + 1u == (tg + 1u) * nx) xb_add(&bar[XB_TOPGEN], 1u);
            else XB_SPIN(xb_ld(&bar[XB_TOPGEN]) == tg, bar);
            __builtin_amdgcn_fence(__ATOMIC_ACQUIRE, "agent");
            xb_add(&bar[XB_XGEN(b.x)], 1u);
            asm volatile("s_waitcnt vmcnt(0)" ::: "memory");
        } else {
            XB_SPIN(xb_ld(&bar[XB_XGEN(b.x)]) == gen, bar);
            __builtin_amdgcn_fence(__ATOMIC_ACQUIRE, "agent");
            asm volatile("s_waitcnt vmcnt(0)" ::: "memory");
        }
    }
    __syncthreads();
}

namespace pg8 {
#define PG8_LAS __attribute__((address_space(3)))
typedef unsigned short bf16_t;
typedef short bf16x8 __attribute__((ext_vector_type(8)));
typedef float f32x4 __attribute__((ext_vector_type(4)));
typedef unsigned u32x4 __attribute__((ext_vector_type(4)));
constexpr int BM = 256, BK = 64, HALF = 128, HTB = HALF * BK * 2  , STAGE_BYTES = 8 * HTB, NXCD = 8, WGM = 8;

__host__ __device__ __forceinline__ int lds_byte(int r, int c) { const int st = (r >> 4) * 2 + (c >> 5), rr = r & 15, cc = c & 31, ob = rr * 64 + cc * 2; return st * 1024 + (ob ^ (((ob >> 9) & 1) << 5)); }
__host__ __device__ __forceinline__ void stage_rc(int b, int& R, int& C) { const int st = b / 1024, sb = b % 1024, swz = sb ^ (((sb >> 9) & 1) << 5); R = (st >> 1) * 16 + swz / 64; C = (st & 1) * 32 + (swz % 64) / 2; }
__host__ __device__ __forceinline__ int perm32(int rho) { const int n = rho >> 4, i = rho & 15; return 8 * (i >> 2) + 4 * n + (i & 3); }

struct Unit { int pm, pn; };
struct Gemm { const bf16_t* A; const bf16_t* Bt; int M, N, K; };

struct StaticOrder {
    int nM, nN, nwg, G, c;
    __host__ __device__ void init(int M, int N, int G_, int c_) { nM = M / BM; nN = N / BM; nwg = nM * nN; G = G_; c = c_; }
    __host__ __device__ bool next(int i, Unit& u) const {
        const long L = (long)i * G + c; if (L >= nwg) return false;
        int wgid = (int)L; { const int q = nwg / NXCD, r = nwg % NXCD, xcd = wgid % NXCD, off = wgid / NXCD; wgid = (xcd < r ? xcd * (q + 1) : r * (q + 1) + (xcd - r) * q) + off; }
        const int nig = WGM * nN, gid = wgid / nig, fm = gid * WGM, gsz = (nM - fm) < WGM ? (nM - fm) : WGM;
        u.pm = fm + ((wgid % nig) % gsz); u.pn = (wgid % nig) / gsz; return true;
    }
    __device__ __forceinline__ void a_ready(const Unit&) const {}
    __device__ __forceinline__ void done(const Unit&) const {}
};

__device__ __forceinline__ unsigned cvt_pk_bf16(float lo, float hi) { unsigned r; asm volatile("v_cvt_pk_bf16_f32 %0, %1, %2" : "=v"(r) : "v"(lo), "v"(hi)); return r; }
typedef float f32x2 __attribute__((ext_vector_type(2)));
template <class Epi, class Sched, bool ALIGN_EPI = false, bool SP2 = false>
__device__ __forceinline__ void gemm_phase(PG8_LAS unsigned char* lds, const Gemm g, const Sched& S, const Epi& E) {
    int tid_ = threadIdx.x; asm volatile("" : "+v"(tid_));
    const int tid = tid_, wid = __builtin_amdgcn_readfirstlane(tid >> 6), lane = tid & 63, wr = wid >> 2, wc = wid & 3, fr = lane & 15, fq = lane >> 4;
    int K_ = g.K; asm volatile("" : "+s"(K_));
    const int K = K_, nt = K / BK;
    unsigned voffA[2], voffB[2];
#pragma unroll
    for (int i = 0; i < 2; ++i) { int R, C; stage_rc(tid * 16 + i * 8192, R, C); const int Rb = Epi::PERM ? ((R & ~31) + perm32(R & 31)) : R;
        voffA[i] = (unsigned)(R * K + C) * 2u; voffB[i] = (unsigned)(Rb * K + C) * 2u; }
    const size_t kstep = (size_t)(BK * 2);
    const size_t hstep = (size_t)HALF * K * 2;
    const size_t tstep = 2 * hstep;
    const unsigned ldsw = (unsigned)wid * 1024u;
    const int aoff = lds_byte(wr * 64 + fr, fq * 8), boff = lds_byte(wc * 32 + fr, fq * 8);
#define PG8_SA(b, h) (((b) * 2 + (h)) * HTB)
#define PG8_SB(b, h) ((4 + (b) * 2 + (h)) * HTB)
#define PG8_STAGE(bufoff, gbase, voff) do { _Pragma("unroll") for (int _i = 0; _i < 2; ++_i) \
        __builtin_amdgcn_global_load_lds((const unsigned*)((const char*)(gbase) + (voff)[_i]), (PG8_LAS unsigned*)(lds + (bufoff) + ldsw + _i * 8192), 16, 0, 0); } while (0)
#define PG8_LDA(dst, b, h) do { _Pragma("unroll") for (int m = 0; m < 4; ++m) _Pragma("unroll") for (int k = 0; k < 2; ++k) dst[m][k] = *(const PG8_LAS bf16x8*)(lds + PG8_SA(b, h) + aoff + m * 2048 + k * 1024); } while (0)
#define PG8_LDB(dst, b, h) do { _Pragma("unroll") for (int n = 0; n < 2; ++n) _Pragma("unroll") for (int k = 0; k < 2; ++k) dst[n][k] = *(const PG8_LAS bf16x8*)(lds + PG8_SB(b, h) + boff + n * 2048 + k * 1024); } while (0)
#define PG8_MMA(ai, bj, At, Bt) do { __builtin_amdgcn_s_setprio(1); _Pragma("unroll") for (int m = 0; m < 4; ++m) _Pragma("unroll") for (int n = 0; n < 2; ++n) _Pragma("unroll") for (int k = 0; k < 2; ++k) \
        acc[ai][bj][m][n] = __builtin_amdgcn_mfma_f32_16x16x32_bf16(Bt[n][k], At[m][k], acc[ai][bj][m][n], 0, 0, 0); __builtin_amdgcn_s_setprio(0); } while (0)
#define PG8_WAIT_V(n) asm volatile("s_waitcnt vmcnt(" #n ")" ::: "memory")
#define PG8_WAIT_L(n) asm volatile("s_waitcnt lgkmcnt(" #n ")" ::: "memory")
#define PG8_BAR __builtin_amdgcn_s_barrier()
#define PG8_SCHED __builtin_amdgcn_sched_barrier(0)
    Unit cur, nxt; int ui = 0;
    if (!S.next(0, cur)) return;
    f32x4 acc[2][2][4][2];
#pragma unroll
    for (int a = 0; a < 2; ++a)
#pragma unroll
        for (int b = 0; b < 2; ++b)
#pragma unroll
            for (int m = 0; m < 4; ++m)
#pragma unroll
                for (int n = 0; n < 2; ++n) acc[a][b][m][n] = (f32x4){0.f, 0.f, 0.f, 0.f};
    bf16x8 At[4][2], B0[2][2], B1[2][2];
    const char* cA = (const char*)g.A + (size_t)cur.pm * tstep; const char* cB = (const char*)g.Bt + (size_t)cur.pn * tstep;
    S.a_ready(cur);
    if constexpr (SP2) {
        PG8_STAGE(PG8_SB(0, 0), cB, voffB); PG8_STAGE(PG8_SB(0, 1), cB + hstep, voffB); PG8_STAGE(PG8_SA(0, 0), cA, voffA); PG8_STAGE(PG8_SA(0, 1), cA + hstep, voffA);
        if (wr == 1) PG8_BAR;
        PG8_WAIT_V(2); PG8_BAR;
        PG8_STAGE(PG8_SB(1, 0), cB + kstep, voffB); PG8_STAGE(PG8_SA(1, 0), cA + kstep, voffA); PG8_STAGE(PG8_SB(1, 1), cB + hstep + kstep, voffB);
        PG8_WAIT_V(6); PG8_BAR;
    } else {
        PG8_STAGE(PG8_SB(0, 0), cB, voffB); PG8_STAGE(PG8_SA(0, 0), cA, voffA); PG8_STAGE(PG8_SB(0, 1), cB + hstep, voffB); PG8_STAGE(PG8_SA(0, 1), cA + hstep, voffA);
        if (wr == 1) PG8_BAR;
        PG8_WAIT_V(4); PG8_BAR;
        PG8_STAGE(PG8_SB(1, 0), cB + kstep, voffB); PG8_STAGE(PG8_SA(1, 0), cA + kstep, voffA); PG8_STAGE(PG8_SB(1, 1), cB + hstep + kstep, voffB);
        PG8_WAIT_V(6); PG8_BAR;
    }
    for (;;) {
        const bool has_next = S.next(ui + 1, nxt);
        const char* nA = has_next ? (const char*)g.A + (size_t)nxt.pm * tstep : cA; const char* nB = has_next ? (const char*)g.Bt + (size_t)nxt.pn * tstep : cB;
        for (int t = 0; t < nt; t += 2) {
            const bool last = (t == nt - 2);
            const char* a1 = cA + (size_t)(t + 1) * kstep;
            const char* a2 = last ? nA : cA + (size_t)(t + 2) * kstep; const char* b2 = last ? nB : cB + (size_t)(t + 2) * kstep;
            const char* a3 = a2 + kstep; const char* b3 = b2 + kstep;
            if (last && has_next) S.a_ready(nxt);
            if constexpr (SP2) {
            PG8_LDB(B0, 0, 0); PG8_LDB(B1, 0, 1); PG8_SCHED; PG8_LDA(At, 0, 0); PG8_STAGE(PG8_SA(1, 1), a1 + hstep, voffA);
            PG8_WAIT_V(8); PG8_WAIT_L(0); PG8_BAR; PG8_MMA(0, 0, At, B0); PG8_MMA(0, 1, At, B1); PG8_BAR; PG8_SCHED;
            PG8_LDA(At, 0, 1); PG8_STAGE(PG8_SB(0, 0), b2, voffB); PG8_STAGE(PG8_SB(0, 1), b2 + hstep, voffB); PG8_STAGE(PG8_SA(0, 0), a2, voffA);
            PG8_WAIT_V(8); PG8_WAIT_L(0); PG8_BAR; PG8_MMA(1, 0, At, B0); PG8_MMA(1, 1, At, B1); PG8_BAR; PG8_SCHED;
            PG8_LDB(B0, 1, 0); PG8_LDB(B1, 1, 1); PG8_SCHED; PG8_LDA(At, 1, 0); PG8_STAGE(PG8_SA(0, 1), a2 + hstep, voffA);
            PG8_WAIT_V(8); PG8_WAIT_L(0); PG8_BAR; PG8_MMA(0, 0, At, B0); PG8_MMA(0, 1, At, B1); PG8_BAR; PG8_SCHED;
            PG8_LDA(At, 1, 1); PG8_STAGE(PG8_SB(1, 0), b3, voffB); PG8_STAGE(PG8_SB(1, 1), b3 + hstep, voffB); PG8_STAGE(PG8_SA(1, 0), a3, voffA);
            PG8_WAIT_V(8); PG8_WAIT_L(0); PG8_BAR; PG8_MMA(1, 0, At, B0); PG8_MMA(1, 1, At, B1); PG8_BAR; PG8_SCHED;
            } else {
            PG8_LDB(B0, 0, 0); PG8_SCHED; PG8_LDA(At, 0, 0); PG8_STAGE(PG8_SA(1, 1), a1 + hstep, voffA);
            PG8_WAIT_L(8); PG8_BAR; PG8_WAIT_L(0); PG8_MMA(0, 0, At, B0); PG8_BAR; PG8_SCHED;
            PG8_LDB(B1, 0, 1); PG8_STAGE(PG8_SB(0, 0), b2, voffB);
            PG8_BAR; PG8_WAIT_L(0); PG8_MMA(0, 1, At, B1); PG8_BAR;
            PG8_LDA(At, 0, 1); PG8_STAGE(PG8_SA(0, 0), a2, voffA);
            PG8_BAR; PG8_WAIT_L(0); PG8_MMA(1, 0, At, B0); PG8_BAR; PG8_SCHED;
            PG8_STAGE(PG8_SB(0, 1), b2 + hstep, voffB);
            PG8_WAIT_V(6); PG8_BAR; PG8_MMA(1, 1, At, B1); PG8_BAR;
            PG8_LDB(B0, 1, 0); PG8_SCHED; PG8_LDA(At, 1, 0); PG8_STAGE(PG8_SA(0, 1), a2 + hstep, voffA);
            PG8_WAIT_L(8); PG8_BAR; PG8_WAIT_L(0); PG8_MMA(0, 0, At, B0); PG8_BAR; PG8_SCHED;
            PG8_LDB(B1, 1, 1); PG8_STAGE(PG8_SB(1, 0), b3, voffB);
            PG8_BAR; PG8_WAIT_L(0); PG8_MMA(0, 1, At, B1); PG8_BAR;
            PG8_LDA(At, 1, 1); PG8_STAGE(PG8_SA(1, 0), a3, voffA);
            PG8_BAR; PG8_WAIT_L(0); PG8_MMA(1, 0, At, B0); PG8_BAR; PG8_SCHED;
            PG8_STAGE(PG8_SB(1, 1), b3 + hstep, voffB);
            PG8_WAIT_V(6); PG8_BAR; PG8_MMA(1, 1, At, B1); PG8_BAR;
            }
        }
        if constexpr (ALIGN_EPI) { if (wr == 0) PG8_BAR; }
        if constexpr (!Epi::AFTER_DRAIN) { E(acc, cur, wr, wc, fr, fq); S.done(cur); }
        if (!has_next) break;
#pragma unroll
        for (int a = 0; a < 2; ++a)
#pragma unroll
            for (int b = 0; b < 2; ++b)
#pragma unroll
                for (int m = 0; m < 4; ++m)
#pragma unroll
                    for (int n = 0; n < 2; ++n) acc[a][b][m][n] = (f32x4){0.f, 0.f, 0.f, 0.f};
        cur = nxt; cA = nA; cB = nB; ++ui;
        if constexpr (ALIGN_EPI) { if (wr == 1) PG8_BAR; }
    }
    PG8_WAIT_V(0);
    if constexpr (!ALIGN_EPI) { if (wr == 0) PG8_BAR; }
    PG8_BAR;
    if constexpr (Epi::AFTER_DRAIN) { E.fused(acc, cur, wr, wc, fr, fq, lds, wid, lane); S.done(cur); }
#undef PG8_SA
#undef PG8_SB
#undef PG8_STAGE
#undef PG8_LDA
#undef PG8_LDB
#undef PG8_MMA
#undef PG8_WAIT_V
#undef PG8_WAIT_L
#undef PG8_BAR
#undef PG8_SCHED
}
}

using pg8::Unit;
typedef pg8::f32x4 f32x4;
__device__ __forceinline__ float sigmoidf_(float x) { return 1.f / (1.f + __expf(-x)); }
__device__ __forceinline__ v4u pack8(f32x4 a, f32x4 b) { v4u w; w.x = pk2(a[0], a[1]); w.y = pk2(a[2], a[3]); w.z = pk2(b[0], b[1]); w.w = pk2(b[2], b[3]); return w; }

struct EpiF32 { static constexpr bool PERM = true, AFTER_DRAIN = false;
    float* O; int ldc;
    __device__ __forceinline__ void operator()(const f32x4 (&acc)[2][2][4][2], const Unit& u, int wr, int wc, int fr, int fq) const {
        const int row0 = u.pm * 256 + wr * 64 + fr, col0 = u.pn * 256 + wc * 32 + 8 * fq;
#pragma unroll
        for (int ai = 0; ai < 2; ++ai)
#pragma unroll
            for (int m = 0; m < 4; ++m) { float* rp = O + (size_t)(row0 + ai * 128 + m * 16) * ldc + col0;
#pragma unroll
                for (int bj = 0; bj < 2; ++bj) { *(f32x4*)(rp + bj * 128) = acc[ai][bj][m][0]; *(f32x4*)(rp + bj * 128 + 4) = acc[ai][bj][m][1]; } }
    }
};
__device__ __forceinline__ float row_ss(const float* RS, int row, bool slots) { if (!slots) return RS[row];
    const v4f* p = (const v4f*)(RS + (size_t)row * 16); const v4f a = p[0], b = p[1], c = p[2], d = p[3];
    return (((a.x + a.y) + (a.z + a.w)) + ((b.x + b.y) + (b.z + b.w))) + (((c.x + c.y) + (c.z + c.w)) + ((d.x + d.y) + (d.z + d.w))); }
struct EpiEvenIn { static constexpr bool PERM = true, AFTER_DRAIN = false;
    float* CQKV; u16* FQ; const float* RS; bool slots;
    __device__ __forceinline__ void operator()(const f32x4 (&acc)[2][2][4][2], const Unit& u, int wr, int wc, int fr, int fq) const {
        const int row0 = u.pm * 256 + wr * 64 + fr, c0 = wc * 32 + 8 * fq;
#pragma unroll
        for (int ai = 0; ai < 2; ++ai)
#pragma unroll
            for (int m = 0; m < 4; ++m) { const int row = row0 + ai * 128 + m * 16; const float rs = rsqrtf(row_ss(RS, row, slots) * (1.f / DM) + RMS_EPS);
#pragma unroll
                for (int bj = 0; bj < 2; ++bj) { const int c = c0 + bj * 128; f32x4 v0 = acc[ai][bj][m][0] * rs, v1 = acc[ai][bj][m][1] * rs;
                    if (u.pn < 2) { float* p = CQKV + (size_t)row * 512 + u.pn * 256 + c; *(f32x4*)p = v0; *(f32x4*)(p + 4) = v1; }
                    else { const int t = u.pn - 2, which = t >> 1; const float sc = which == 0 ? QS64 : 1.f;
                        u16* p = FQ + (size_t)which * ((size_t)S * 512) + (size_t)row * 512 + (t & 1) * 256 + c; *(v4u*)p = pack8(v0 * sc, v1 * sc); } } }
    }
};
struct EpiOddIn { static constexpr bool PERM = true, AFTER_DRAIN = false;
    u16* DQ; u16* NQ; u16* SM1; u16* SM2; float* GATE; const float* RS; bool slots;
    __device__ __forceinline__ void operator()(const f32x4 (&acc)[2][2][4][2], const Unit& u, int wr, int wc, int fr, int fq) const {
        const int row0 = u.pm * 256 + wr * 64 + fr, c0 = wc * 32 + 8 * fq;
#pragma unroll
        for (int ai = 0; ai < 2; ++ai)
#pragma unroll
            for (int m = 0; m < 4; ++m) { const int row = row0 + ai * 128 + m * 16; const float rs = rsqrtf(row_ss(RS, row, slots) * (1.f / DM) + RMS_EPS);
#pragma unroll
                for (int bj = 0; bj < 2; ++bj) { const int c = c0 + bj * 128; f32x4 v0 = acc[ai][bj][m][0] * rs, v1 = acc[ai][bj][m][1] * rs;
                    if (u.pn < 9) { const int which = u.pn / 3; const float sc = which == 0 ? QS64 : 1.f;
                        u16* p = DQ + (size_t)which * ((size_t)S * 768) + (size_t)row * 768 + (u.pn - which * 3) * 256 + c; *(v4u*)p = pack8(v0 * sc, v1 * sc); }
                    else if (u.pn == 9) { *(v4u*)(NQ + (size_t)row * 256 + c) = pack8(v0 * QS64, v1 * QS64); }
                    else if (u.pn == 10) { const int seg = c >> 6, cc = c & 63;
                        if (seg < 3) *(v4u*)(SM1 + (size_t)seg * ((size_t)S * 64) + (size_t)row * 64 + cc) = pack8(v0, v1);
                        else { u16* vt = SM1 + (size_t)3 * ((size_t)S * 64) + (size_t)(row >> 6) * 4096 + (row & 63);
#pragma unroll
                            for (int e = 0; e < 8; ++e) vt[(cc + e) * 64] = (u16)f2bf(e < 4 ? v0[e & 3] : v1[e & 3]); } }
                    else { *(v4u*)(SM2 + (size_t)row * 256 + c) = pack8(v0, v1);
                        if (c >= 128 && c < 144) {
#pragma unroll
                            for (int e = 0; e < 8; ++e) { const int gi = c + e - 128; const float v = e < 4 ? v0[e & 3] : v1[e & 3]; if (gi < 12) GATE[(size_t)row * 16 + gi] = sigmoidf_(v); } } } } }
    }
};
struct EpiUq { static constexpr bool PERM = true, AFTER_DRAIN = false;
    u16* QM; const float* CS;
    __device__ __forceinline__ void operator()(const f32x4 (&acc)[2][2][4][2], const Unit& u, int wr, int wc, int fr, int fq) const {
        const int row0 = u.pm * 256 + wr * 64 + fr, c0 = wc * 32 + 8 * fq;
#pragma unroll
        for (int ai = 0; ai < 2; ++ai)
#pragma unroll
            for (int m = 0; m < 4; ++m) { const int row = row0 + ai * 128 + m * 16;
#pragma unroll
                for (int bj = 0; bj < 2; ++bj) { const int c = c0 + bj * 128; f32x4 v0 = acc[ai][bj][m][0], v1 = acc[ai][bj][m][1];
                    if (u.pn < 2) { const int cc = u.pn * 256 + c, head = cc >> 6, d = cc & 63; *(v4u*)(QM + (size_t)row * 768 + head * 96 + d) = pack8(v0 * QS96, v1 * QS96); }
                    else { const int head = c >> 5, grp = (c & 31) >> 3;
                        const f32x4 cs = *(const f32x4*)(CS + (size_t)row * 32 + 4 * grp), sn = *(const f32x4*)(CS + (size_t)row * 32 + 16 + 4 * grp);
                        const f32x4 o1 = (v0 * cs - v1 * sn) * QS96, o2 = (v1 * cs + v0 * sn) * QS96;
                        v2u w1, w2; w1.x = pk2(o1[0], o1[1]); w1.y = pk2(o1[2], o1[3]); w2.x = pk2(o2[0], o2[1]); w2.y = pk2(o2[2], o2[3]);
                        u16* qp = QM + (size_t)row * 768 + head * 96 + 64 + 4 * grp; *(v2u*)qp = w1; *(v2u*)(qp + 16) = w2; } } }
    }
};
struct EpiUkv { static constexpr bool PERM = true, AFTER_DRAIN = false;
    u16* KM; u16* VM;
    __device__ __forceinline__ void operator()(const f32x4 (&acc)[2][2][4][2], const Unit& u, int wr, int wc, int fr, int fq) const {
        const int row0 = u.pm * 256 + wr * 64 + fr, c0 = wc * 32 + 8 * fq;
#pragma unroll
        for (int ai = 0; ai < 2; ++ai)
#pragma unroll
            for (int m = 0; m < 4; ++m) { const int row = row0 + ai * 128 + m * 16;
#pragma unroll
                for (int bj = 0; bj < 2; ++bj) { const int c = c0 + bj * 128; const v4u w = pack8(acc[ai][bj][m][0], acc[ai][bj][m][1]);
                    if (u.pn < 2) { const int cc = u.pn * 256 + c, head = cc >> 6, d = cc & 63; *(v4u*)(KM + (size_t)row * 768 + head * 96 + d) = w; }
                    else { *(v4u*)(VM + (size_t)row * 512 + (u.pn - 2) * 256 + c) = w; } } }
    }
};
struct EpiUp { static constexpr bool PERM = true, AFTER_DRAIN = false;
    u16* HID; const float* RS;
    __device__ __forceinline__ void operator()(const f32x4 (&acc)[2][2][4][2], const Unit& u, int wr, int wc, int fr, int fq) const {
        const int row0 = u.pm * 256 + wr * 64 + fr, col0 = u.pn * 256 + wc * 32 + 8 * fq;
#pragma unroll
        for (int ai = 0; ai < 2; ++ai)
#pragma unroll
            for (int m = 0; m < 4; ++m) { const int row = row0 + ai * 128 + m * 16; const float rs = rsqrtf(RS[row] * (1.f / DM) + RMS_EPS);
#pragma unroll
                for (int bj = 0; bj < 2; ++bj) { f32x4 v0 = acc[ai][bj][m][0] * rs, v1 = acc[ai][bj][m][1] * rs;
#pragma unroll
                    for (int e = 0; e < 4; ++e) { const float a = fmaxf(v0[e], 0.f), b = fmaxf(v1[e], 0.f); v0[e] = a * a; v1[e] = b * b; }
                    *(v4u*)(HID + (size_t)row * DFF + col0 + bj * 128) = pack8(v0, v1); } }
    }
};
struct EpiPleG { static constexpr bool PERM = true, AFTER_DRAIN = false;
    float* H; u16* HB; const float* PP; const float* RS; float* RSB;
    __device__ __forceinline__ void operator()(const f32x4 (&acc)[2][2][4][2], const Unit& u, int wr, int wc, int fr, int fq) const {
        const int row0 = u.pm * 256 + wr * 64 + fr, col0 = u.pn * 256 + wc * 32 + 8 * fq;
#pragma unroll
        for (int ai = 0; ai < 2; ++ai)
#pragma unroll
            for (int m = 0; m < 4; ++m) { const int row = row0 + ai * 128 + m * 16; const float rs = rsqrtf(RS[row] * (1.f / DM) + RMS_EPS); float ssq = 0.f;
#pragma unroll
                for (int bj = 0; bj < 2; ++bj) { const size_t off = (size_t)row * DM + col0 + bj * 128;
                    f32x4 g0 = acc[ai][bj][m][0] * rs, g1 = acc[ai][bj][m][1] * rs;
                    const f32x4 p0 = *(const f32x4*)(PP + off), p1 = *(const f32x4*)(PP + off + 4);
                    f32x4 h0 = *(const f32x4*)(H + off), h1 = *(const f32x4*)(H + off + 4);
#pragma unroll
                    for (int e = 0; e < 4; ++e) { h0[e] += sigmoidf_(g0[e]) * p0[e]; h1[e] += sigmoidf_(g1[e]) * p1[e]; ssq += h0[e] * h0[e] + h1[e] * h1[e]; }
                    *(f32x4*)(H + off) = h0; *(f32x4*)(H + off + 4) = h1; *(v4u*)(HB + off) = pack8(h0, h1); }
                ssq += __shfl_xor(ssq, 16); ssq += __shfl_xor(ssq, 32);
                if (fq == 0) RSB[(size_t)row * 16 + u.pn * 4 + wc] = ssq; }
    }
};

__device__ __forceinline__ void cvt_item(const float* __restrict__ W, int ldw, int K, int col0, int ncols, const float* __restrict__ gain, u16* __restrict__ dst, int row0,
                                         LAS float* scr, int kb, int nb, int lane) {
    const int k0 = kb * 64, n0 = nb * 32;
#pragma unroll 8
    for (int i = 0; i < 32; ++i) { const int kk = 2 * i + (lane >> 5), n = n0 + (lane & 31);
        float v = (n < ncols) ? W[(size_t)(k0 + kk) * ldw + col0 + n] : 0.f; if (gain) v *= gain[k0 + kk];
        scr[kk * 33 + (lane & 31)] = v; }
    LDS_WAIT();
    const int c = lane & 7;
#pragma unroll
    for (int j = 0; j < 4; ++j) { const int n = (lane >> 3) + 8 * j; const LAS float* s = scr + (8 * c) * 33 + n;
        v4u o; o.x = pk2(s[0 * 33], s[1 * 33]); o.y = pk2(s[2 * 33], s[3 * 33]); o.z = pk2(s[4 * 33], s[5 * 33]); o.w = pk2(s[6 * 33], s[7 * 33]);
        if (n0 + n < ncols) *(v4u*)(dst + (size_t)(row0 + n0 + n) * K + k0 + 8 * c) = o; }
    LDS_WAIT();
}
__device__ __forceinline__ void cvt_job(const float* W, int ldw, int K, int col0, int ncols, const float* gain, u16* dst, int row0, int& cursor, LAS float* scr, int gw, int NGW, int lane) {
    const int nnb = (ncols + 31) / 32, nit = (K / 64) * nnb;
    int first = gw - cursor; if (first < 0) first += NGW;
    for (int it = first; it < nit; it += NGW) cvt_item(W, ldw, K, col0, ncols, gain, dst, row0, scr, it / nnb, it % nnb, lane);
    cursor = (cursor + nit) % NGW;
}

template <int DQK, class KF>
__device__ __forceinline__ void attn_accum(const u16* __restrict__ qrow, int count, const KF kf, const u16* __restrict__ Kb, int kstride, const u16* __restrict__ Vb, int vstride,
                                           float& m, float& l, float& o, int lane) {
    unsigned qp[DQK / 2];
#pragma unroll
    for (int i = 0; i < DQK / 8; ++i) { const v4u v = *(const v4u*)(qrow + 8 * i); qp[4 * i] = v.x; qp[4 * i + 1] = v.y; qp[4 * i + 2] = v.z; qp[4 * i + 3] = v.w; }
    for (int j0 = 0; j0 < count; j0 += 64) {
        const int j = j0 + lane; int ridx = 0; float bias = 0.f;
        const bool valid = (j < count) && kf(j, ridx, bias);
        float s = -INFINITY;
        if (valid) { const u16* kr = Kb + (size_t)ridx * kstride; float a0 = 0.f, a1 = 0.f;
#pragma unroll
            for (int i = 0; i < DQK / 8; ++i) { const v4u kk = *(const v4u*)(kr + 8 * i);
                a0 += bflo(qp[4 * i]) * bflo(kk.x) + bflo(qp[4 * i + 1]) * bflo(kk.y) + bflo(qp[4 * i + 2]) * bflo(kk.z) + bflo(qp[4 * i + 3]) * bflo(kk.w);
                a1 += bfhi(qp[4 * i]) * bfhi(kk.x) + bfhi(qp[4 * i + 1]) * bfhi(kk.y) + bfhi(qp[4 * i + 2]) * bfhi(kk.z) + bfhi(qp[4 * i + 3]) * bfhi(kk.w); }
            s = a0 + a1 + bias; }
        const float cm = wave_max(s);
        if (cm == -INFINITY) continue;
        const float mn = fmaxf(m, cm), alpha = exp2f(m - mn), p = valid ? exp2f(s - mn) : 0.f;
        l = l * alpha + wave_sum(p); o *= alpha; m = mn;
        if (!valid) ridx = 0;
#pragma unroll 2
        for (int jj = 0; jj < 64; ++jj) { const float pj = rdlane_f(p, jj);
            if (pj != 0.f) { const int rj = __builtin_amdgcn_readlane(ridx, jj); o += pj * bf2f(Vb[(size_t)rj * vstride + lane]); } }
    }
}
struct KfCausal { int t; __device__ __forceinline__ bool operator()(int j, int& r, float& b) const { r = j; b = 0.f; return j <= t; } };
struct KfFox { int t; const float* cum; int h; __device__ __forceinline__ bool operator()(int j, int& r, float& b) const { r = j; if (j <= t) b = -cum[(size_t)j * 8 + h] * LOG2E; return j <= t; } };
struct KfDil { int t, d; const float* lut; __device__ __forceinline__ bool operator()(int j, int& r, float& b) const { const int s = t - d * j; r = s; b = lut[j]; return s >= 0; } };
struct KfAll { __device__ __forceinline__ bool operator()(int j, int& r, float& b) const { r = j; b = 0.f; return true; } };
struct KfSel { int t; const LAS int* sel; const float* lut; __device__ __forceinline__ bool operator()(int j, int& r, float& b) const {
    const int tok = sel[j >> 6] * 64 + (j & 63), dist = t - tok; r = tok; b = lut[dist < 0 ? 0 : (dist > 2047 ? 2047 : dist)]; return dist >= 0; } };
struct KfWin { int t; const float* lut; __device__ __forceinline__ bool operator()(int j, int& r, float& b) const { const int s = t - j; r = s; b = lut[j]; return s >= 0; } };

__device__ __forceinline__ int t5_bucket(int n) {
    if (n < 16) return n;
    int b = 16;
    b += (n >= 22) + (n >= 30) + (n >= 40) + (n >= 54) + (n >= 73) + (n >= 99) + (n >= 134) + (n >= 182) + (n >= 246) + (n >= 332) + (n >= 450) + (n >= 609) + (n >= 825) + (n >= 1117) + (n >= 1513);
    return b;
}
__device__ __forceinline__ float gelu_tanh(float x) { return 0.5f * x * (1.f + tanhf(0.7978845608028654f * (x + 0.044715f * x * x * x))); }

__device__ __forceinline__ void finalize_row(float* __restrict__ h, const float* __restrict__ mix, const float* __restrict__ g, u16* __restrict__ hb, float* __restrict__ rs, int row, int lane) {
    const v4f* mr = (const v4f*)(mix + (size_t)row * DM) + lane; v4f* hr = (v4f*)(h + (size_t)row * DM) + lane; const v4f* gr = (const v4f*)g + lane;
    v4f mv[4]; float ss = 0.f;
#pragma unroll
    for (int j = 0; j < 4; ++j) { mv[j] = mr[64 * j]; ss += mv[j].x * mv[j].x + mv[j].y * mv[j].y + mv[j].z * mv[j].z + mv[j].w * mv[j].w; }
    const float rstd = rsqrtf(wave_sum(ss) * (1.f / DM) + RMS_EPS); float s2 = 0.f;
    v2u* o8 = (v2u*)(hb + (size_t)row * DM) + lane;
#pragma unroll
    for (int j = 0; j < 4; ++j) { v4f hv = hr[64 * j]; const v4f gv = gr[64 * j]; hv = hv + mv[j] * rstd * gv; hr[64 * j] = hv;
        s2 += hv.x * hv.x + hv.y * hv.y + hv.z * hv.z + hv.w * hv.w; v2u w; w.x = pk2(hv.x, hv.y); w.y = pk2(hv.z, hv.w); o8[64 * j] = w; }
    s2 = wave_sum(s2); if (lane == 0) rs[row] = s2;
}


typedef short bf16x8_t __attribute__((ext_vector_type(8)));
typedef short s16x4_t __attribute__((ext_vector_type(4)));
typedef float f32x16 __attribute__((ext_vector_type(16)));
__device__ __forceinline__ s16x4_t lds_tr16(const LAS unsigned char* p) { return __builtin_bit_cast(s16x4_t, __builtin_amdgcn_ds_read_tr16_b64_v4i16((LAS s16x4_t*)p)); }
__device__ __forceinline__ float xhalf_max(float v) { auto rr = __builtin_amdgcn_permlane32_swap(__float_as_uint(v), __float_as_uint(v), false, false);
    const unsigned a = rr[0], b = rr[1]; return fmaxf(__uint_as_float(a), __uint_as_float(b)); }
__device__ __forceinline__ float xhalf_sum(float v) { auto rr = __builtin_amdgcn_permlane32_swap(__float_as_uint(v), __float_as_uint(v), false, false);
    const unsigned a = rr[0], b = rr[1]; return __uint_as_float(a) + __uint_as_float(b); }
constexpr int ATT_BUF = 24576;

template <int DQK, bool KBIAS>
__device__ __forceinline__ void attn_unit(LAS unsigned char* lds, const u16* __restrict__ Qh, int qpitch, const u16* __restrict__ Kh, int kpitch, const u16* __restrict__ Vh, int vpitch,
                                          u16* __restrict__ Oh, int opitch, int qb, const float* __restrict__ cumh, int tid) {
    constexpr int NCH = DQK / 8, KS = DQK / 16, NKL = (64 * NCH + 511) / 512;
    const int lane = tid & 63, wid = __builtin_amdgcn_readfirstlane(tid >> 6), r32 = lane & 31, hi = lane >> 5;
    const int q0 = qb * 256, NT = 4 * (qb + 1), row0w = q0 + 32 * wid;
    bf16x8_t qf[KS];
#pragma unroll
    for (int d0 = 0; d0 < KS; ++d0) qf[d0] = *(const bf16x8_t*)(Qh + (size_t)(row0w + r32) * qpitch + 16 * d0 + 8 * hi);
    f32x16 o0, o1;
#pragma unroll
    for (int r = 0; r < 16; ++r) { o0[r] = 0.f; o1[r] = 0.f; }
    float m = -INFINITY, l = 0.f;
    const int vdt = tid >> 8, vkey = (tid & 255) >> 2, vpart = tid & 3;
    const u16* vsrc = Vh + (size_t)vkey * vpitch + vdt * 32 + vpart * 8;
    const int vdst = 12288 + vdt * 4096 + vkey * 64 + vpart * 16;
    v4u kreg[NKL]; v4u vreg; float breg = 0.f;
#define ATT_LOAD(kt) do { _Pragma("unroll") for (int i_ = 0; i_ < NKL; ++i_) { const int idx_ = tid + 512 * i_; if (idx_ < 64 * NCH) kreg[i_] = *(const v4u*)(Kh + (size_t)((kt) * 64 + (idx_ & 63)) * kpitch + (idx_ >> 6) * 8); } \
        vreg = *(const v4u*)(vsrc + (size_t)(kt) * 64 * vpitch); if (KBIAS && tid < 64) breg = -cumh[(size_t)((kt) * 64 + tid) * 8] * LOG2E; } while (0)
#define ATT_STORE(buf) do { LAS unsigned char* b_ = lds + (buf) * ATT_BUF; _Pragma("unroll") for (int i_ = 0; i_ < NKL; ++i_) { const int idx_ = tid + 512 * i_; if (idx_ < 64 * NCH) *(LAS v4u*)(b_ + (idx_ >> 6) * 1024 + (idx_ & 63) * 16) = kreg[i_]; } \
        *(LAS v4u*)(b_ + vdst) = vreg; if (KBIAS && tid < 64) *(LAS float*)(b_ + 20480 + tid * 4) = breg; } while (0)
    ATT_LOAD(0); ATT_STORE(0);
    __syncthreads();
    const int kfo = hi * 1024 + r32 * 16;
    const int vfo = 12288 + (4 * hi + ((lane & 15) >> 2)) * 64 + ((lane >> 4) & 1) * 32 + (lane & 3) * 8;
    for (int kt = 0; kt < NT; ++kt) {
        const LAS unsigned char* bf = lds + (kt & 1) * ATT_BUF;
        if (kt + 1 < NT) ATT_LOAD(kt + 1);
        const int kbase = 64 * kt;
        if (kbase <= row0w + 31) {
            f32x16 p0, p1;
            if (KBIAS) {
#pragma unroll
                for (int a4 = 0; a4 < 4; ++a4) { const v4f b0 = *(const LAS v4f*)(bf + 20480 + (8 * a4 + 4 * hi) * 4), b1 = *(const LAS v4f*)(bf + 20480 + (32 + 8 * a4 + 4 * hi) * 4);
                    p0[4 * a4] = b0.x; p0[4 * a4 + 1] = b0.y; p0[4 * a4 + 2] = b0.z; p0[4 * a4 + 3] = b0.w; p1[4 * a4] = b1.x; p1[4 * a4 + 1] = b1.y; p1[4 * a4 + 2] = b1.z; p1[4 * a4 + 3] = b1.w; }
            } else {
#pragma unroll
                for (int r = 0; r < 16; ++r) { p0[r] = 0.f; p1[r] = 0.f; }
            }
#pragma unroll
            for (int d0 = 0; d0 < KS; ++d0) { const bf16x8_t k0 = *(const LAS bf16x8_t*)(bf + kfo + d0 * 2048), k1 = *(const LAS bf16x8_t*)(bf + kfo + d0 * 2048 + 512);
                p0 = __builtin_amdgcn_mfma_f32_32x32x16_bf16(k0, qf[d0], p0, 0, 0, 0); p1 = __builtin_amdgcn_mfma_f32_32x32x16_bf16(k1, qf[d0], p1, 0, 0, 0); }
            if (kbase + 63 > row0w) {
                const int qrow = row0w + r32;
#pragma unroll
                for (int r = 0; r < 16; ++r) { const int key = kbase + (r & 3) + 8 * (r >> 2) + 4 * hi; if (key > qrow) p0[r] = -INFINITY; if (key + 32 > qrow) p1[r] = -INFINITY; }
            }
            float mx = fmaxf(p0[0], p1[0]);
#pragma unroll
            for (int r = 1; r < 16; ++r) mx = fmaxf(mx, fmaxf(p0[r], p1[r]));
            mx = xhalf_max(mx);
            const float mn = fmaxf(m, mx), alpha = exp2f(m - mn); m = mn;
            float ps = 0.f;
#pragma unroll
            for (int r = 0; r < 16; ++r) { p0[r] = exp2f(p0[r] - mn); p1[r] = exp2f(p1[r] - mn); ps += p0[r] + p1[r]; }
            l = l * alpha + ps;
#pragma unroll
            for (int r = 0; r < 16; ++r) { o0[r] *= alpha; o1[r] *= alpha; }
            bf16x8_t pw[4];
#pragma unroll
            for (int ks = 0; ks < 4; ++ks) { v4u w;
                if (ks < 2) { w.x = pk2(p0[8 * ks], p0[8 * ks + 1]); w.y = pk2(p0[8 * ks + 2], p0[8 * ks + 3]); w.z = pk2(p0[8 * ks + 4], p0[8 * ks + 5]); w.w = pk2(p0[8 * ks + 6], p0[8 * ks + 7]); }
                else { const int k2 = ks - 2; w.x = pk2(p1[8 * k2], p1[8 * k2 + 1]); w.y = pk2(p1[8 * k2 + 2], p1[8 * k2 + 3]); w.z = pk2(p1[8 * k2 + 4], p1[8 * k2 + 5]); w.w = pk2(p1[8 * k2 + 6], p1[8 * k2 + 7]); }
                pw[ks] = __builtin_bit_cast(bf16x8_t, w); }
#pragma unroll
            for (int ks = 0; ks < 4; ++ks) {
#pragma unroll
                for (int dt = 0; dt < 2; ++dt) { const s16x4_t a = lds_tr16(bf + vfo + dt * 4096 + ks * 1024), b = lds_tr16(bf + vfo + dt * 4096 + ks * 1024 + 512);
                    bf16x8_t vf; vf[0] = a[0]; vf[1] = a[1]; vf[2] = a[2]; vf[3] = a[3]; vf[4] = b[0]; vf[5] = b[1]; vf[6] = b[2]; vf[7] = b[3];
                    if (dt == 0) o0 = __builtin_amdgcn_mfma_f32_32x32x16_bf16(vf, pw[ks], o0, 0, 0, 0); else o1 = __builtin_amdgcn_mfma_f32_32x32x16_bf16(vf, pw[ks], o1, 0, 0, 0); } }
        }
        if (kt + 1 < NT) ATT_STORE((kt + 1) & 1);
        __syncthreads();
    }
#undef ATT_LOAD
#undef ATT_STORE
    const float inv = 1.f / xhalf_sum(l);
    u16* orow = Oh + (size_t)(row0w + r32) * opitch;
#pragma unroll
    for (int a4 = 0; a4 < 4; ++a4) { v2u w0, w1; w0.x = pk2(o0[4 * a4] * inv, o0[4 * a4 + 1] * inv); w0.y = pk2(o0[4 * a4 + 2] * inv, o0[4 * a4 + 3] * inv);
        w1.x = pk2(o1[4 * a4] * inv, o1[4 * a4 + 1] * inv); w1.y = pk2(o1[4 * a4 + 2] * inv, o1[4 * a4 + 3] * inv);
        *(v2u*)(orow + 8 * a4 + 4 * hi) = w0; *(v2u*)(orow + 32 + 8 * a4 + 4 * hi) = w1; }
}


typedef float f32x4v __attribute__((ext_vector_type(4)));
__device__ __forceinline__ void win_unit(LAS unsigned char* lds, const u16* __restrict__ Qb, int qpitch, const u16* __restrict__ Kb, int kpitch, const u16* __restrict__ Vb, int vpitch,
                                         int r0, int rs, int W, const float* __restrict__ lut, int qb, u16* __restrict__ Ob, int ldo, float* __restrict__ lse, int lse_stride, int tid) {
    const int lane = tid & 63, wid = __builtin_amdgcn_readfirstlane(tid >> 6), r32 = lane & 31, hi = lane >> 5;
    const int i0 = qb * 256, iw0 = i0 + 32 * wid, qi = iw0 + r32;
    int ktlo = i0 - (W - 1); ktlo = ktlo < 0 ? 0 : (ktlo >> 6); const int kthi = (i0 + 255) >> 6;
    const size_t qtok = (size_t)r0 + (size_t)qi * rs;
    bf16x8_t qf[4];
#pragma unroll
    for (int d0 = 0; d0 < 4; ++d0) qf[d0] = *(const bf16x8_t*)(Qb + qtok * qpitch + 16 * d0 + 8 * hi);
    LAS float* lutL = (LAS float*)(lds + 49152);
    for (int i = tid; i < W; i += NTHREADS) lutL[i] = lut[i];
    f32x16 o0, o1;
#pragma unroll
    for (int r = 0; r < 16; ++r) { o0[r] = 0.f; o1[r] = 0.f; }
    float m = -INFINITY, l = 0.f;
    const int kc = tid >> 6, kkey = tid & 63, vdt = tid >> 8, vkey = (tid & 255) >> 2, vpart = tid & 3;
    const int kdst = kc * 1024 + kkey * 16, vdst = 12288 + vdt * 4096 + vkey * 64 + vpart * 16;
    v4u kreg, vreg;
#define WIN_LOAD(kt) do { kreg = *(const v4u*)(Kb + ((size_t)r0 + (size_t)((kt) * 64 + kkey) * rs) * kpitch + kc * 8); \
        vreg = *(const v4u*)(Vb + ((size_t)r0 + (size_t)((kt) * 64 + vkey) * rs) * vpitch + vdt * 32 + vpart * 8); } while (0)
#define WIN_STORE(buf) do { LAS unsigned char* b_ = lds + (buf) * ATT_BUF; *(LAS v4u*)(b_ + kdst) = kreg; *(LAS v4u*)(b_ + vdst) = vreg; } while (0)
    WIN_LOAD(ktlo); WIN_STORE(0);
    __syncthreads();
    const int kfo = hi * 1024 + r32 * 16;
    const int vfo = 12288 + (4 * hi + ((lane & 15) >> 2)) * 64 + ((lane >> 4) & 1) * 32 + (lane & 3) * 8;
    for (int kt = ktlo; kt <= kthi; ++kt) {
        const int par = (kt - ktlo) & 1;
        const LAS unsigned char* bf = lds + par * ATT_BUF;
        if (kt < kthi) WIN_LOAD(kt + 1);
        const int kbase = 64 * kt;
        if (kbase <= iw0 + 31 && kbase + 63 >= iw0 - (W - 1)) {
            f32x16 p0, p1;
#pragma unroll
            for (int r = 0; r < 16; ++r) { p0[r] = 0.f; p1[r] = 0.f; }
#pragma unroll
            for (int d0 = 0; d0 < 4; ++d0) { const bf16x8_t k0 = *(const LAS bf16x8_t*)(bf + kfo + d0 * 2048), k1 = *(const LAS bf16x8_t*)(bf + kfo + d0 * 2048 + 512);
                p0 = __builtin_amdgcn_mfma_f32_32x32x16_bf16(k0, qf[d0], p0, 0, 0, 0); p1 = __builtin_amdgcn_mfma_f32_32x32x16_bf16(k1, qf[d0], p1, 0, 0, 0); }
            const int dq = qi - kbase - 4 * hi;
#pragma unroll
            for (int r = 0; r < 16; ++r) { const int d0_ = dq - ((r & 3) + 8 * (r >> 2)), d1_ = d0_ - 32;
                const int c0 = d0_ < 0 ? 0 : (d0_ >= W ? W - 1 : d0_), c1 = d1_ < 0 ? 0 : (d1_ >= W ? W - 1 : d1_);
                const float b0 = lutL[c0], b1 = lutL[c1];
                p0[r] = (d0_ >= 0 && d0_ < W) ? p0[r] + b0 : -INFINITY; p1[r] = (d1_ >= 0 && d1_ < W) ? p1[r] + b1 : -INFINITY; }
            float mx = fmaxf(p0[0], p1[0]);
#pragma unroll
            for (int r = 1; r < 16; ++r) mx = fmaxf(mx, fmaxf(p0[r], p1[r]));
            mx = xhalf_max(mx);
            const float mn = fmaxf(m, mx), msub = (mn == -INFINITY) ? 0.f : mn, alpha = __builtin_amdgcn_exp2f(m - msub); m = mn;
            float ps = 0.f;
#pragma unroll
            for (int r = 0; r < 16; ++r) { p0[r] = __builtin_amdgcn_exp2f(p0[r] - msub); p1[r] = __builtin_amdgcn_exp2f(p1[r] - msub); ps += p0[r] + p1[r]; }
            l = l * alpha + ps;
#pragma unroll
            for (int r = 0; r < 16; ++r) { o0[r] *= alpha; o1[r] *= alpha; }
            bf16x8_t pw[4];
#pragma unroll
            for (int ks = 0; ks < 4; ++ks) { v4u w;
                if (ks < 2) { w.x = pk2(p0[8 * ks], p0[8 * ks + 1]); w.y = pk2(p0[8 * ks + 2], p0[8 * ks + 3]); w.z = pk2(p0[8 * ks + 4], p0[8 * ks + 5]); w.w = pk2(p0[8 * ks + 6], p0[8 * ks + 7]); }
                else { const int k2 = ks - 2; w.x = pk2(p1[8 * k2], p1[8 * k2 + 1]); w.y = pk2(p1[8 * k2 + 2], p1[8 * k2 + 3]); w.z = pk2(p1[8 * k2 + 4], p1[8 * k2 + 5]); w.w = pk2(p1[8 * k2 + 6], p1[8 * k2 + 7]); }
                pw[ks] = __builtin_bit_cast(bf16x8_t, w); }
#pragma unroll
            for (int ks = 0; ks < 4; ++ks) {
#pragma unroll
                for (int dt = 0; dt < 2; ++dt) { const s16x4_t a = lds_tr16(bf + vfo + dt * 4096 + ks * 1024), b = lds_tr16(bf + vfo + dt * 4096 + ks * 1024 + 512);
                    bf16x8_t vf; vf[0] = a[0]; vf[1] = a[1]; vf[2] = a[2]; vf[3] = a[3]; vf[4] = b[0]; vf[5] = b[1]; vf[6] = b[2]; vf[7] = b[3];
                    if (dt == 0) o0 = __builtin_amdgcn_mfma_f32_32x32x16_bf16(vf, pw[ks], o0, 0, 0, 0); else o1 = __builtin_amdgcn_mfma_f32_32x32x16_bf16(vf, pw[ks], o1, 0, 0, 0); } }
        }
        if (kt < kthi) WIN_STORE(par ^ 1);
        __syncthreads();
    }
#undef WIN_LOAD
#undef WIN_STORE
    const float lt = xhalf_sum(l), inv = 1.f / lt;
    u16* orow = Ob + qtok * ldo;
#pragma unroll
    for (int a4 = 0; a4 < 4; ++a4) { v2u w0, w1; w0.x = pk2(o0[4 * a4] * inv, o0[4 * a4 + 1] * inv); w0.y = pk2(o0[4 * a4 + 2] * inv, o0[4 * a4 + 3] * inv);
        w1.x = pk2(o1[4 * a4] * inv, o1[4 * a4 + 1] * inv); w1.y = pk2(o1[4 * a4 + 2] * inv, o1[4 * a4 + 3] * inv);
        *(v2u*)(orow + 8 * a4 + 4 * hi) = w0; *(v2u*)(orow + 32 + 8 * a4 + 4 * hi) = w1; }
    if (lse != nullptr && hi == 0) lse[qtok * lse_stride] = m + __builtin_amdgcn_logf(lt);
}

__device__ __forceinline__ void compress_task(LAS unsigned char* lds, const u16* __restrict__ src  , const float* __restrict__ pos, const float* __restrict__ w1, const float* __restrict__ w2,
                                              u16* __restrict__ dst  , int grp, int tid) {
    LAS float* tok = (LAS float*)lds;
    LAS float* posL = tok + 144 * 64;
    LAS float* red = posL + 2048;
    LAS float* hid = red + 2 * 9 * 256;
    const int i0 = grp * 8, t0 = 16 * i0;
    for (int e = tid; e < 144 * 64; e += NTHREADS) { int t = t0 + (e >> 6); t = t < S ? t : S - 1; tok[e] = bf2f(src[(size_t)t * 64 + (e & 63)]); }
    for (int e = tid; e < 2048; e += NTHREADS) posL[e] = pos[e];
    __syncthreads();
    { const int n = tid & 255, kh = tid >> 8; float acc[9];
#pragma unroll
      for (int r = 0; r < 9; ++r) acc[r] = 0.f;
      for (int k = kh * 1024; k < kh * 1024 + 1024; k += 4) { const int lq = k >> 6, d = k & 63;
          const float w0 = w1[(size_t)k * 256 + n], w1_ = w1[(size_t)(k + 1) * 256 + n], w2_ = w1[(size_t)(k + 2) * 256 + n], w3 = w1[(size_t)(k + 3) * 256 + n];
#pragma unroll
          for (int r = 0; r < 8; ++r) { const v4f a = *(const LAS v4f*)(tok + (16 * r + lq) * 64 + d); acc[r] += a.x * w0 + a.y * w1_ + a.z * w2_ + a.w * w3; }
          const v4f pa = *(const LAS v4f*)(posL + k); acc[8] += pa.x * w0 + pa.y * w1_ + pa.z * w2_ + pa.w * w3; }
#pragma unroll
      for (int r = 0; r < 9; ++r) red[(kh * 9 + r) * 256 + n] = acc[r]; }
    __syncthreads();
    for (int e = tid; e < 8 * 256; e += NTHREADS) { const int r = e >> 8, n = e & 255;
        hid[e] = gelu_tanh((red[r * 256 + n] + red[(9 + r) * 256 + n]) + (red[8 * 256 + n] + red[(9 + 8) * 256 + n])); }
    __syncthreads();
    { const int r = tid >> 6, d = tid & 63; float acc = 0.f;
#pragma unroll 8
      for (int n = 0; n < 256; ++n) acc += hid[r * 256 + n] * w2[n * 64 + d];
      if (i0 + r < 1023) dst[(size_t)(i0 + r) * 64 + d] = (u16)f2bf(acc); }
    __syncthreads();
}

typedef float f32x4m __attribute__((ext_vector_type(4)));
struct NsaBufs { const u16* NQ; const u16* KC; const u16* VC; const u16* KSEL; const u16* VSELT; const float* LUTN; const float* GATE;
                 const u16* ODIL; const float* LSED; const u16* OWIN; u16* OCMP; u16* OSEL; u16* OA; };
constexpr int NSA_IMP = 49152, NSA_SEL = NSA_IMP + 65536;
__device__ __forceinline__ void nsa_unit(LAS unsigned char* lds, const NsaBufs& B, int t0, int tid) {
    const int lane = tid & 63, wid = __builtin_amdgcn_readfirstlane(tid >> 6), r32 = lane & 31, hi = lane >> 5;
    LAS unsigned* imp = (LAS unsigned*)(lds + NSA_IMP);
    LAS int* sel = (LAS int*)(lds + NSA_SEL);
    const int hrow = r32 >> 3, tq = t0 + 8 * wid + (r32 & 7), imax = tq >= 31 ? ((tq - 31) >> 4) : -1;
    const int tmaxu = t0 + 63, ntile = tmaxu >= 31 ? ((((tmaxu - 31) >> 4)) >> 6) + 1 : 0;
    const int iwmax = (t0 + 8 * wid + 7) >= 31 ? ((t0 + 8 * wid + 7 - 31) >> 4) : -1;
    bf16x8_t qf[4];
#pragma unroll
    for (int d0 = 0; d0 < 4; ++d0) qf[d0] = *(const bf16x8_t*)(B.NQ + (size_t)tq * 256 + hrow * 64 + 16 * d0 + 8 * hi);
    for (int e = tid; e < 64 * 256; e += NTHREADS) imp[e] = 0u;
    const int kc = tid >> 6, kkey = tid & 63, vdt = tid >> 8, vkey = (tid & 255) >> 2, vpart = tid & 3;
    const int kdst = kc * 1024 + kkey * 16, vdst = 12288 + vdt * 4096 + vkey * 64 + vpart * 16;
    const int kfo = hi * 1024 + r32 * 16;
    const int vfo = 12288 + (4 * hi + ((lane & 15) >> 2)) * 64 + ((lane >> 4) & 1) * 32 + (lane & 3) * 8;
    float m = -INFINITY, l = 0.f, invl = 0.f;
    v4u kreg, vreg;
#define CMP_LOAD(kt) do { kreg = *(const v4u*)(B.KC + (size_t)((kt) * 64 + kkey) * 64 + kc * 8); vreg = *(const v4u*)(B.VC + (size_t)((kt) * 64 + vkey) * 64 + vdt * 32 + vpart * 8); } while (0)
#define CMP_STORE(buf) do { LAS unsigned char* b_ = lds + (buf) * ATT_BUF; *(LAS v4u*)(b_ + kdst) = kreg; *(LAS v4u*)(b_ + vdst) = vreg; } while (0)
#define CMP_SCORES() f32x16 p0, p1; _Pragma("unroll") for (int r = 0; r < 16; ++r) { p0[r] = 0.f; p1[r] = 0.f; } \
        _Pragma("unroll") for (int d0 = 0; d0 < 4; ++d0) { const bf16x8_t k0 = *(const LAS bf16x8_t*)(bf + kfo + d0 * 2048), k1 = *(const LAS bf16x8_t*)(bf + kfo + d0 * 2048 + 512); \
            p0 = __builtin_amdgcn_mfma_f32_32x32x16_bf16(k0, qf[d0], p0, 0, 0, 0); p1 = __builtin_amdgcn_mfma_f32_32x32x16_bf16(k1, qf[d0], p1, 0, 0, 0); } \
        _Pragma("unroll") for (int r = 0; r < 16; ++r) { const int key = kbase + (r & 3) + 8 * (r >> 2) + 4 * hi; if (key > imax) p0[r] = -INFINITY; if (key + 32 > imax) p1[r] = -INFINITY; }
    if (ntile > 0) {
        f32x16 o0, o1;
#pragma unroll
        for (int r = 0; r < 16; ++r) { o0[r] = 0.f; o1[r] = 0.f; }
        CMP_LOAD(0); CMP_STORE(0);
        __syncthreads();
        for (int kt = 0; kt < ntile; ++kt) {
            const LAS unsigned char* bf = lds + (kt & 1) * ATT_BUF;
            if (kt + 1 < ntile) CMP_LOAD(kt + 1);
            const int kbase = 64 * kt;
            if (kbase <= iwmax) {
                CMP_SCORES();
                float mx = fmaxf(p0[0], p1[0]);
#pragma unroll
                for (int r = 1; r < 16; ++r) mx = fmaxf(mx, fmaxf(p0[r], p1[r]));
                mx = xhalf_max(mx);
                const float mn = fmaxf(m, mx), msub = (mn == -INFINITY) ? 0.f : mn, alpha = __builtin_amdgcn_exp2f(m - msub); m = mn;
                float ps = 0.f;
#pragma unroll
                for (int r = 0; r < 16; ++r) { p0[r] = __builtin_amdgcn_exp2f(p0[r] - msub); p1[r] = __builtin_amdgcn_exp2f(p1[r] - msub); ps += p0[r] + p1[r]; }
                l = l * alpha + ps;
#pragma unroll
                for (int r = 0; r < 16; ++r) { o0[r] *= alpha; o1[r] *= alpha; }
                bf16x8_t pw[4];
#pragma unroll
                for (int ks = 0; ks < 4; ++ks) { v4u w;
                    if (ks < 2) { w.x = pk2(p0[8 * ks], p0[8 * ks + 1]); w.y = pk2(p0[8 * ks + 2], p0[8 * ks + 3]); w.z = pk2(p0[8 * ks + 4], p0[8 * ks + 5]); w.w = pk2(p0[8 * ks + 6], p0[8 * ks + 7]); }
                    else { const int k2 = ks - 2; w.x = pk2(p1[8 * k2], p1[8 * k2 + 1]); w.y = pk2(p1[8 * k2 + 2], p1[8 * k2 + 3]); w.z = pk2(p1[8 * k2 + 4], p1[8 * k2 + 5]); w.w = pk2(p1[8 * k2 + 6], p1[8 * k2 + 7]); }
                    pw[ks] = __builtin_bit_cast(bf16x8_t, w); }
#pragma unroll
                for (int ks = 0; ks < 4; ++ks) {
#pragma unroll
                    for (int dt = 0; dt < 2; ++dt) { const s16x4_t a = lds_tr16(bf + vfo + dt * 4096 + ks * 1024), b = lds_tr16(bf + vfo + dt * 4096 + ks * 1024 + 512);
                        bf16x8_t vf; vf[0] = a[0]; vf[1] = a[1]; vf[2] = a[2]; vf[3] = a[3]; vf[4] = b[0]; vf[5] = b[1]; vf[6] = b[2]; vf[7] = b[3];
                        if (dt == 0) o0 = __builtin_amdgcn_mfma_f32_32x32x16_bf16(vf, pw[ks], o0, 0, 0, 0); else o1 = __builtin_amdgcn_mfma_f32_32x32x16_bf16(vf, pw[ks], o1, 0, 0, 0); } }
            }
            if (kt + 1 < ntile) CMP_STORE((kt + 1) & 1);
            __syncthreads();
        }
        const float lt = xhalf_sum(l); invl = lt > 0.f ? 1.f / lt : 0.f;
        { u16* orow = B.OCMP + (size_t)tq * 256 + hrow * 64;
#pragma unroll
          for (int a4 = 0; a4 < 4; ++a4) { v2u w0, w1; w0.x = pk2(o0[4 * a4] * invl, o0[4 * a4 + 1] * invl); w0.y = pk2(o0[4 * a4 + 2] * invl, o0[4 * a4 + 3] * invl);
              w1.x = pk2(o1[4 * a4] * invl, o1[4 * a4 + 1] * invl); w1.y = pk2(o1[4 * a4 + 2] * invl, o1[4 * a4 + 3] * invl);
              *(v2u*)(orow + 8 * a4 + 4 * hi) = w0; *(v2u*)(orow + 32 + 8 * a4 + 4 * hi) = w1; } }
        const float msub2 = (m == -INFINITY) ? 0.f : m;
        LAS unsigned* impq = imp + (8 * wid + (r32 & 7)) * 256;
        CMP_LOAD(0); CMP_STORE(0);
        __syncthreads();
        for (int kt = 0; kt < ntile; ++kt) {
            const LAS unsigned char* bf = lds + (kt & 1) * ATT_BUF;
            if (kt + 1 < ntile) CMP_LOAD(kt + 1);
            const int kbase = 64 * kt;
            if (kbase <= iwmax) {
                CMP_SCORES();
#pragma unroll
                for (int r = 0; r < 16; ++r) { p0[r] = __builtin_amdgcn_exp2f(p0[r] - msub2) * invl; p1[r] = __builtin_amdgcn_exp2f(p1[r] - msub2) * invl; }
#pragma unroll
                for (int a4 = 0; a4 < 4; ++a4) {
                    { const int jg = (kbase >> 2) + 2 * a4 + hi; const float g = (p0[4 * a4] + p0[4 * a4 + 1]) + (p0[4 * a4 + 2] + p0[4 * a4 + 3]);
                      __hip_atomic_fetch_add(impq + jg, (unsigned)(g * 67108864.f + 0.5f), __ATOMIC_RELAXED, __HIP_MEMORY_SCOPE_WORKGROUP);
                      if (jg + 1 < 256) __hip_atomic_fetch_add(impq + jg + 1, (unsigned)(p0[4 * a4 + 3] * 67108864.f + 0.5f), __ATOMIC_RELAXED, __HIP_MEMORY_SCOPE_WORKGROUP); }
                    { const int jg = (kbase >> 2) + 8 + 2 * a4 + hi; const float g = (p1[4 * a4] + p1[4 * a4 + 1]) + (p1[4 * a4 + 2] + p1[4 * a4 + 3]);
                      __hip_atomic_fetch_add(impq + jg, (unsigned)(g * 67108864.f + 0.5f), __ATOMIC_RELAXED, __HIP_MEMORY_SCOPE_WORKGROUP);
                      if (jg + 1 < 256) __hip_atomic_fetch_add(impq + jg + 1, (unsigned)(p1[4 * a4 + 3] * 67108864.f + 0.5f), __ATOMIC_RELAXED, __HIP_MEMORY_SCOPE_WORKGROUP); } }
            }
            if (kt + 1 < ntile) CMP_STORE((kt + 1) & 1);
            __syncthreads();
        }
    } else {
        u16* orow = B.OCMP + (size_t)tq * 256 + hrow * 64;
#pragma unroll
        for (int a4 = 0; a4 < 4; ++a4) { *(v2u*)(orow + 8 * a4 + 4 * hi) = (v2u){0u, 0u}; *(v2u*)(orow + 32 + 8 * a4 + 4 * hi) = (v2u){0u, 0u}; }
        __syncthreads();
    }
#undef CMP_LOAD
#undef CMP_STORE
#undef CMP_SCORES
    LAS float* lutL = (LAS float*)lds;
    for (int e = tid; e < 4 * 2048; e += NTHREADS) lutL[e] = B.LUTN[e];
    for (int qi = 0; qi < 8; ++qi) { const int q = 8 * wid + qi, t = t0 + q, tb = t >> 6; unsigned sc[4];
#pragma unroll
        for (int k = 0; k < 4; ++k) { const int j = lane + 64 * k; const unsigned v = imp[q * 256 + j]; const bool forced = (j == 0) || (j == tb) || (j == tb - 1);
            sc[k] = forced ? 0xFFFFFFFFu : (j <= tb ? (v < 0xFFFFFFF0u ? v : 0xFFFFFFF0u) + 2u : 1u); }
        for (int r = 0; r < 16; ++r) { unsigned bv = sc[0]; int bi = lane;
#pragma unroll
            for (int k = 1; k < 4; ++k) if (sc[k] > bv) { bv = sc[k]; bi = lane + 64 * k; }
#pragma unroll
            for (int off = 1; off < 64; off <<= 1) { const unsigned ov = (unsigned)__shfl_xor((int)bv, off); const int oi = __shfl_xor(bi, off); if (ov > bv || (ov == bv && oi < bi)) { bv = ov; bi = oi; } }
            if (lane == 0) sel[q * 16 + r] = bi;
#pragma unroll
            for (int k = 0; k < 4; ++k) if (bi == lane + 64 * k) sc[k] = 0u;
        }
    }
    __syncthreads();
    { const int col = lane & 15, kg = lane >> 4, hcol = col & 3;
      for (int qi = 0; qi < 8; ++qi) { const int q = 8 * wid + qi, t = t0 + q;
          bf16x8_t qB[2];
#pragma unroll
          for (int ks = 0; ks < 2; ++ks) qB[ks] = *(const bf16x8_t*)(B.NQ + (size_t)t * 256 + hcol * 64 + 32 * ks + 8 * kg);
          f32x4m oacc[4];
#pragma unroll
          for (int d = 0; d < 4; ++d) oacc[d] = (f32x4m){0.f, 0.f, 0.f, 0.f};
          float ms = -INFINITY, ls = 0.f;
          const LAS float* lutH = lutL + hcol * 2048; const float bfar = lutH[2047];
          for (int bi = 0; bi < 16; ++bi) { const int blk = sel[q * 16 + bi], tok0 = blk * 64;
              if (tok0 > t) continue;
              f32x4m c[4];
#pragma unroll
              for (int mt = 0; mt < 4; ++mt) { const u16* kr = B.KSEL + (size_t)(tok0 + 16 * mt + col) * 64 + 8 * kg;
                  const bf16x8_t a0 = *(const bf16x8_t*)kr, a1 = *(const bf16x8_t*)(kr + 32);
                  c[mt] = __builtin_amdgcn_mfma_f32_16x16x32_bf16(a0, qB[0], (f32x4m){0.f, 0.f, 0.f, 0.f}, 0, 0, 0);
                  c[mt] = __builtin_amdgcn_mfma_f32_16x16x32_bf16(a1, qB[1], c[mt], 0, 0, 0); }
              const int dbase = t - tok0 - 4 * kg;
              if (t - (tok0 + 63) >= 1513) {
#pragma unroll
                  for (int mt = 0; mt < 4; ++mt)
#pragma unroll
                      for (int e = 0; e < 4; ++e) c[mt][e] += bfar;
              } else {
#pragma unroll
                  for (int mt = 0; mt < 4; ++mt)
#pragma unroll
                      for (int e = 0; e < 4; ++e) { const int d = dbase - 16 * mt - e; const int dc = d < 0 ? 0 : (d > 2047 ? 2047 : d); const float b = lutH[dc]; c[mt][e] = d >= 0 ? c[mt][e] + b : -INFINITY; }
              }
              float mx = fmaxf(fmaxf(c[0][0], c[0][1]), fmaxf(c[0][2], c[0][3]));
#pragma unroll
              for (int mt = 1; mt < 4; ++mt) mx = fmaxf(mx, fmaxf(fmaxf(c[mt][0], c[mt][1]), fmaxf(c[mt][2], c[mt][3])));
              mx = fmaxf(mx, __shfl_xor(mx, 16)); mx = fmaxf(mx, __shfl_xor(mx, 32));
              const float mn = fmaxf(ms, mx), alpha = __builtin_amdgcn_exp2f(ms - mn); ms = mn;
              float ps = 0.f;
#pragma unroll
              for (int mt = 0; mt < 4; ++mt)
#pragma unroll
                  for (int e = 0; e < 4; ++e) { c[mt][e] = __builtin_amdgcn_exp2f(c[mt][e] - mn); ps += c[mt][e]; }
              ls = ls * alpha + ps;
#pragma unroll
              for (int d = 0; d < 4; ++d) oacc[d] *= alpha;
              bf16x8_t pB[2];
#pragma unroll
              for (int s2 = 0; s2 < 2; ++s2) { v4u w; w.x = pk2(c[2 * s2][0], c[2 * s2][1]); w.y = pk2(c[2 * s2][2], c[2 * s2][3]); w.z = pk2(c[2 * s2 + 1][0], c[2 * s2 + 1][1]); w.w = pk2(c[2 * s2 + 1][2], c[2 * s2 + 1][3]);
                  pB[s2] = __builtin_bit_cast(bf16x8_t, w); }
#pragma unroll
              for (int d = 0; d < 4; ++d)
#pragma unroll
                  for (int s2 = 0; s2 < 2; ++s2) { const u16* vr = B.VSELT + ((size_t)blk * 64 + 16 * d + col) * 64 + 32 * s2 + 4 * kg;
                      const v2u x0 = *(const v2u*)vr, x1 = *(const v2u*)(vr + 16); v4u w; w.x = x0.x; w.y = x0.y; w.z = x1.x; w.w = x1.y;
                      oacc[d] = __builtin_amdgcn_mfma_f32_16x16x32_bf16(__builtin_bit_cast(bf16x8_t, w), pB[s2], oacc[d], 0, 0, 0); }
          }
          ls += __shfl_xor(ls, 16); ls += __shfl_xor(ls, 32);
          const float inv = 1.f / ls;
          if (col < 4) {
#pragma unroll
              for (int d = 0; d < 4; ++d) { v2u w; w.x = pk2(oacc[d][0] * inv, oacc[d][1] * inv); w.y = pk2(oacc[d][2] * inv, oacc[d][3] * inv);
                  *(v2u*)(B.OSEL + (size_t)t * 256 + col * 64 + 16 * d + 4 * kg) = w; } }
      } }
    asm volatile("s_waitcnt vmcnt(0)" ::: "memory");
    __syncthreads();
    __builtin_amdgcn_fence(__ATOMIC_ACQUIRE, "agent");
    asm volatile("s_waitcnt vmcnt(0)" ::: "memory");
    { const int tl = tid >> 3, sub = tid & 7, t = t0 + tl;
      u16* oa = B.OA + (size_t)t * 512;
      if (sub < 4) { const int hh = sub;
          const float l0 = B.LSED[((size_t)0 * S + t) * 4 + hh], l1 = B.LSED[((size_t)1 * S + t) * 4 + hh], l2 = B.LSED[((size_t)2 * S + t) * 4 + hh];
          const float lm = fmaxf(l0, fmaxf(l1, l2)); float w0 = __builtin_amdgcn_exp2f(l0 - lm), w1 = __builtin_amdgcn_exp2f(l1 - lm), w2 = __builtin_amdgcn_exp2f(l2 - lm);
          const float ws = 1.f / (w0 + w1 + w2); w0 *= ws; w1 *= ws; w2 *= ws;
          const u16* s0 = B.ODIL + ((size_t)0 * S + t) * 256 + hh * 64; const u16* s1 = B.ODIL + ((size_t)1 * S + t) * 256 + hh * 64; const u16* s2 = B.ODIL + ((size_t)2 * S + t) * 256 + hh * 64;
#pragma unroll
          for (int i = 0; i < 8; ++i) { const v4u a = *(const v4u*)(s0 + 8 * i), b = *(const v4u*)(s1 + 8 * i), c = *(const v4u*)(s2 + 8 * i); v4u o;
              o.x = pk2(w0 * bflo(a.x) + w1 * bflo(b.x) + w2 * bflo(c.x), w0 * bfhi(a.x) + w1 * bfhi(b.x) + w2 * bfhi(c.x));
              o.y = pk2(w0 * bflo(a.y) + w1 * bflo(b.y) + w2 * bflo(c.y), w0 * bfhi(a.y) + w1 * bfhi(b.y) + w2 * bfhi(c.y));
              o.z = pk2(w0 * bflo(a.z) + w1 * bflo(b.z) + w2 * bflo(c.z), w0 * bfhi(a.z) + w1 * bfhi(b.z) + w2 * bfhi(c.z));
              o.w = pk2(w0 * bflo(a.w) + w1 * bflo(b.w) + w2 * bflo(c.w), w0 * bfhi(a.w) + w1 * bfhi(b.w) + w2 * bfhi(c.w));
              *(v4u*)(oa + hh * 64 + 8 * i) = o; }
      } else { const int hh = sub - 4; const float* gp = B.GATE + (size_t)t * 16 + hh * 3; const float g0 = gp[0], g1 = gp[1], g2 = gp[2];
          const u16* s0 = B.OCMP + (size_t)t * 256 + hh * 64; const u16* s1 = B.OSEL + (size_t)t * 256 + hh * 64; const u16* s2 = B.OWIN + (size_t)t * 256 + hh * 64;
#pragma unroll
          for (int i = 0; i < 8; ++i) { const v4u a = *(const v4u*)(s0 + 8 * i), b = *(const v4u*)(s1 + 8 * i), c = *(const v4u*)(s2 + 8 * i); v4u o;
              o.x = pk2(g0 * bflo(a.x) + g1 * bflo(b.x) + g2 * bflo(c.x), g0 * bfhi(a.x) + g1 * bfhi(b.x) + g2 * bfhi(c.x));
              o.y = pk2(g0 * bflo(a.y) + g1 * bflo(b.y) + g2 * bflo(c.y), g0 * bfhi(a.y) + g1 * bfhi(b.y) + g2 * bfhi(c.y));
              o.z = pk2(g0 * bflo(a.z) + g1 * bflo(b.z) + g2 * bflo(c.z), g0 * bfhi(a.z) + g1 * bfhi(b.z) + g2 * bfhi(c.z));
              o.w = pk2(g0 * bflo(a.w) + g1 * bflo(b.w) + g2 * bflo(c.w), g0 * bfhi(a.w) + g1 * bfhi(b.w) + g2 * bfhi(c.w));
              *(v4u*)(oa + 256 + hh * 64 + 8 * i) = o; }
      } }
    __syncthreads();
}

struct Args { const void* in[28]; float* out; unsigned char* ws; int ph_lo, ph_hi; };
typedef const __attribute__((address_space(4))) Args* KArgP;
__device__ __forceinline__ KArgP kargs() { KArgP p = (KArgP)__builtin_amdgcn_kernarg_segment_ptr(); asm volatile("" : "+s"(p)); return p; }
#define WSP(T, off) ((T*)(ws + (off)))
#define INP(k) ((const float*)ap->in[k])

#define IN(k) (kargs()->ph_lo <= (k) && (k) < kargs()->ph_hi)
#define SEAM(k) do { if (IN((k) + 1)) { XcdBarrier b_; b_.bar = (unsigned*)(kargs()->ws + WS_CTL) + CW_BAR; b_.x = xb_xcc_id(); b_.st = (volatile LAS unsigned*)(lds + MISC_OFF) + 8; xcd_barrier(b_); } } while (0)
#define PHASE_IDS() int tid_l = threadIdx.x, bid_l = blockIdx.x, G_l = gridDim.x; asm volatile("" : "+v"(tid_l), "+s"(bid_l), "+s"(G_l)); \
    const int tid = tid_l, bid = bid_l, G = G_l, NGW = G * NWAVES, lane = tid & 63, wave = __builtin_amdgcn_readfirstlane(tid >> 6), gw = bid * NWAVES + wave; (void)NGW; \
    LAS float* wscr = (LAS float*)(lds + wave * 16384); (void)wscr; (void)gw; (void)lane; (void)tid
#define GEMM_IDS() int bid_l = blockIdx.x, G_l = gridDim.x; asm volatile("" : "+s"(bid_l), "+s"(G_l)); const int bid = bid_l, G = G_l


template <int li> __device__ __forceinline__ void layer_body(LAS unsigned char* lds) {
    constexpr int pb = 1 + li * 12, lj = li >> 1; constexpr bool even = (li & 1) == 0;
    constexpr size_t HBC = (li & 1) ? WS_HB2 : WS_HB, HBN = (li & 1) ? WS_HB : WS_HB2;
        if (IN(pb + 0)) {
            KArgP ap = kargs(); unsigned char* ws = ap->ws; PHASE_IDS();
            u16* W_in = WSP(u16, WS_W + W_IN); u16* W_out = WSP(u16, WS_W + W_OUT);
            int cursor = 0; const int gt = bid * NTHREADS + tid, NGT = G * NTHREADS;
            const float* g_pre = INP(19) + (size_t)li * DM;
            if (even) {
                const float* W = INP(4) + (size_t)lj * DM * EV_IN;
                ap = kargs(); cvt_job(W, EV_IN, DM, 0, 256, g_pre, W_in, 0, cursor, wscr, gw, NGW, lane);
                ap = kargs(); cvt_job(W, EV_IN, DM, 256, 128, g_pre, W_in, 256, cursor, wscr, gw, NGW, lane);
                ap = kargs(); cvt_job(W, EV_IN, DM, 384, 32, g_pre, W_in, 384, cursor, wscr, gw, NGW, lane);
                ap = kargs(); cvt_job(W, EV_IN, DM, 1952, 8, g_pre, W_in, 416, cursor, wscr, gw, NGW, lane);
                ap = kargs(); cvt_job(W, EV_IN, DM, 416, 512, g_pre, W_in, 512, cursor, wscr, gw, NGW, lane);
                ap = kargs(); cvt_job(W, EV_IN, DM, 928, 512, g_pre, W_in, 1024, cursor, wscr, gw, NGW, lane);
                ap = kargs(); cvt_job(W, EV_IN, DM, 1440, 512, g_pre, W_in, 1536, cursor, wscr, gw, NGW, lane);
                for (int idx = gt; idx < (512 - 424) * DM / 8; idx += NGT) ((v4u*)(W_in + (size_t)424 * DM))[idx] = (v4u){0u, 0u, 0u, 0u};
                ap = kargs(); cvt_job(INP(10) + (size_t)lj * DM * DM, DM, DM, 0, DM, nullptr, W_out, 0, cursor, wscr, gw, NGW, lane);
                u16* W_uq = WSP(u16, WS_W + W_UQ); u16* W_ukv = WSP(u16, WS_W + W_UKV);
                const float* wuq = INP(6) + (size_t)lj * 256 * 768; const float* qn = INP(5) + lj * 256;
                for (int idx = gt; idx < 768 * 256; idx += NGT) { const int n = idx >> 8, k = idx & 255; int col;
                    if (n < 512) col = (n >> 6) * 96 + (n & 63); else { const int r = n - 512, hh = r >> 5, grp = (r & 31) >> 3, e = r & 7; col = hh * 96 + 64 + (e < 4 ? 4 * grp + e : 16 + 4 * grp + e - 4); }
                    W_uq[idx] = (u16)f2bf(wuq[(size_t)k * 768 + col] * qn[k]); }
                const float* wukv = INP(8) + (size_t)lj * 128 * 1024; const float* kvn = INP(7) + lj * 128;
                for (int idx = gt; idx < 1024 * 128; idx += NGT) { const int n = idx >> 7, k = idx & 127; int col;
                    if (n < 512) col = (n >> 6) * 128 + (n & 63); else { const int r = n - 512; col = (r >> 6) * 128 + 64 + (r & 63); }
                    W_ukv[idx] = (u16)f2bf(wukv[(size_t)k * 1024 + col] * kvn[k]); }
            } else {
                const float* W = INP(11) + (size_t)lj * DM * OD_IN;
                ap = kargs(); cvt_job(W, OD_IN, DM, 0, OD_IN, g_pre, W_in, 0, cursor, wscr, gw, NGW, lane);
                for (int idx = gt; idx < (3072 - OD_IN) * DM / 8; idx += NGT) ((v4u*)(W_in + (size_t)OD_IN * DM))[idx] = (v4u){0u, 0u, 0u, 0u};
                ap = kargs(); cvt_job(INP(18) + (size_t)lj * 512 * DM, DM, 512, 0, DM, nullptr, W_out, 0, cursor, wscr, gw, NGW, lane);
            }
            ap = kargs(); cvt_job(INP(23) + (size_t)li * DM * DFF, DFF, DM, 0, DFF, INP(21) + (size_t)li * DM, WSP(u16, WS_W + W_UP), 0, cursor, wscr, gw, NGW, lane);
            ap = kargs(); cvt_job(INP(24) + (size_t)li * DFF * DM, DM, DFF, 0, DM, nullptr, WSP(u16, WS_W + W_DN), 0, cursor, wscr, gw, NGW, lane);
            ap = kargs(); cvt_job(INP(26) + (size_t)li * DM * DM, DM, DM, 0, DM, INP(25) + (size_t)li * DM, WSP(u16, WS_W + W_PG), 0, cursor, wscr, gw, NGW, lane);
            ap = kargs(); cvt_job(INP(27) + (size_t)li * PLE * DM, DM, PLE, 0, DM, nullptr, WSP(u16, WS_W + W_PP), 0, cursor, wscr, gw, NGW, lane);
            const v4f* ps = (const v4f*)(INP(1) + (size_t)li * S * PLE); v2u* PB2 = WSP(v2u, WS_PB);
            for (int idx = gt; idx < S * PLE / 4; idx += NGT) { const v4f v = ps[idx]; v2u w; w.x = pk2(v.x, v.y); w.y = pk2(v.z, v.w); PB2[idx] = w; }
            SEAM(pb + 0);
        }
        if (even) {
            if (IN(pb + 1)) {
                KArgP ap = kargs(); unsigned char* ws = ap->ws; GEMM_IDS();
                pg8::Gemm g{WSP(u16, HBC), WSP(u16, WS_W + W_IN), S, 2048, DM}; pg8::StaticOrder So; So.init(S, 2048, G, bid);
                EpiEvenIn E{WSP(float, WS_MIX), WSP(u16, WS_A + A_FQ), li == 0 ? WSP(float, WS_LUT + OFF_RSA) : WSP(float, WS_RSP), li != 0};
                pg8::gemm_phase<EpiEvenIn, pg8::StaticOrder, true, true>(lds, g, So, E);
                SEAM(pb + 1);
            }
            if (IN(pb + 2)) {
                KArgP ap = kargs(); unsigned char* ws = ap->ws; PHASE_IDS();
                const float* CQKV = WSP(float, WS_MIX); const float* CS = WSP(float, WS_CS); u16* CQN = WSP(u16, WS_A + A_CQN); u16* CKVN = WSP(u16, WS_A + A_CKVN); u16* KM = WSP(u16, WS_A + A_KM);
                float* LOGF = WSP(float, WS_LUT + OFF_LOGF); float* CT = WSP(float, WS_LUT + OFF_CT);
                const float* fb = INP(9) + lj * 8;
                LAS float* lf = (LAS float*)(lds + 131072 - 4096);
                for (int c = bid; c < S / 64; c += G) {
                    for (int jr = 0; jr < 8; ++jr) { const int rl = wave * 8 + jr, t = c * 64 + rl; const float* cr = CQKV + (size_t)t * 512;
                        { const v4f v = *((const v4f*)cr + lane); const float ss = wave_sum(v.x * v.x + v.y * v.y + v.z * v.z + v.w * v.w); const float r = rsqrtf(ss * (1.f / 256) + RMS_EPS);
                          v2u w; w.x = pk2(v.x * r, v.y * r); w.y = pk2(v.z * r, v.w * r); *((v2u*)(CQN + (size_t)t * 256) + lane) = w; }
                        { const v2f v = *((const v2f*)(cr + 256) + lane); const float ss = wave_sum(v.x * v.x + v.y * v.y); const float r = rsqrtf(ss * (1.f / 128) + RMS_EPS);
                          *((unsigned*)(CKVN + (size_t)t * 128) + lane) = pk2(v.x * r, v.y * r); }
                        if (lane < 16) { const float x1 = cr[384 + lane], x2 = cr[400 + lane], cs = CS[(size_t)t * 32 + lane], sn = CS[(size_t)t * 32 + 16 + lane];
                            const u16 o1 = (u16)f2bf(x1 * cs - x2 * sn), o2 = (u16)f2bf(x2 * cs + x1 * sn);
#pragma unroll
                            for (int hh = 0; hh < 8; ++hh) { KM[(size_t)t * 768 + hh * 96 + 64 + lane] = o1; KM[(size_t)t * 768 + hh * 96 + 80 + lane] = o2; } }
                        if (lane < 8) { const float z = cr[416 + lane] + fb[lane]; lf[rl * 8 + lane] = fminf(z, 0.f) - log1pf(__expf(-fabsf(z))); } }
                    __syncthreads();
                    if (tid < 8) { float acc = 0.f; for (int r = 0; r < 64; ++r) { acc += lf[r * 8 + tid]; LOGF[(size_t)(c * 64 + r) * 8 + tid] = acc; } CT[c * 8 + tid] = acc; }
                    __syncthreads();
                }
                SEAM(pb + 2);
            }
            if (IN(pb + 3)) {
                { KArgP ap = kargs(); unsigned char* ws = ap->ws; PHASE_IDS();
                  const float* LOGF = WSP(float, WS_LUT + OFF_LOGF); const float* CT = WSP(float, WS_LUT + OFF_CT); float* CUM = WSP(float, WS_A + A_CUM);
                  for (int c = bid; c < S / 64; c += G) {
                      if (wave == 0) { float pre = 0.f; const int hh = lane & 7;
                          for (int cc = lane >> 3; cc < c; cc += 8) pre += CT[cc * 8 + hh];
                          pre += __shfl_xor(pre, 8); pre += __shfl_xor(pre, 16); pre += __shfl_xor(pre, 32);
                          for (int r = lane >> 3; r < 64; r += 8) { const size_t o = (size_t)(c * 64 + r) * 8 + hh; CUM[o] = LOGF[o] + pre; } }
                  } }
                { KArgP ap = kargs(); unsigned char* ws = ap->ws; GEMM_IDS();
                  pg8::Gemm g{WSP(u16, WS_A + A_CKVN), WSP(u16, WS_W + W_UKV), S, 1024, 128}; pg8::StaticOrder So; So.init(S, 1024, G, bid); EpiUkv E{WSP(u16, WS_A + A_KM), WSP(u16, WS_A + A_VM)};
                  pg8::gemm_phase<EpiUkv, pg8::StaticOrder, true, true>(lds, g, So, E); }
                { KArgP ap = kargs(); unsigned char* ws = ap->ws; GEMM_IDS();
                  pg8::Gemm g{WSP(u16, WS_A + A_CQN), WSP(u16, WS_W + W_UQ), S, 768, 256}; pg8::StaticOrder So; So.init(S, 768, G, bid); EpiUq E{WSP(u16, WS_A + A_QM), WSP(float, WS_CS)};
                  pg8::gemm_phase<EpiUq, pg8::StaticOrder, true, true>(lds, g, So, E); }
                SEAM(pb + 3);
            }
            if (IN(pb + 4)) {
                KArgP ap = kargs(); unsigned char* ws = ap->ws; PHASE_IDS();
                const u16* FQ = WSP(u16, WS_A + A_FQ); const u16* FK = WSP(u16, WS_A + A_FK); const u16* FV = WSP(u16, WS_A + A_FV);
                const u16* QM = WSP(u16, WS_A + A_QM); const u16* KM = WSP(u16, WS_A + A_KM); const u16* VM = WSP(u16, WS_A + A_VM); u16* OA = WSP(u16, WS_A + A_OA); const float* CUM = WSP(float, WS_A + A_CUM);
                for (int pid = bid; pid < 256; pid += G) { const int hh = pid & 7, pr = pid >> 3;
                    for (int sub = 0; sub < 2; ++sub) { const int qb = sub ? 63 - pr : pr;
                        attn_unit<96, false>(lds, QM + hh * 96, 768, KM + hh * 96, 768, VM + hh * 64, 512, OA + hh * 64, DM, qb, nullptr, tid);
                        attn_unit<64, true>(lds, FQ + hh * 64, 512, FK + hh * 64, 512, FV + hh * 64, 512, OA + 512 + hh * 64, DM, qb, CUM + hh, tid); } }
                SEAM(pb + 4);
            }
            if (IN(pb + 5)) {
                KArgP ap = kargs(); unsigned char* ws = ap->ws; GEMM_IDS();
                pg8::Gemm g{WSP(u16, WS_A + A_OA), WSP(u16, WS_W + W_OUT), S, DM, DM}; pg8::StaticOrder So; So.init(S, DM, G, bid); EpiF32 E{WSP(float, WS_MIX), DM};
                pg8::gemm_phase<EpiF32, pg8::StaticOrder, true, true>(lds, g, So, E);
                SEAM(pb + 5);
            }
        } else {
            if (IN(pb + 1)) {
                KArgP ap = kargs(); unsigned char* ws = ap->ws; GEMM_IDS();
                pg8::Gemm g{WSP(u16, HBC), WSP(u16, WS_W + W_IN), S, 3072, DM}; pg8::StaticOrder So; So.init(S, 3072, G, bid);
                EpiOddIn E{WSP(u16, WS_A + A_DQ), WSP(u16, WS_A + A_NQ), WSP(u16, WS_A + A_SM1), WSP(u16, WS_A + A_SM2), WSP(float, WS_A + A_GATE), WSP(float, WS_RSP), true};
                pg8::gemm_phase<EpiOddIn, pg8::StaticOrder, true, true>(lds, g, So, E);
                SEAM(pb + 1);
            }
            if (IN(pb + 2)) {
                KArgP ap = kargs(); unsigned char* ws = ap->ws; PHASE_IDS();
                for (int task = bid; task < 256; task += G) { const int c = task >> 7, grp = task & 127;
                    compress_task(lds, WSP(u16, WS_A + A_SM1) + (size_t)c * ((size_t)S * 64), INP(c ? 13 : 12) + (size_t)lj * 2048, INP(c ? 16 : 14) + (size_t)lj * 2048 * 256, INP(c ? 17 : 15) + (size_t)lj * 256 * 64,
                                  c ? WSP(u16, WS_A + A_VC) : WSP(u16, WS_A + A_KC), grp, tid); }
                const u16* DQ = WSP(u16, WS_A + A_DQ); const u16* DK = WSP(u16, WS_A + A_DK); const u16* DV = WSP(u16, WS_A + A_DV); const u16* NQ = WSP(u16, WS_A + A_NQ); const u16* SM2 = WSP(u16, WS_A + A_SM2);
                u16* ODIL = WSP(u16, WS_A + A_ODIL); float* LSED = WSP(float, WS_A + A_LSED); u16* OWIN = WSP(u16, WS_A + A_OWIN);
                const float* LUTN = WSP(float, WS_LUT + LUT_N); const float* LUTD = WSP(float, WS_LUT + LUT_D);
                for (int u = bid; u < 1024; u += G) {
                    if (u < 768) { const int g = u >> 8, rem = u & 255, hh = rem >> 6, r = rem & 63, dsh = 2 * g, d = 1 << dsh, rho = r & (d - 1), qb = r >> dsh;
                        win_unit(lds, DQ + g * 256 + hh * 64, 768, DK + g * 256 + hh * 64, 768, DV + g * 256 + hh * 64, 768, rho, d, 129, LUTD + (g * 4 + hh) * 132, qb,
                                 ODIL + (size_t)g * ((size_t)S * 256) + hh * 64, 256, LSED + (size_t)g * ((size_t)S * 4) + hh, 4, tid); }
                    else { const int hh = (u - 768) >> 6, qb = (u - 768) & 63;
                        win_unit(lds, NQ + hh * 64, 256, SM2, 256, SM2 + 64, 256, 0, 1, 512, LUTN + hh * 2048, qb, OWIN + hh * 64, 256, nullptr, 0, tid); } }
                SEAM(pb + 2);
            }
            if (IN(pb + 3)) { SEAM(pb + 3); }
            if (IN(pb + 4)) {
                KArgP ap = kargs(); unsigned char* ws = ap->ws; PHASE_IDS();
                NsaBufs B{WSP(u16, WS_A + A_NQ), WSP(u16, WS_A + A_KC), WSP(u16, WS_A + A_VC), WSP(u16, WS_A + A_SM1) + (size_t)2 * ((size_t)S * 64), WSP(u16, WS_A + A_SM1) + (size_t)3 * ((size_t)S * 64),
                          WSP(float, WS_LUT + LUT_N), WSP(float, WS_A + A_GATE), WSP(u16, WS_A + A_ODIL), WSP(float, WS_A + A_LSED), WSP(u16, WS_A + A_OWIN), WSP(u16, WS_A + A_OCMP), WSP(u16, WS_A + A_OSEL), WSP(u16, WS_A + A_OA)};
                for (int u = bid; u < S / 64; u += G) nsa_unit(lds, B, u * 64, tid);
                SEAM(pb + 4);
            }
            if (IN(pb + 5)) {
                KArgP ap = kargs(); unsigned char* ws = ap->ws; GEMM_IDS();
                pg8::Gemm g{WSP(u16, WS_A + A_OA), WSP(u16, WS_W + W_OUT), S, DM, 512}; pg8::StaticOrder So; So.init(S, DM, G, bid); EpiF32 E{WSP(float, WS_MIX), DM};
                pg8::gemm_phase<EpiF32, pg8::StaticOrder, true, true>(lds, g, So, E);
                SEAM(pb + 5);
            }
        }
        if (IN(pb + 6)) {
            KArgP ap = kargs(); unsigned char* ws = ap->ws; PHASE_IDS();
            const float* gpost = INP(20) + (size_t)li * DM; float* H = ap->out;
            for (int row = gw; row < S; row += NGW) finalize_row(H, WSP(float, WS_MIX), gpost, WSP(u16, HBC), WSP(float, WS_LUT + OFF_RSA), row, lane);
            SEAM(pb + 6);
        }
        if (IN(pb + 7)) {
            KArgP ap = kargs(); unsigned char* ws = ap->ws; GEMM_IDS();
            pg8::Gemm g{WSP(u16, HBC), WSP(u16, WS_W + W_UP), S, DFF, DM}; pg8::StaticOrder So; So.init(S, DFF, G, bid); EpiUp E{WSP(u16, WS_A), WSP(float, WS_LUT + OFF_RSA)};
            pg8::gemm_phase<EpiUp, pg8::StaticOrder, true, true>(lds, g, So, E);
            SEAM(pb + 7);
        }
        if (IN(pb + 8)) {
            KArgP ap = kargs(); unsigned char* ws = ap->ws; GEMM_IDS();
            pg8::Gemm g{WSP(u16, WS_A), WSP(u16, WS_W + W_DN), S, DM, DFF}; pg8::StaticOrder So; So.init(S, DM, G, bid); EpiF32 E{WSP(float, WS_MIX), DM};
            pg8::gemm_phase<EpiF32, pg8::StaticOrder, true, true>(lds, g, So, E);
            SEAM(pb + 8);
        }
        if (IN(pb + 9)) {
            KArgP ap = kargs(); unsigned char* ws = ap->ws; PHASE_IDS();
            const float* gpost = INP(22) + (size_t)li * DM; float* H = ap->out;
            for (int row = gw; row < S; row += NGW) finalize_row(H, WSP(float, WS_MIX), gpost, WSP(u16, HBC), WSP(float, WS_LUT + OFF_RSA), row, lane);
            SEAM(pb + 9);
        }
        if (IN(pb + 10)) {
            KArgP ap = kargs(); unsigned char* ws = ap->ws; GEMM_IDS();
            pg8::Gemm g{WSP(u16, WS_PB), WSP(u16, WS_W + W_PP), S, DM, PLE}; pg8::StaticOrder So; So.init(S, DM, G, bid); EpiF32 E{WSP(float, WS_MIX), DM};
            pg8::gemm_phase<EpiF32, pg8::StaticOrder, true, true>(lds, g, So, E);
            SEAM(pb + 10);
        }
        if (IN(pb + 11)) {
            KArgP ap = kargs(); unsigned char* ws = ap->ws; GEMM_IDS();
            pg8::Gemm g{WSP(u16, HBC), WSP(u16, WS_W + W_PG), S, DM, DM}; pg8::StaticOrder So; So.init(S, DM, G, bid);
            EpiPleG E{ap->out, WSP(u16, HBN), WSP(float, WS_MIX), WSP(float, WS_LUT + OFF_RSA), WSP(float, WS_RSP)};
            pg8::gemm_phase<EpiPleG, pg8::StaticOrder, true, true>(lds, g, So, E);
            SEAM(pb + 11);
        }
    }

__global__ void __launch_bounds__(NTHREADS, 2) fwd(Args a) {
    extern __shared__ __attribute__((aligned(16))) unsigned char lds_raw[];
    LAS unsigned char* lds = (LAS unsigned char*)lds_raw;
    volatile LAS unsigned* MISC = (volatile LAS unsigned*)(lds + MISC_OFF);
    for (int u = threadIdx.x; u < (LDS_BYTES - RING_BYTES) / 4; u += NTHREADS) ((LAS unsigned*)(lds + RING_BYTES))[u] = 0u;
    __syncthreads();
    (void)xcd_barrier_post((unsigned*)(a.ws + WS_CTL) + CW_BAR, MISC + 8);
    if (IN(0)) {
        KArgP ap = kargs(); unsigned char* ws = ap->ws; PHASE_IDS();
        const float* x = INP(0); const int* positions = (const int*)ap->in[2]; const float* t5 = INP(3);
        float* H = ap->out; float* CS = WSP(float, WS_CS); float* LUTN = WSP(float, WS_LUT + LUT_N); float* LUTD = WSP(float, WS_LUT + LUT_D); float* RSA = WSP(float, WS_LUT + OFF_RSA); u16* HB = WSP(u16, WS_HB);
        const int gt = bid * NTHREADS + tid, NGT = G * NTHREADS;
        for (int idx = gt; idx < S * 16; idx += NGT) { const int t = idx >> 4, i = idx & 15;
            const float invf = (float)pow(10000.0, -(double)i / 16.0); const float ang = (float)positions[t] * invf;
            CS[(size_t)t * 32 + i] = (float)cos((double)ang); CS[(size_t)t * 32 + 16 + i] = (float)sin((double)ang); }
        for (int idx = gt; idx < 4 * 2048; idx += NGT) { const int h = idx >> 11, n = idx & 2047; LUTN[idx] = t5[t5_bucket(n) * 16 + 12 + h] * LOG2E; }
        for (int idx = gt; idx < 12 * 132; idx += NGT) { const int gh = idx / 132, j = idx % 132, g = gh >> 2; const int d = g == 0 ? 1 : (g == 1 ? 4 : 16);
            LUTD[idx] = j <= 128 ? t5[t5_bucket(d * j) * 16 + gh] * LOG2E : 0.f; }
        for (int row = gw; row < S; row += NGW) { const v4f* xr = (const v4f*)(x + (size_t)row * DM) + lane; v4f* hr = (v4f*)(H + (size_t)row * DM) + lane; v2u* o8 = (v2u*)(HB + (size_t)row * DM) + lane; float ss = 0.f;
#pragma unroll
            for (int j = 0; j < 4; ++j) { const v4f v = xr[64 * j]; hr[64 * j] = v; ss += v.x * v.x + v.y * v.y + v.z * v.z + v.w * v.w; v2u w; w.x = pk2(v.x, v.y); w.y = pk2(v.z, v.w); o8[64 * j] = w; }
            ss = wave_sum(ss); if (lane == 0) RSA[row] = ss; }
        SEAM(0);
    }

    layer_body<0>(lds); layer_body<1>(lds); layer_body<2>(lds); layer_body<3>(lds);
}

constexpr int N_PHASES = 1 + 12 * DEPTH;
#ifndef MK_PER_PHASE
#define MK_PER_PHASE 0
#endif
extern "C" void kernel_launch(void* const* d_in, const int* in_sizes, int n_in, void* d_out, int out_size, void* d_ws, size_t ws_size, hipStream_t stream) {
    static int grid = 0;
    if (grid == 0) {
        if (n_in != 28 || out_size != S * DM || ws_size < WS_END) { fprintf(stderr, "kernel_launch: unexpected shapes (n_in %d out %d ws %zu, need %zu)\n", n_in, out_size, ws_size, (size_t)WS_END); grid = -1; return; }
        int dev = 0, cus = 0;
        if (hipGetDevice(&dev) != hipSuccess || hipDeviceGetAttribute(&cus, hipDeviceAttributeMultiprocessorCount, dev) != hipSuccess) { grid = -1; return; }
        if (hipFuncSetAttribute((const void*)fwd, hipFuncAttributeMaxDynamicSharedMemorySize, LDS_BYTES) != hipSuccess) { fprintf(stderr, "kernel_launch: hipFuncSetAttribute failed\n"); grid = -1; return; }
        int per_cu = 0;
        if (hipOccupancyMaxActiveBlocksPerMultiprocessor(&per_cu, (const void*)fwd, NTHREADS, LDS_BYTES) != hipSuccess || per_cu < 1) fprintf(stderr, "kernel_launch: occupancy query reports %d\n", per_cu);
        (void)hipGetLastError();
        grid = cus;
    }
    if (grid < 0) return;
    (void)hipMemsetAsync((char*)d_ws + WS_CTL, 0, CTL_ZERO_BYTES, stream);
    Args a{};
    for (int i = 0; i < 28; ++i) a.in[i] = d_in[i];
    a.out = (float*)d_out; a.ws = (unsigned char*)d_ws;
#if MK_PER_PHASE
    for (int ph = 0; ph < N_PHASES; ++ph) { a.ph_lo = ph; a.ph_hi = ph + 1; hipLaunchKernelGGL(fwd, dim3(grid), dim3(NTHREADS), LDS_BYTES, stream, a); }
#else
    a.ph_lo = 0; a.ph_hi = N_PHASES;
    hipLaunchKernelGGL(fwd, dim3(grid), dim3(NTHREADS), LDS_BYTES, stream, a);
#endif
}
```

```cpp
#include <hip/hip_runtime.h>
#include <cstdio>
#include <cstdint>

#define GAS __attribute__((address_space(1)))
#define LAS __attribute__((address_space(3)))
typedef unsigned short u16;
typedef unsigned v4u __attribute__((ext_vector_type(4)));
typedef unsigned v2u __attribute__((ext_vector_type(2)));
typedef float v4f __attribute__((ext_vector_type(4)));
typedef float v2f __attribute__((ext_vector_type(2)));

constexpr int S = 16384, DM = 1024, DFF = 4096, PLE = 256, DEPTH = 4;
constexpr int NWAVES = 8, NTHREADS = 512;
constexpr int EV_IN = 1960, OD_IN = 2956;
constexpr float RMS_EPS = 1e-6f, LOG2E = 1.4426950408889634f;
constexpr float QS64 = 0.125f * LOG2E;
constexpr float QS96 = 0.10206207261596575f * LOG2E;

constexpr size_t MiB = 1u << 20;
constexpr size_t WS_CTL = 0, CTL_ZERO_BYTES = 1 * MiB;
constexpr size_t WS_CS = 1 * MiB;
constexpr size_t WS_LUT = 3 * MiB;
constexpr size_t LUT_N = 0;
constexpr size_t LUT_D = 32768;
constexpr size_t OFF_RSA = 65536, OFF_RSB = 131072;
constexpr size_t OFF_LOGF = 262144;
constexpr size_t OFF_CT = 786432;
constexpr size_t OFF_KNT = 802816, OFF_QNC = 811008;
constexpr size_t OFF_QKN = 794624;
constexpr size_t WS_W = 4 * MiB;
constexpr size_t W_IN = 0, W_OUT = 6 * MiB, W_UP = 8 * MiB, W_DN = 16 * MiB, W_PG = 24 * MiB, W_PP = 26 * MiB, W_UQ = 26 * MiB + 512 * 1024, W_UKV = 27 * MiB;
constexpr size_t WS_PB = 32 * MiB;
constexpr size_t WS_HB = 40 * MiB;
constexpr size_t WS_MIX = 72 * MiB;
constexpr size_t WS_A = 136 * MiB;
constexpr size_t A_FQ = 0, A_FK = 16 * MiB, A_FV = 32 * MiB, A_CQN = 48 * MiB, A_CKVN = 56 * MiB, A_QM = 60 * MiB, A_KM = 84 * MiB, A_VM = 108 * MiB, A_OA = 124 * MiB, A_CUM = 156 * MiB;
constexpr size_t A_DQ = 0, A_DK = 24 * MiB, A_DV = 48 * MiB, A_NQ = 72 * MiB, A_SM1 = 80 * MiB, A_SM2 = 88 * MiB, A_GATE = 96 * MiB, A_KC = 97 * MiB, A_VC = 97 * MiB + 256 * 1024;
constexpr size_t A_LSED = 98 * MiB, A_ODIL = 99 * MiB, A_OWIN = 140 * MiB;
constexpr size_t A_OCMP = 0, A_OSEL = 8 * MiB;
constexpr size_t WS_HB2 = 293 * MiB;
constexpr size_t WS_RSP = 325 * MiB;
constexpr size_t WS_C1 = 326 * MiB;
constexpr size_t WS_END = 329 * MiB;
constexpr int CW_BAR = 4096;

constexpr int RING_BYTES = 131072;
constexpr int MISC_OFF = 163840 - 512;
constexpr int LDS_BYTES = 163840;

__device__ __forceinline__ unsigned f2bf(float f) { unsigned u = __builtin_bit_cast(unsigned, f); return (u + 0x7fffu + ((u >> 16) & 1u)) >> 16; }
typedef float f32x2_t __attribute__((ext_vector_type(2))); typedef __bf16 bf16x2_t __attribute__((ext_vector_type(2)));
__device__ __forceinline__ unsigned pk2(float lo, float hi) { f32x2_t v = {lo, hi}; bf16x2_t b = __builtin_convertvector(v, bf16x2_t); return __builtin_bit_cast(unsigned, b); }
__device__ __forceinline__ float bf2f(u16 h) { return __builtin_bit_cast(float, (unsigned)h << 16); }
__device__ __forceinline__ float bflo(unsigned u) { return __builtin_bit_cast(float, u << 16); }
__device__ __forceinline__ float bfhi(unsigned u) { return __builtin_bit_cast(float, u & 0xffff0000u); }
__device__ __forceinline__ float wave_sum(float v) {
#pragma unroll
    for (int o = 1; o < 64; o <<= 1) v += __shfl_xor(v, o);
    return v;
}
__device__ __forceinline__ float wave_max(float v) {
#pragma unroll
    for (int o = 1; o < 64; o <<= 1) v = fmaxf(v, __shfl_xor(v, o));
    return v;
}
__device__ __forceinline__ float rdlane_f(float v, int l) { return __builtin_bit_cast(float, __builtin_amdgcn_readlane(__builtin_bit_cast(int, v), l)); }
#define LDS_WAIT() asm volatile("s_waitcnt lgkmcnt(0)" ::: "memory")

#define XB_TMO      128
#define XB_XCNT(j)  (256  + 64 * (j))
#define XB_XSUB(j)  (1280 + 64 * (j))
#define XB_XGEN(j)  (2304 + 64 * (j))
#define XB_TOP      3328
#define XB_TOPGEN   3392
#define XCD_BAR_WORDS 3456
#define XB_SPIN_CAP (1u << 18)

__device__ __forceinline__ unsigned xb_ld(unsigned* p)              { return __hip_atomic_load(p, __ATOMIC_RELAXED, __HIP_MEMORY_SCOPE_AGENT); }
__device__ __forceinline__ unsigned xb_add(unsigned* p, unsigned v) { return __hip_atomic_fetch_add(p, v, __ATOMIC_RELAXED, __HIP_MEMORY_SCOPE_AGENT); }
__device__ __forceinline__ unsigned xb_xcc_id() { return (unsigned)__builtin_amdgcn_s_getreg((3 << 11) | 20) & 0xFu; }
#define XB_SPIN(cond, bar) do { unsigned _sp = 0; while (cond) { __builtin_amdgcn_s_sleep(1); \
    if ((++_sp & 255u) == 0u) { if (xb_ld(&(bar)[XB_TMO])) break; if (_sp > XB_SPIN_CAP) { atomicAdd(&(bar)[XB_TMO], 1u); break; } } } } while (0)

struct XcdBarrier {
    unsigned* bar; unsigned x;
    volatile LAS unsigned* st;
};

__device__ __forceinline__ XcdBarrier xcd_barrier_post(unsigned* bar, volatile LAS unsigned* st) {
    XcdBarrier b; b.bar = bar; b.x = xb_xcc_id(); b.st = st;
    if (threadIdx.x == 0) (void)xb_add(&bar[XB_XCNT(b.x)], 1u);
    return b;
}
__device__ __forceinline__ void xcd_barrier_complete(unsigned* bar, unsigned x, unsigned& nloc, unsigned& nx) {
    const unsigned G = gridDim.x * gridDim.y * gridDim.z;
    unsigned sum, cnt, mine, sp = 0u;
    for (;;) {
        sum = 0u; cnt = 0u; mine = 0u;
#pragma unroll
        for (unsigned j = 0; j < 16; ++j) { const unsigned c = xb_ld(&bar[XB_XCNT(j)]); sum += c; cnt += (c > 0u) ? 1u : 0u; mine = (j == x) ? c : mine; }
        if (sum == G) break;
        __builtin_amdgcn_s_sleep(1);
        if ((++sp & 255u) == 0u) { if (xb_ld(&bar[XB_TMO])) break; if (sp > XB_SPIN_CAP) { atomicAdd(&bar[XB_TMO], 1u); break; } }
    }
    nloc = mine > 0u ? mine : 1u; nx = cnt > 0u ? cnt : 1u;
}

__device__ __forceinline__ void xcd_barrier(const XcdBarrier& b) {
    asm volatile("s_waitcnt vmcnt(0)" ::: "memory");
    __syncthreads();
    if (threadIdx.x == 0) {
        unsigned* bar = b.bar;
        __builtin_amdgcn_s_waitcnt(0);
        unsigned nloc = b.st[0], nx = b.st[1];
        if (nloc == 0u) { xcd_barrier_complete(bar, b.x, nloc, nx); b.st[0] = nloc; b.st[1] = nx; }
        const unsigned old = xb_add(&bar[XB_XSUB(b.x)], 1u);
        const unsigned gen = old / nloc;
        if (old + 1u == (gen + 1u) * nloc) {
            __builtin_amdgcn_fence(__ATOMIC_RELEASE, "agent");
            asm volatile("s_waitcnt vmcnt(0)" ::: "memory");
            const unsigned og = xb_add(&bar[XB_TOP], 1u);
            const unsigned tg = og / nx;
            if (og + 1u == (tg + 1u) * nx) xb_add(&bar[XB_TOPGEN], 1u);
            else XB_SPIN(xb_ld(&bar[XB_TOPGEN]) == tg, bar);
            __builtin_amdgcn_fence(__ATOMIC_ACQUIRE, "agent");
            xb_add(&bar[XB_XGEN(b.x)], 1u);
            asm volatile("s_waitcnt vmcnt(0)" ::: "memory");
        } else {
            XB_SPIN(xb_ld(&bar[XB_XGEN(b.x)]) == gen, bar);
            __builtin_amdgcn_fence(__ATOMIC_ACQUIRE, "agent");
            asm volatile("s_waitcnt vmcnt(0)" ::: "memory");
        }
    }
    __syncthreads();
}

namespace pg8 {
#define PG8_LAS __attribute__((address_space(3)))
typedef unsigned short bf16_t;
typedef short bf16x8 __attribute__((ext_vector_type(8)));
typedef float f32x4 __attribute__((ext_vector_type(4)));
typedef unsigned u32x4 __attribute__((ext_vector_type(4)));
constexpr int BM = 256, BK = 64, HALF = 128, HTB = HALF * BK * 2  , STAGE_BYTES = 8 * HTB, NXCD = 8, WGM = 8;

__host__ __device__ __forceinline__ int lds_byte(int r, int c) { const int st = (r >> 4) * 2 + (c >> 5), rr = r & 15, cc = c & 31, ob = rr * 64 + cc * 2; return st * 1024 + (ob ^ (((ob >> 9) & 1) << 5)); }
__host__ __device__ __forceinline__ void stage_rc(int b, int& R, int& C) { const int st = b / 1024, sb = b % 1024, swz = sb ^ (((sb >> 9) & 1) << 5); R = (st >> 1) * 16 + swz / 64; C = (st & 1) * 32 + (swz % 64) / 2; }
__host__ __device__ __forceinline__ int perm32(int rho) { const int n = rho >> 4, i = rho & 15; return 8 * (i >> 2) + 4 * n + (i & 3); }

struct Unit { int pm, pn; };
struct Gemm { const bf16_t* A; const bf16_t* Bt; int M, N, K; };

struct StaticOrder {
    int nM, nN, nwg, G, c;
    __host__ __device__ void init(int M, int N, int G_, int c_) { nM = M / BM; nN = N / BM; nwg = nM * nN; G = G_; c = c_; }
    __host__ __device__ bool next(int i, Unit& u) const {
        const long L = (long)i * G + c; if (L >= nwg) return false;
        int wgid = (int)L; { const int q = nwg / NXCD, r = nwg % NXCD, xcd = wgid % NXCD, off = wgid / NXCD; wgid = (xcd < r ? xcd * (q + 1) : r * (q + 1) + (xcd - r) * q) + off; }
        const int nig = WGM * nN, gid = wgid / nig, fm = gid * WGM, gsz = (nM - fm) < WGM ? (nM - fm) : WGM;
        u.pm = fm + ((wgid % nig) % gsz); u.pn = (wgid % nig) / gsz; return true;
    }
    __device__ __forceinline__ void a_ready(const Unit&) const {}
    __device__ __forceinline__ void done(const Unit&) const {}
};

__device__ __forceinline__ unsigned cvt_pk_bf16(float lo, float hi) { unsigned r; asm volatile("v_cvt_pk_bf16_f32 %0, %1, %2" : "=v"(r) : "v"(lo), "v"(hi)); return r; }
typedef float f32x2 __attribute__((ext_vector_type(2)));
template <class Epi, class Sched, bool ALIGN_EPI = false, bool SP2 = false>
__device__ __forceinline__ void gemm_phase(PG8_LAS unsigned char* lds, const Gemm g, const Sched& S, const Epi& E) {
    int tid_ = threadIdx.x; asm volatile("" : "+v"(tid_));
    const int tid = tid_, wid = __builtin_amdgcn_readfirstlane(tid >> 6), lane = tid & 63, wr = wid >> 2, wc = wid & 3, fr = lane & 15, fq = lane >> 4;
    int K_ = g.K; asm volatile("" : "+s"(K_));
    const int K = K_, nt = K / BK;
    unsigned voffA[2], voffB[2];
#pragma unroll
    for (int i = 0; i < 2; ++i) { int R, C; stage_rc(tid * 16 + i * 8192, R, C); const int Rb = Epi::PERM ? ((R & ~31) + perm32(R & 31)) : R;
        voffA[i] = (unsigned)(R * K + C) * 2u; voffB[i] = (unsigned)(Rb * K + C) * 2u; }
    const size_t kstep = (size_t)(BK * 2);
    const size_t hstep = (size_t)HALF * K * 2;
    const size_t tstep = 2 * hstep;
    const unsigned ldsw = (unsigned)wid * 1024u;
    const int aoff = lds_byte(wr * 64 + fr, fq * 8), boff = lds_byte(wc * 32 + fr, fq * 8);
#define PG8_SA(b, h) (((b) * 2 + (h)) * HTB)
#define PG8_SB(b, h) ((4 + (b) * 2 + (h)) * HTB)
#define PG8_STAGE(bufoff, gbase, voff) do { _Pragma("unroll") for (int _i = 0; _i < 2; ++_i) \
        __builtin_amdgcn_global_load_lds((const unsigned*)((const char*)(gbase) + (voff)[_i]), (PG8_LAS unsigned*)(lds + (bufoff) + ldsw + _i * 8192), 16, 0, 0); } while (0)
#define PG8_LDA(dst, b, h) do { _Pragma("unroll") for (int m = 0; m < 4; ++m) _Pragma("unroll") for (int k = 0; k < 2; ++k) dst[m][k] = *(const PG8_LAS bf16x8*)(lds + PG8_SA(b, h) + aoff + m * 2048 + k * 1024); } while (0)
#define PG8_LDB(dst, b, h) do { _Pragma("unroll") for (int n = 0; n < 2; ++n) _Pragma("unroll") for (int k = 0; k < 2; ++k) dst[n][k] = *(const PG8_LAS bf16x8*)(lds + PG8_SB(b, h) + boff + n * 2048 + k * 1024); } while (0)
#define PG8_MMA(ai, bj, At, Bt) do { __builtin_amdgcn_s_setprio(1); _Pragma("unroll") for (int m = 0; m < 4; ++m) _Pragma("unroll") for (int n = 0; n < 2; ++n) _Pragma("unroll") for (int k = 0; k < 2; ++k) \
        acc[ai][bj][m][n] = __builtin_amdgcn_mfma_f32_16x16x32_bf16(Bt[n][k], At[m][k], acc[ai][bj][m][n], 0, 0, 0); __builtin_amdgcn_s_setprio(0); } while (0)
#define PG8_WAIT_V(n) asm volatile("s_waitcnt vmcnt(" #n ")" ::: "memory")
#define PG8_WAIT_L(n) asm volatile("s_waitcnt lgkmcnt(" #n ")" ::: "memory")
#define PG8_BAR __builtin_amdgcn_s_barrier()
#define PG8_SCHED __builtin_amdgcn_sched_barrier(0)
    Unit cur, nxt; int ui = 0;
    if (!S.next(0, cur)) return;
    f32x4 acc[2][2][4][2];
#pragma unroll
    for (int a = 0; a < 2; ++a)
#pragma unroll
        for (int b = 0; b < 2; ++b)
#pragma unroll
            for (int m = 0; m < 4; ++m)
#pragma unroll
                for (int n = 0; n < 2; ++n) acc[a][b][m][n] = (f32x4){0.f, 0.f, 0.f, 0.f};
    bf16x8 At[4][2], B0[2][2], B1[2][2];
    const char* cA = (const char*)g.A + (size_t)cur.pm * tstep; const char* cB = (const char*)g.Bt + (size_t)cur.pn * tstep;
    S.a_ready(cur);
    if constexpr (SP2) {
        PG8_STAGE(PG8_SB(0, 0), cB, voffB); PG8_STAGE(PG8_SB(0, 1), cB + hstep, voffB); PG8_STAGE(PG8_SA(0, 0), cA, voffA); PG8_STAGE(PG8_SA(0, 1), cA + hstep, voffA);
        if (wr == 1) PG8_BAR;
        PG8_WAIT_V(2); PG8_BAR;
        PG8_STAGE(PG8_SB(1, 0), cB + kstep, voffB); PG8_STAGE(PG8_SA(1, 0), cA + kstep, voffA); PG8_STAGE(PG8_SB(1, 1), cB + hstep + kstep, voffB);
        PG8_WAIT_V(6); PG8_BAR;
    } else {
        PG8_STAGE(PG8_SB(0, 0), cB, voffB); PG8_STAGE(PG8_SA(0, 0), cA, voffA); PG8_STAGE(PG8_SB(0, 1), cB + hstep, voffB); PG8_STAGE(PG8_SA(0, 1), cA + hstep, voffA);
        if (wr == 1) PG8_BAR;
        PG8_WAIT_V(4); PG8_BAR;
        PG8_STAGE(PG8_SB(1, 0), cB + kstep, voffB); PG8_STAGE(PG8_SA(1, 0), cA + kstep, voffA); PG8_STAGE(PG8_SB(1, 1), cB + hstep + kstep, voffB);
        PG8_WAIT_V(6); PG8_BAR;
    }
    for (;;) {
        const bool has_next = S.next(ui + 1, nxt);
        const char* nA = has_next ? (const char*)g.A + (size_t)nxt.pm * tstep : cA; const char* nB = has_next ? (const char*)g.Bt + (size_t)nxt.pn * tstep : cB;
        for (int t = 0; t < nt; t += 2) {
            const bool last = (t == nt - 2);
            const char* a1 = cA + (size_t)(t + 1) * kstep;
            const char* a2 = last ? nA : cA + (size_t)(t + 2) * kstep; const char* b2 = last ? nB : cB + (size_t)(t + 2) * kstep;
            const char* a3 = a2 + kstep; const char* b3 = b2 + kstep;
            if (last && has_next) S.a_ready(nxt);
            if constexpr (SP2) {
            PG8_LDB(B0, 0, 0); PG8_LDB(B1, 0, 1); PG8_SCHED; PG8_LDA(At, 0, 0); PG8_STAGE(PG8_SA(1, 1), a1 + hstep, voffA);
            PG8_WAIT_V(8); PG8_WAIT_L(0); PG8_BAR; PG8_MMA(0, 0, At, B0); PG8_MMA(0, 1, At, B1); PG8_BAR; PG8_SCHED;
            PG8_LDA(At, 0, 1); PG8_STAGE(PG8_SB(0, 0), b2, voffB); PG8_STAGE(PG8_SB(0, 1), b2 + hstep, voffB); PG8_STAGE(PG8_SA(0, 0), a2, voffA);
            PG8_WAIT_V(8); PG8_WAIT_L(0); PG8_BAR; PG8_MMA(1, 0, At, B0); PG8_MMA(1, 1, At, B1); PG8_BAR; PG8_SCHED;
            PG8_LDB(B0, 1, 0); PG8_LDB(B1, 1, 1); PG8_SCHED; PG8_LDA(At, 1, 0); PG8_STAGE(PG8_SA(0, 1), a2 + hstep, voffA);
            PG8_WAIT_V(8); PG8_WAIT_L(0); PG8_BAR; PG8_MMA(0, 0, At, B0); PG8_MMA(0, 1, At, B1); PG8_BAR; PG8_SCHED;
            PG8_LDA(At, 1, 1); PG8_STAGE(PG8_SB(1, 0), b3, voffB); PG8_STAGE(PG8_SB(1, 1), b3 + hstep, voffB); PG8_STAGE(PG8_SA(1, 0), a3, voffA);
            PG8_WAIT_V(8); PG8_WAIT_L(0); PG8_BAR; PG8_MMA(1, 0, At, B0); PG8_MMA(1, 1, At, B1); PG8_BAR; PG8_SCHED;
            } else {
            PG8_LDB(B0, 0, 0); PG8_SCHED; PG8_LDA(At, 0, 0); PG8_STAGE(PG8_SA(1, 1), a1 + hstep, voffA);
            PG8_WAIT_L(8); PG8_BAR; PG8_WAIT_L(0); PG8_MMA(0, 0, At, B0); PG8_BAR; PG8_SCHED;
            PG8_LDB(B1, 0, 1); PG8_STAGE(PG8_SB(0, 0), b2, voffB);
            PG8_BAR; PG8_WAIT_L(0); PG8_MMA(0, 1, At, B1); PG8_BAR;
            PG8_LDA(At, 0, 1); PG8_STAGE(PG8_SA(0, 0), a2, voffA);
            PG8_BAR; PG8_WAIT_L(0); PG8_MMA(1, 0, At, B0); PG8_BAR; PG8_SCHED;
            PG8_STAGE(PG8_SB(0, 1), b2 + hstep, voffB);
            PG8_WAIT_V(6); PG8_BAR; PG8_MMA(1, 1, At, B1); PG8_BAR;
            PG8_LDB(B0, 1, 0); PG8_SCHED; PG8_LDA(At, 1, 0); PG8_STAGE(PG8_SA(0, 1), a2 + hstep, voffA);
            PG8_WAIT_L(8); PG8_BAR; PG8_WAIT_L(0); PG8_MMA(0, 0, At, B0); PG8_BAR; PG8_SCHED;
            PG8_LDB(B1, 1, 1); PG8_STAGE(PG8_SB(1, 0), b3, voffB);
            PG8_BAR; PG8_WAIT_L(0); PG8_MMA(0, 1, At, B1); PG8_BAR;
            PG8_LDA(At, 1, 1); PG8_STAGE(PG8_SA(1, 0), a3, voffA);
            PG8_BAR; PG8_WAIT_L(0); PG8_MMA(1, 0, At, B0); PG8_BAR; PG8_SCHED;
            PG8_STAGE(PG8_SB(1, 1), b3 + hstep, voffB);
            PG8_WAIT_V(6); PG8_BAR; PG8_MMA(1, 1, At, B1); PG8_BAR;
            }
        }
        if constexpr (ALIGN_EPI) { if (wr == 0) PG8_BAR; }
        if constexpr (!Epi::AFTER_DRAIN) { E(acc, cur, wr, wc, fr, fq); S.done(cur); }
        if (!has_next) break;
#pragma unroll
        for (int a = 0; a < 2; ++a)
#pragma unroll
            for (int b = 0; b < 2; ++b)
#pragma unroll
                for (int m = 0; m < 4; ++m)
#pragma unroll
                    for (int n = 0; n < 2; ++n) acc[a][b][m][n] = (f32x4){0.f, 0.f, 0.f, 0.f};
        cur = nxt; cA = nA; cB = nB; ++ui;
        if constexpr (ALIGN_EPI) { if (wr == 1) PG8_BAR; }
    }
    PG8_WAIT_V(0);
    if constexpr (!ALIGN_EPI) { if (wr == 0) PG8_BAR; }
    PG8_BAR;
    if constexpr (Epi::AFTER_DRAIN) { E.fused(acc, cur, wr, wc, fr, fq, lds, wid, lane); S.done(cur); }
#undef PG8_SA
#undef PG8_SB
#undef PG8_STAGE
#undef PG8_LDA
#undef PG8_LDB
#undef PG8_MMA
#undef PG8_WAIT_V
#undef PG8_WAIT_L
#undef PG8_BAR
#undef PG8_SCHED
}
}

using pg8::Unit;
typedef pg8::f32x4 f32x4;
__device__ __forceinline__ float sigmoidf_(float x) { return 1.f / (1.f + __expf(-x)); }
__device__ __forceinline__ v4u pack8(f32x4 a, f32x4 b) { v4u w; w.x = pk2(a[0], a[1]); w.y = pk2(a[2], a[3]); w.z = pk2(b[0], b[1]); w.w = pk2(b[2], b[3]); return w; }

struct EpiF32 { static constexpr bool PERM = true, AFTER_DRAIN = false;
    float* O; int ldc;
    __device__ __forceinline__ void operator()(const f32x4 (&acc)[2][2][4][2], const Unit& u, int wr, int wc, int fr, int fq) const {
        const int row0 = u.pm * 256 + wr * 64 + fr, col0 = u.pn * 256 + wc * 32 + 8 * fq;
#pragma unroll
        for (int ai = 0; ai < 2; ++ai)
#pragma unroll
            for (int m = 0; m < 4; ++m) { float* rp = O + (size_t)(row0 + ai * 128 + m * 16) * ldc + col0;
#pragma unroll
                for (int bj = 0; bj < 2; ++bj) { *(f32x4*)(rp + bj * 128) = acc[ai][bj][m][0]; *(f32x4*)(rp + bj * 128 + 4) = acc[ai][bj][m][1]; } }
    }
};
__device__ __forceinline__ float row_ss(const float* RS, int row, bool slots) { if (!slots) return RS[row];
    const v4f* p = (const v4f*)(RS + (size_t)row * 16); const v4f a = p[0], b = p[1], c = p[2], d = p[3];
    return (((a.x + a.y) + (a.z + a.w)) + ((b.x + b.y) + (b.z + b.w))) + (((c.x + c.y) + (c.z + c.w)) + ((d.x + d.y) + (d.z + d.w))); }
struct EpiBf16 { static constexpr bool PERM = true, AFTER_DRAIN = false;
    u16* O; int ldc;
    __device__ __forceinline__ void operator()(const f32x4 (&acc)[2][2][4][2], const Unit& u, int wr, int wc, int fr, int fq) const {
        const int row0 = u.pm * 256 + wr * 64 + fr, col0 = u.pn * 256 + wc * 32 + 8 * fq;
#pragma unroll
        for (int ai = 0; ai < 2; ++ai)
#pragma unroll
            for (int m = 0; m < 4; ++m) { u16* rp = O + (size_t)(row0 + ai * 128 + m * 16) * ldc + col0;
#pragma unroll
                for (int bj = 0; bj < 2; ++bj) *(v4u*)(rp + bj * 128) = pack8(acc[ai][bj][m][0], acc[ai][bj][m][1]); }
    }
};
struct EpiEvenIn { static constexpr bool PERM = true, AFTER_DRAIN = false;
    float* CQKV; u16* FQ; const float* RS; bool slots;
    __device__ __forceinline__ void operator()(const f32x4 (&acc)[2][2][4][2], const Unit& u, int wr, int wc, int fr, int fq) const {
        const int row0 = u.pm * 256 + wr * 64 + fr, c0 = wc * 32 + 8 * fq;
#pragma unroll
        for (int ai = 0; ai < 2; ++ai)
#pragma unroll
            for (int m = 0; m < 4; ++m) { const int row = row0 + ai * 128 + m * 16; const float rs = rsqrtf(row_ss(RS, row, slots) * (1.f / DM) + RMS_EPS);
#pragma unroll
                for (int bj = 0; bj < 2; ++bj) { const int c = c0 + bj * 128; f32x4 v0 = acc[ai][bj][m][0] * rs, v1 = acc[ai][bj][m][1] * rs;
                    if (u.pn < 2) { float* p = CQKV + (size_t)row * 512 + u.pn * 256 + c; *(f32x4*)p = v0; *(f32x4*)(p + 4) = v1; }
                    else { const int t = u.pn - 2, which = t >> 1; const float sc = which == 0 ? QS64 : 1.f;
                        u16* p = FQ + (size_t)which * ((size_t)S * 512) + (size_t)row * 512 + (t & 1) * 256 + c; *(v4u*)p = pack8(v0 * sc, v1 * sc); } } }
    }
};
struct EpiOddIn { static constexpr bool PERM = true, AFTER_DRAIN = false;
    u16* DQ; u16* NQ; u16* SM1; u16* SM2; float* GATE; const float* RS; bool slots;
    __device__ __forceinline__ void operator()(const f32x4 (&acc)[2][2][4][2], const Unit& u, int wr, int wc, int fr, int fq) const {
        const int row0 = u.pm * 256 + wr * 64 + fr, c0 = wc * 32 + 8 * fq;
#pragma unroll
        for (int ai = 0; ai < 2; ++ai)
#pragma unroll
            for (int m = 0; m < 4; ++m) { const int row = row0 + ai * 128 + m * 16; const float rs = rsqrtf(row_ss(RS, row, slots) * (1.f / DM) + RMS_EPS);
#pragma unroll
                for (int bj = 0; bj < 2; ++bj) { const int c = c0 + bj * 128; f32x4 v0 = acc[ai][bj][m][0] * rs, v1 = acc[ai][bj][m][1] * rs;
                    if (u.pn < 9) { const int which = u.pn / 3; const float sc = which == 0 ? QS64 : 1.f;
                        u16* p = DQ + (size_t)which * ((size_t)S * 768) + (size_t)row * 768 + (u.pn - which * 3) * 256 + c; *(v4u*)p = pack8(v0 * sc, v1 * sc); }
                    else if (u.pn == 9) { *(v4u*)(NQ + (size_t)row * 256 + c) = pack8(v0 * QS64, v1 * QS64); }
                    else if (u.pn == 10) { const int seg = c >> 6, cc = c & 63;
                        if (seg < 2) *(v4u*)(SM1 + (size_t)seg * ((size_t)S * 64) + (size_t)row * 64 + cc) = pack8(v0, v1);
                        else if (seg == 2) *(v4u*)(SM1 + (size_t)2 * ((size_t)S * 64) + (size_t)(row >> 6) * 4096 + (cc >> 3) * 512 + (row & 63) * 8) = pack8(v0, v1);
                        else { const int kq = row & 63, kpos = (kq & 32) + ((kq >> 2) & 3) * 8 + ((kq >> 4) & 1) * 4 + (kq & 3);
                            u16* vt = SM1 + (size_t)3 * ((size_t)S * 64) + (size_t)(row >> 6) * 4096 + (kpos >> 3) * 512 + (kpos & 7);
#pragma unroll
                            for (int e = 0; e < 8; ++e) vt[(cc + e) * 8] = (u16)f2bf(e < 4 ? v0[e & 3] : v1[e & 3]); } }
                    else { *(v4u*)(SM2 + (size_t)row * 256 + c) = pack8(v0, v1);
                        if (c >= 128 && c < 144) {
#pragma unroll
                            for (int e = 0; e < 8; ++e) { const int gi = c + e - 128; const float v = e < 4 ? v0[e & 3] : v1[e & 3]; if (gi < 12) GATE[(size_t)row * 16 + gi] = sigmoidf_(v); } } } } }
    }
};
struct EpiUq { static constexpr bool PERM = true, AFTER_DRAIN = false;
    u16* QM; const float* CS;
    __device__ __forceinline__ void operator()(const f32x4 (&acc)[2][2][4][2], const Unit& u, int wr, int wc, int fr, int fq) const {
        const int row0 = u.pm * 256 + wr * 64 + fr, c0 = wc * 32 + 8 * fq;
#pragma unroll
        for (int ai = 0; ai < 2; ++ai)
#pragma unroll
            for (int m = 0; m < 4; ++m) { const int row = row0 + ai * 128 + m * 16;
#pragma unroll
                for (int bj = 0; bj < 2; ++bj) { const int c = c0 + bj * 128; f32x4 v0 = acc[ai][bj][m][0], v1 = acc[ai][bj][m][1];
                    if (u.pn < 2) { const int cc = u.pn * 256 + c, head = cc >> 6, d = cc & 63; *(v4u*)(QM + (size_t)row * 768 + head * 96 + d) = pack8(v0 * QS96, v1 * QS96); }
                    else { const int head = c >> 5, grp = (c & 31) >> 3;
                        const f32x4 cs = *(const f32x4*)(CS + (size_t)row * 32 + 4 * grp), sn = *(const f32x4*)(CS + (size_t)row * 32 + 16 + 4 * grp);
                        const f32x4 o1 = (v0 * cs - v1 * sn) * QS96, o2 = (v1 * cs + v0 * sn) * QS96;
                        v2u w1, w2; w1.x = pk2(o1[0], o1[1]); w1.y = pk2(o1[2], o1[3]); w2.x = pk2(o2[0], o2[1]); w2.y = pk2(o2[2], o2[3]);
                        u16* qp = QM + (size_t)row * 768 + head * 96 + 64 + 4 * grp; *(v2u*)qp = w1; *(v2u*)(qp + 16) = w2; } } }
    }
};
struct EpiUkv { static constexpr bool PERM = true, AFTER_DRAIN = false;
    u16* KM; u16* VM;
    __device__ __forceinline__ void operator()(const f32x4 (&acc)[2][2][4][2], const Unit& u, int wr, int wc, int fr, int fq) const {
        const int row0 = u.pm * 256 + wr * 64 + fr, c0 = wc * 32 + 8 * fq;
#pragma unroll
        for (int ai = 0; ai < 2; ++ai)
#pragma unroll
            for (int m = 0; m < 4; ++m) { const int row = row0 + ai * 128 + m * 16;
#pragma unroll
                for (int bj = 0; bj < 2; ++bj) { const int c = c0 + bj * 128; const v4u w = pack8(acc[ai][bj][m][0], acc[ai][bj][m][1]);
                    if (u.pn < 2) { const int cc = u.pn * 256 + c, head = cc >> 6, d = cc & 63; *(v4u*)(KM + (size_t)row * 768 + head * 96 + d) = w; }
                    else { *(v4u*)(VM + (size_t)row * 512 + (u.pn - 2) * 256 + c) = w; } } }
    }
};
struct EpiUp { static constexpr bool PERM = true, AFTER_DRAIN = false;
    u16* HID; const float* RS;
    __device__ __forceinline__ void operator()(const f32x4 (&acc)[2][2][4][2], const Unit& u, int wr, int wc, int fr, int fq) const {
        const int row0 = u.pm * 256 + wr * 64 + fr, col0 = u.pn * 256 + wc * 32 + 8 * fq;
#pragma unroll
        for (int ai = 0; ai < 2; ++ai)
#pragma unroll
            for (int m = 0; m < 4; ++m) { const int row = row0 + ai * 128 + m * 16; const float rs = rsqrtf(RS[row] * (1.f / DM) + RMS_EPS);
#pragma unroll
                for (int bj = 0; bj < 2; ++bj) { f32x4 v0 = acc[ai][bj][m][0] * rs, v1 = acc[ai][bj][m][1] * rs;
#pragma unroll
                    for (int e = 0; e < 4; ++e) { const float a = fmaxf(v0[e], 0.f), b = fmaxf(v1[e], 0.f); v0[e] = a * a; v1[e] = b * b; }
                    *(v4u*)(HID + (size_t)row * DFF + col0 + bj * 128) = pack8(v0, v1); } }
    }
};
struct EpiPleG { static constexpr bool PERM = true, AFTER_DRAIN = false;
    float* H; u16* HB; const u16* PP; const float* RS; float* RSB;
    __device__ __forceinline__ void operator()(const f32x4 (&acc)[2][2][4][2], const Unit& u, int wr, int wc, int fr, int fq) const {
        const int row0 = u.pm * 256 + wr * 64 + fr, col0 = u.pn * 256 + wc * 32 + 8 * fq;
#pragma unroll
        for (int ai = 0; ai < 2; ++ai)
#pragma unroll
            for (int m = 0; m < 4; ++m) { const int row = row0 + ai * 128 + m * 16; const float rs = rsqrtf(RS[row] * (1.f / DM) + RMS_EPS); float ssq = 0.f;
#pragma unroll
                for (int bj = 0; bj < 2; ++bj) { const size_t off = (size_t)row * DM + col0 + bj * 128;
                    f32x4 g0 = acc[ai][bj][m][0] * rs, g1 = acc[ai][bj][m][1] * rs;
                    const v4u pq = *(const v4u*)(PP + off); const f32x4 p0 = {bflo(pq.x), bfhi(pq.x), bflo(pq.y), bfhi(pq.y)}, p1 = {bflo(pq.z), bfhi(pq.z), bflo(pq.w), bfhi(pq.w)};
                    f32x4 h0 = *(const f32x4*)(H + off), h1 = *(const f32x4*)(H + off + 4);
#pragma unroll
                    for (int e = 0; e < 4; ++e) { h0[e] += sigmoidf_(g0[e]) * p0[e]; h1[e] += sigmoidf_(g1[e]) * p1[e]; ssq += h0[e] * h0[e] + h1[e] * h1[e]; }
                    *(f32x4*)(H + off) = h0; *(f32x4*)(H + off + 4) = h1; *(v4u*)(HB + off) = pack8(h0, h1); }
                ssq += __shfl_xor(ssq, 16); ssq += __shfl_xor(ssq, 32);
                if (fq == 0) RSB[(size_t)row * 16 + u.pn * 4 + wc] = ssq; }
    }
};

__device__ __forceinline__ void cvt_item(const float* __restrict__ W, int ldw, int K, int col0, int ncols, const float* __restrict__ gain, u16* __restrict__ dst, int row0,
                                         LAS float* scr, int kb, int nb, int lane) {
    const int k0 = kb * 64, n0 = nb * 32;
    { v4f v[8]; const int c4 = (lane & 7) * 4, n = n0 + c4;
#pragma unroll
      for (int i = 0; i < 8; ++i) { const int kk = 8 * i + (lane >> 3); v[i] = (n < ncols) ? *(const v4f*)(W + (size_t)(k0 + kk) * ldw + col0 + n) : (v4f){0.f, 0.f, 0.f, 0.f}; }
#pragma unroll
      for (int i = 0; i < 8; ++i) { const int kk = 8 * i + (lane >> 3); const float g = gain ? gain[k0 + kk] : 1.f; LAS float* d = scr + kk * 33 + c4;
          d[0] = v[i].x * g; d[1] = v[i].y * g; d[2] = v[i].z * g; d[3] = v[i].w * g; } }
    LDS_WAIT();
    const int c = lane & 7;
#pragma unroll
    for (int j = 0; j < 4; ++j) { const int n = (lane >> 3) + 8 * j; const LAS float* s = scr + (8 * c) * 33 + n;
        v4u o; o.x = pk2(s[0 * 33], s[1 * 33]); o.y = pk2(s[2 * 33], s[3 * 33]); o.z = pk2(s[4 * 33], s[5 * 33]); o.w = pk2(s[6 * 33], s[7 * 33]);
        if (n0 + n < ncols) *(v4u*)(dst + (size_t)(row0 + n0 + n) * K + k0 + 8 * c) = o; }
    LDS_WAIT();
}
__device__ __forceinline__ void cvt_job(const float* W, int ldw, int K, int col0, int ncols, const float* gain, u16* dst, int row0, int& cursor, LAS float* scr, int gw, int NGW, int lane) {
    const int nnb = (ncols + 31) / 32, nit = (K / 64) * nnb;
    int first = gw - cursor; if (first < 0) first += NGW;
    for (int it = first; it < nit; it += NGW) cvt_item(W, ldw, K, col0, ncols, gain, dst, row0, scr, it / nnb, it % nnb, lane);
    cursor = (cursor + nit) % NGW;
}

template <int DQK, class KF>
__device__ __forceinline__ void attn_accum(const u16* __restrict__ qrow, int count, const KF kf, const u16* __restrict__ Kb, int kstride, const u16* __restrict__ Vb, int vstride,
                                           float& m, float& l, float& o, int lane) {
    unsigned qp[DQK / 2];
#pragma unroll
    for (int i = 0; i < DQK / 8; ++i) { const v4u v = *(const v4u*)(qrow + 8 * i); qp[4 * i] = v.x; qp[4 * i + 1] = v.y; qp[4 * i + 2] = v.z; qp[4 * i + 3] = v.w; }
    for (int j0 = 0; j0 < count; j0 += 64) {
        const int j = j0 + lane; int ridx = 0; float bias = 0.f;
        const bool valid = (j < count) && kf(j, ridx, bias);
        float s = -INFINITY;
        if (valid) { const u16* kr = Kb + (size_t)ridx * kstride; float a0 = 0.f, a1 = 0.f;
#pragma unroll
            for (int i = 0; i < DQK / 8; ++i) { const v4u kk = *(const v4u*)(kr + 8 * i);
                a0 += bflo(qp[4 * i]) * bflo(kk.x) + bflo(qp[4 * i + 1]) * bflo(kk.y) + bflo(qp[4 * i + 2]) * bflo(kk.z) + bflo(qp[4 * i + 3]) * bflo(kk.w);
                a1 += bfhi(qp[4 * i]) * bfhi(kk.x) + bfhi(qp[4 * i + 1]) * bfhi(kk.y) + bfhi(qp[4 * i + 2]) * bfhi(kk.z) + bfhi(qp[4 * i + 3]) * bfhi(kk.w); }
            s = a0 + a1 + bias; }
        const float cm = wave_max(s);
        if (cm == -INFINITY) continue;
        const float mn = fmaxf(m, cm), alpha = exp2f(m - mn), p = valid ? exp2f(s - mn) : 0.f;
        l = l * alpha + wave_sum(p); o *= alpha; m = mn;
        if (!valid) ridx = 0;
#pragma unroll 2
        for (int jj = 0; jj < 64; ++jj) { const float pj = rdlane_f(p, jj);
            if (pj != 0.f) { const int rj = __builtin_amdgcn_readlane(ridx, jj); o += pj * bf2f(Vb[(size_t)rj * vstride + lane]); } }
    }
}
struct KfCausal { int t; __device__ __forceinline__ bool operator()(int j, int& r, float& b) const { r = j; b = 0.f; return j <= t; } };
struct KfFox { int t; const float* cum; int h; __device__ __forceinline__ bool operator()(int j, int& r, float& b) const { r = j; if (j <= t) b = -cum[(size_t)j * 8 + h] * LOG2E; return j <= t; } };
struct KfDil { int t, d; const float* lut; __device__ __forceinline__ bool operator()(int j, int& r, float& b) const { const int s = t - d * j; r = s; b = lut[j]; return s >= 0; } };
struct KfAll { __device__ __forceinline__ bool operator()(int j, int& r, float& b) const { r = j; b = 0.f; return true; } };
struct KfSel { int t; const LAS int* sel; const float* lut; __device__ __forceinline__ bool operator()(int j, int& r, float& b) const {
    const int tok = sel[j >> 6] * 64 + (j & 63), dist = t - tok; r = tok; b = lut[dist < 0 ? 0 : (dist > 2047 ? 2047 : dist)]; return dist >= 0; } };
struct KfWin { int t; const float* lut; __device__ __forceinline__ bool operator()(int j, int& r, float& b) const { const int s = t - j; r = s; b = lut[j]; return s >= 0; } };

__device__ __forceinline__ int t5_bucket(int n) {
    if (n < 16) return n;
    int b = 16;
    b += (n >= 22) + (n >= 30) + (n >= 40) + (n >= 54) + (n >= 73) + (n >= 99) + (n >= 134) + (n >= 182) + (n >= 246) + (n >= 332) + (n >= 450) + (n >= 609) + (n >= 825) + (n >= 1117) + (n >= 1513);
    return b;
}
__device__ __forceinline__ float gelu_tanh(float x) { return 0.5f * x * (1.f + tanhf(0.7978845608028654f * (x + 0.044715f * x * x * x))); }

__device__ __forceinline__ void finalize_row(float* __restrict__ h, const u16* __restrict__ mix, const float* __restrict__ g, u16* __restrict__ hb, float* __restrict__ rs, int row, int lane) {
    const v2u* mr = (const v2u*)(mix + (size_t)row * DM) + lane; v4f* hr = (v4f*)(h + (size_t)row * DM) + lane; const v4f* gr = (const v4f*)g + lane;
    v4f mv[4]; float ss = 0.f;
#pragma unroll
    for (int j = 0; j < 4; ++j) { const v2u q = mr[64 * j]; mv[j] = (v4f){bflo(q.x), bfhi(q.x), bflo(q.y), bfhi(q.y)}; ss += mv[j].x * mv[j].x + mv[j].y * mv[j].y + mv[j].z * mv[j].z + mv[j].w * mv[j].w; }
    const float rstd = rsqrtf(wave_sum(ss) * (1.f / DM) + RMS_EPS); float s2 = 0.f;
    v2u* o8 = (v2u*)(hb + (size_t)row * DM) + lane;
#pragma unroll
    for (int j = 0; j < 4; ++j) { v4f hv = hr[64 * j]; const v4f gv = gr[64 * j]; hv = hv + mv[j] * rstd * gv; hr[64 * j] = hv;
        s2 += hv.x * hv.x + hv.y * hv.y + hv.z * hv.z + hv.w * hv.w; v2u w; w.x = pk2(hv.x, hv.y); w.y = pk2(hv.z, hv.w); o8[64 * j] = w; }
    s2 = wave_sum(s2); if (lane == 0) rs[row] = s2;
}


typedef short bf16x8_t __attribute__((ext_vector_type(8)));
typedef short s16x4_t __attribute__((ext_vector_type(4)));
typedef float f32x16 __attribute__((ext_vector_type(16)));
__device__ __forceinline__ float max3f(float a, float b, float c) { float r; asm("v_max3_f32 %0, %1, %2, %3" : "=v"(r) : "v"(a), "v"(b), "v"(c)); return r; }
__device__ __forceinline__ s16x4_t lds_tr16(const LAS unsigned char* p) { return __builtin_bit_cast(s16x4_t, __builtin_amdgcn_ds_read_tr16_b64_v4i16((LAS s16x4_t*)p)); }
__device__ __forceinline__ float xhalf_max(float v) { auto rr = __builtin_amdgcn_permlane32_swap(__float_as_uint(v), __float_as_uint(v), false, false);
    const unsigned a = rr[0], b = rr[1]; return fmaxf(__uint_as_float(a), __uint_as_float(b)); }
__device__ __forceinline__ float xhalf_sum(float v) { auto rr = __builtin_amdgcn_permlane32_swap(__float_as_uint(v), __float_as_uint(v), false, false);
    const unsigned a = rr[0], b = rr[1]; return __uint_as_float(a) + __uint_as_float(b); }
constexpr int ATT_BUF = 24576;

template <int DQK, bool KBIAS>
__device__ __forceinline__ void attn_unit(LAS unsigned char* lds, const u16* __restrict__ Qh, int qpitch, const u16* __restrict__ Kh, int kpitch, const u16* __restrict__ Vh, int vpitch,
                                          u16* __restrict__ Oh, int opitch, int qb, const float* __restrict__ cumh, float qkbound, const unsigned* __restrict__ knt, const unsigned* __restrict__ qnc, int tid) {
    constexpr int NCH = DQK / 8, KS = DQK / 16, NKL = (64 * NCH + 511) / 512;
    const int lane = tid & 63, wid = __builtin_amdgcn_readfirstlane(tid >> 6), r32 = lane & 31, hi = lane >> 5;
    const int q0 = qb * 256, NT = 4 * (qb + 1), row0w = q0 + 32 * wid;
    int kt0 = 0;
    if (KBIAS) { const float bq0 = -cumh[(size_t)q0 * 8] * LOG2E;
        const float qn = 2.f * sqrtf(fmaxf(fmaxf(__uint_as_float(qnc[(size_t)(4 * qb) * 8]), __uint_as_float(qnc[(size_t)(4 * qb + 1) * 8])), fmaxf(__uint_as_float(qnc[(size_t)(4 * qb + 2) * 8]), __uint_as_float(qnc[(size_t)(4 * qb + 3) * 8]))));
        int ns = 0; bool open = true;
        for (int k4 = 0; k4 < NT && open; k4 += 64) { const int kt = k4 + lane, ktc = kt < NT ? kt : NT - 1;
            const bool sk = (kt < NT) && (qn * sqrtf(__uint_as_float(knt[(size_t)ktc * 8])) + (-cumh[(size_t)(64 * ktc + 63) * 8] * LOG2E) - bq0 < -48.f);
            const unsigned long long mk = __ballot(sk), nk = ~mk;
            const int lead = nk ? __builtin_ctzll(nk) : 64; ns += lead; open = (lead == 64); }
        kt0 = __builtin_amdgcn_readfirstlane(ns); (void)qkbound; }
    bf16x8_t qf[KS];
#pragma unroll
    for (int d0 = 0; d0 < KS; ++d0) qf[d0] = *(const bf16x8_t*)(Qh + (size_t)(row0w + r32) * qpitch + 16 * d0 + 8 * hi);
    f32x16 o0, o1;
#pragma unroll
    for (int r = 0; r < 16; ++r) { o0[r] = 0.f; o1[r] = 0.f; }
    float m = 0.f, l = 0.f;
    const int vdt = (tid & 7) >> 2, vkey = tid >> 3, vpart = tid & 3;
    int ksrc[NKL], kdsto[NKL];
#pragma unroll
    for (int i_ = 0; i_ < NKL; ++i_) { const int idx_ = tid + 512 * i_, key_ = idx_ / NCH, c_ = idx_ - key_ * NCH; ksrc[i_] = key_ * kpitch + c_ * 8; kdsto[i_] = c_ * 1024 + ((key_ + 2 * c_) & 63) * 16; }
    const u16* vsrc = Vh + (size_t)vkey * vpitch + vdt * 32 + vpart * 8;
    const int vdst = 12288 + vdt * 4096 + vkey * 64 + vpart * 16;
    v4u kreg[NKL]; v4u vreg; float breg = 0.f;
#define ATT_LOAD(kt) do { _Pragma("unroll") for (int i_ = 0; i_ < NKL; ++i_) { const int idx_ = tid + 512 * i_; if (idx_ < 64 * NCH) kreg[i_] = *(const v4u*)(Kh + (size_t)((kt) * 64) * kpitch + ksrc[i_]); } \
        vreg = *(const v4u*)(vsrc + (size_t)(kt) * 64 * vpitch); if (KBIAS && tid < 64) breg = -cumh[(size_t)((kt) * 64 + tid) * 8] * LOG2E; } while (0)
#define ATT_STORE(buf) do { LAS unsigned char* b_ = lds + (buf) * ATT_BUF; _Pragma("unroll") for (int i_ = 0; i_ < NKL; ++i_) { const int idx_ = tid + 512 * i_; if (idx_ < 64 * NCH) *(LAS v4u*)(b_ + kdsto[i_]) = kreg[i_]; } \
        *(LAS v4u*)(b_ + vdst) = vreg; if (KBIAS && tid < 64) *(LAS float*)(b_ + 20480 + tid * 4) = breg; } while (0)
    ATT_LOAD(kt0); ATT_STORE(0);
    __syncthreads();
    int kfo[KS];
#pragma unroll
    for (int d0 = 0; d0 < KS; ++d0) kfo[d0] = (2 * d0 + hi) * 1024 + ((r32 + 4 * d0 + 2 * hi) & 63) * 16;
    const int vfo = 12288 + (4 * hi + ((lane & 15) >> 2)) * 64 + ((lane >> 4) & 1) * 32 + (lane & 3) * 8;
    for (int kt = kt0; kt < NT; ++kt) {
        const LAS unsigned char* bf = lds + ((kt - kt0) & 1) * ATT_BUF;
        if (kt + 1 < NT) ATT_LOAD(kt + 1);
        const int kbase = 64 * kt;
        if (kbase <= row0w + 31) {
            f32x16 p0, p1;
            if (KBIAS) {
#pragma unroll
                for (int a4 = 0; a4 < 4; ++a4) { const v4f b0 = *(const LAS v4f*)(bf + 20480 + (8 * a4 + 4 * hi) * 4), b1 = *(const LAS v4f*)(bf + 20480 + (32 + 8 * a4 + 4 * hi) * 4);
                    p0[4 * a4] = b0.x; p0[4 * a4 + 1] = b0.y; p0[4 * a4 + 2] = b0.z; p0[4 * a4 + 3] = b0.w; p1[4 * a4] = b1.x; p1[4 * a4 + 1] = b1.y; p1[4 * a4 + 2] = b1.z; p1[4 * a4 + 3] = b1.w; }
            } else {
#pragma unroll
                for (int r = 0; r < 16; ++r) { p0[r] = 0.f; p1[r] = 0.f; }
            }
#pragma unroll
            for (int d0 = 0; d0 < KS; ++d0) { const bf16x8_t k0 = *(const LAS bf16x8_t*)(bf + kfo[d0]), k1 = *(const LAS bf16x8_t*)(bf + (kfo[d0] ^ 512));
                p0 = __builtin_amdgcn_mfma_f32_32x32x16_bf16(k0, qf[d0], p0, 0, 0, 0); p1 = __builtin_amdgcn_mfma_f32_32x32x16_bf16(k1, qf[d0], p1, 0, 0, 0); }
            if (kbase + 63 > row0w) {
                asm volatile("" ::: "memory");
                const int qrow = row0w + r32;
#pragma unroll
                for (int r = 0; r < 16; ++r) { const int key = kbase + (r & 3) + 8 * (r >> 2) + 4 * hi; if (key > qrow) p0[r] = -INFINITY; if (key + 32 > qrow) p1[r] = -INFINITY; }
            }
            const bool first = kt == kt0;
            v2f tA[8], tB[8]; { const v2f m2 = {m, m};
#pragma unroll
              for (int i = 0; i < 8; ++i) { tA[i] = (v2f){p0[2 * i], p0[2 * i + 1]} - m2; tB[i] = (v2f){p1[2 * i], p1[2 * i + 1]} - m2; } }
            float mx = max3f(tA[0].x, tA[0].y, tB[0].x), mx2 = max3f(tB[0].y, tA[1].x, tA[1].y);
            mx = max3f(mx, tB[1].x, tB[1].y);
#pragma unroll
            for (int i = 2; i < 8; i += 2) { mx = max3f(mx, tA[i].x, tA[i].y); mx2 = max3f(mx2, tB[i].x, tB[i].y); mx = max3f(mx, tA[i + 1].x, tA[i + 1].y); mx2 = max3f(mx2, tB[i + 1].x, tB[i + 1].y); }
            mx = xhalf_max(fmaxf(mx, mx2));
            const float dl = fmaxf(mx, first ? -INFINITY : 0.f), alpha = first ? 1.f : __builtin_amdgcn_exp2f(-dl); const bool moved = __any(dl != 0.f); m += dl;
            float ps;
            { const v2f d2 = {dl, dl}; v2f s2 = {0.f, 0.f};
#pragma unroll
              for (int i = 0; i < 8; ++i) { const v2f a = tA[i] - d2, b = tB[i] - d2;
                  p0[2 * i] = __builtin_amdgcn_exp2f(a.x); p0[2 * i + 1] = __builtin_amdgcn_exp2f(a.y); p1[2 * i] = __builtin_amdgcn_exp2f(b.x); p1[2 * i + 1] = __builtin_amdgcn_exp2f(b.y);
                  s2 += (v2f){p0[2 * i], p0[2 * i + 1]}; s2 += (v2f){p1[2 * i], p1[2 * i + 1]}; }
              ps = s2.x + s2.y; }
            l = l * alpha + ps;
            if (moved) {
#pragma unroll
                for (int r = 0; r < 16; ++r) { o0[r] *= alpha; o1[r] *= alpha; } }
            bf16x8_t pw[4];
#pragma unroll
            for (int ks = 0; ks < 4; ++ks) { v4u w;
                if (ks < 2) { w.x = pk2(p0[8 * ks], p0[8 * ks + 1]); w.y = pk2(p0[8 * ks + 2], p0[8 * ks + 3]); w.z = pk2(p0[8 * ks + 4], p0[8 * ks + 5]); w.w = pk2(p0[8 * ks + 6], p0[8 * ks + 7]); }
                else { const int k2 = ks - 2; w.x = pk2(p1[8 * k2], p1[8 * k2 + 1]); w.y = pk2(p1[8 * k2 + 2], p1[8 * k2 + 3]); w.z = pk2(p1[8 * k2 + 4], p1[8 * k2 + 5]); w.w = pk2(p1[8 * k2 + 6], p1[8 * k2 + 7]); }
                pw[ks] = __builtin_bit_cast(bf16x8_t, w); }
#pragma unroll
            for (int ks = 0; ks < 4; ++ks) {
#pragma unroll
                for (int dt = 0; dt < 2; ++dt) { const s16x4_t a = lds_tr16(bf + vfo + dt * 4096 + ks * 1024), b = lds_tr16(bf + vfo + dt * 4096 + ks * 1024 + 512);
                    bf16x8_t vf; vf[0] = a[0]; vf[1] = a[1]; vf[2] = a[2]; vf[3] = a[3]; vf[4] = b[0]; vf[5] = b[1]; vf[6] = b[2]; vf[7] = b[3];
                    if (dt == 0) o0 = __builtin_amdgcn_mfma_f32_32x32x16_bf16(vf, pw[ks], o0, 0, 0, 0); else o1 = __builtin_amdgcn_mfma_f32_32x32x16_bf16(vf, pw[ks], o1, 0, 0, 0); } }
        }
        if (kt + 1 < NT) ATT_STORE((kt + 1 - kt0) & 1);
        __syncthreads();
    }
#undef ATT_LOAD
#undef ATT_STORE
    const float inv = 1.f / xhalf_sum(l);
    u16* orow = Oh + (size_t)(row0w + r32) * opitch;
#pragma unroll
    for (int a4 = 0; a4 < 4; ++a4) { v2u w0, w1; w0.x = pk2(o0[4 * a4] * inv, o0[4 * a4 + 1] * inv); w0.y = pk2(o0[4 * a4 + 2] * inv, o0[4 * a4 + 3] * inv);
        w1.x = pk2(o1[4 * a4] * inv, o1[4 * a4 + 1] * inv); w1.y = pk2(o1[4 * a4 + 2] * inv, o1[4 * a4 + 3] * inv);
        *(v2u*)(orow + 8 * a4 + 4 * hi) = w0; *(v2u*)(orow + 32 + 8 * a4 + 4 * hi) = w1; }
}


typedef float f32x4v __attribute__((ext_vector_type(4)));
__device__ __forceinline__ void win_unit(LAS unsigned char* lds, const u16* __restrict__ Qb, int qpitch, const u16* __restrict__ Kb, int kpitch, const u16* __restrict__ Vb, int vpitch,
                                         int r0, int rs, int W, const float* __restrict__ lut, int qb, u16* __restrict__ Ob, int ldo, float* __restrict__ lse, int lse_stride, int tid) {
    const int lane = tid & 63, wid = __builtin_amdgcn_readfirstlane(tid >> 6), r32 = lane & 31, hi = lane >> 5;
    const int i0 = qb * 256, iw0 = i0 + 32 * wid, qi = iw0 + r32;
    int ktlo = i0 - (W - 1); ktlo = ktlo < 0 ? 0 : (ktlo >> 6); const int kthi = (i0 + 255) >> 6;
    const size_t qtok = (size_t)r0 + (size_t)qi * rs;
    bf16x8_t qf[4];
#pragma unroll
    for (int d0 = 0; d0 < 4; ++d0) qf[d0] = *(const bf16x8_t*)(Qb + qtok * qpitch + 16 * d0 + 8 * hi);
    LAS float* lutL = (LAS float*)(lds + 49152) + 96;
    for (int i = tid; i < W + 192; i += NTHREADS) { const int d = i - 96; lutL[d] = (d >= 0 && d < W) ? lut[d] : 0.f; }
    f32x16 o0, o1;
#pragma unroll
    for (int r = 0; r < 16; ++r) { o0[r] = 0.f; o1[r] = 0.f; }
    float m = -INFINITY, l = 0.f;
    const int kc = tid & 7, kkey = tid >> 3, vdt = (tid & 7) >> 2, vkey = tid >> 3, vpart = tid & 3;
    const int kdst = kc * 1024 + ((kkey + 2 * kc) & 63) * 16, vdst = 12288 + vdt * 4096 + vkey * 64 + vpart * 16;
    v4u kreg, vreg;
#define WIN_LOAD(kt) do { kreg = *(const v4u*)(Kb + ((size_t)r0 + (size_t)((kt) * 64 + kkey) * rs) * kpitch + kc * 8); \
        vreg = *(const v4u*)(Vb + ((size_t)r0 + (size_t)((kt) * 64 + vkey) * rs) * vpitch + vdt * 32 + vpart * 8); } while (0)
#define WIN_STORE(buf) do { LAS unsigned char* b_ = lds + (buf) * ATT_BUF; *(LAS v4u*)(b_ + kdst) = kreg; *(LAS v4u*)(b_ + vdst) = vreg; } while (0)
    WIN_LOAD(ktlo); WIN_STORE(0);
    __syncthreads();
    int kfo[4];
#pragma unroll
    for (int d0 = 0; d0 < 4; ++d0) kfo[d0] = (2 * d0 + hi) * 1024 + ((r32 + 4 * d0 + 2 * hi) & 63) * 16;
    const int vfo = 12288 + (4 * hi + ((lane & 15) >> 2)) * 64 + ((lane >> 4) & 1) * 32 + (lane & 3) * 8;
    for (int kt = ktlo; kt <= kthi; ++kt) {
        const int par = (kt - ktlo) & 1;
        const LAS unsigned char* bf = lds + par * ATT_BUF;
        if (kt < kthi) WIN_LOAD(kt + 1);
        const int kbase = 64 * kt;
        if (kbase <= iw0 + 31 && kbase + 63 >= iw0 - (W - 1)) {
            f32x16 p0, p1;
#pragma unroll
            for (int r = 0; r < 16; ++r) { p0[r] = 0.f; p1[r] = 0.f; }
#pragma unroll
            for (int d0 = 0; d0 < 4; ++d0) { const bf16x8_t k0 = *(const LAS bf16x8_t*)(bf + kfo[d0]), k1 = *(const LAS bf16x8_t*)(bf + (kfo[d0] ^ 512));
                p0 = __builtin_amdgcn_mfma_f32_32x32x16_bf16(k0, qf[d0], p0, 0, 0, 0); p1 = __builtin_amdgcn_mfma_f32_32x32x16_bf16(k1, qf[d0], p1, 0, 0, 0); }
            const int dq = qi - kbase - 4 * hi;
#pragma unroll
            for (int r = 0; r < 16; ++r) { const int d0_ = dq - ((r & 3) + 8 * (r >> 2)), d1_ = d0_ - 32;
                const float b0 = lutL[d0_], b1 = lutL[d1_];
                p0[r] = ((unsigned)d0_ < (unsigned)W) ? p0[r] + b0 : -INFINITY; p1[r] = ((unsigned)d1_ < (unsigned)W) ? p1[r] + b1 : -INFINITY; }
            float mx = fmaxf(p0[0], p1[0]);
#pragma unroll
            for (int r = 1; r < 16; ++r) mx = fmaxf(mx, fmaxf(p0[r], p1[r]));
            mx = xhalf_max(mx);
            const float mn = fmaxf(m, mx), msub = (mn == -INFINITY) ? 0.f : mn, alpha = __builtin_amdgcn_exp2f(m - msub); m = mn;
            float ps = 0.f;
#pragma unroll
            for (int r = 0; r < 16; ++r) { p0[r] = __builtin_amdgcn_exp2f(p0[r] - msub); p1[r] = __builtin_amdgcn_exp2f(p1[r] - msub); ps += p0[r] + p1[r]; }
            l = l * alpha + ps;
#pragma unroll
            for (int r = 0; r < 16; ++r) { o0[r] *= alpha; o1[r] *= alpha; }
            bf16x8_t pw[4];
#pragma unroll
            for (int ks = 0; ks < 4; ++ks) { v4u w;
                if (ks < 2) { w.x = pk2(p0[8 * ks], p0[8 * ks + 1]); w.y = pk2(p0[8 * ks + 2], p0[8 * ks + 3]); w.z = pk2(p0[8 * ks + 4], p0[8 * ks + 5]); w.w = pk2(p0[8 * ks + 6], p0[8 * ks + 7]); }
                else { const int k2 = ks - 2; w.x = pk2(p1[8 * k2], p1[8 * k2 + 1]); w.y = pk2(p1[8 * k2 + 2], p1[8 * k2 + 3]); w.z = pk2(p1[8 * k2 + 4], p1[8 * k2 + 5]); w.w = pk2(p1[8 * k2 + 6], p1[8 * k2 + 7]); }
                pw[ks] = __builtin_bit_cast(bf16x8_t, w); }
#pragma unroll
            for (int ks = 0; ks < 4; ++ks) {
#pragma unroll
                for (int dt = 0; dt < 2; ++dt) { const s16x4_t a = lds_tr16(bf + vfo + dt * 4096 + ks * 1024), b = lds_tr16(bf + vfo + dt * 4096 + ks * 1024 + 512);
                    bf16x8_t vf; vf[0] = a[0]; vf[1] = a[1]; vf[2] = a[2]; vf[3] = a[3]; vf[4] = b[0]; vf[5] = b[1]; vf[6] = b[2]; vf[7] = b[3];
                    if (dt == 0) o0 = __builtin_amdgcn_mfma_f32_32x32x16_bf16(vf, pw[ks], o0, 0, 0, 0); else o1 = __builtin_amdgcn_mfma_f32_32x32x16_bf16(vf, pw[ks], o1, 0, 0, 0); } }
        }
        if (kt < kthi) WIN_STORE(par ^ 1);
        __syncthreads();
    }
#undef WIN_LOAD
#undef WIN_STORE
    const float lt = xhalf_sum(l), inv = 1.f / lt;
    u16* orow = Ob + qtok * ldo;
#pragma unroll
    for (int a4 = 0; a4 < 4; ++a4) { v2u w0, w1; w0.x = pk2(o0[4 * a4] * inv, o0[4 * a4 + 1] * inv); w0.y = pk2(o0[4 * a4 + 2] * inv, o0[4 * a4 + 3] * inv);
        w1.x = pk2(o1[4 * a4] * inv, o1[4 * a4 + 1] * inv); w1.y = pk2(o1[4 * a4 + 2] * inv, o1[4 * a4 + 3] * inv);
        *(v2u*)(orow + 8 * a4 + 4 * hi) = w0; *(v2u*)(orow + 32 + 8 * a4 + 4 * hi) = w1; }
    if (lse != nullptr && hi == 0) lse[qtok * lse_stride] = m + __builtin_amdgcn_logf(lt);
}

typedef float f32x4m __attribute__((ext_vector_type(4)));
__device__ __forceinline__ void compress_task(LAS unsigned char* lds, const u16* __restrict__ src  , const u16* __restrict__ w1t  , const float* __restrict__ c1  ,
                                              const float* __restrict__ w2, u16* __restrict__ dst  , int grp, int tid) {
    LAS u16* tok = (LAS u16*)lds;
    LAS float* hid = (LAS float*)(lds + 18432);
    const int lane = tid & 63, wid = __builtin_amdgcn_readfirstlane(tid >> 6), col = lane & 15, kg = lane >> 4;
    const int i0 = grp * 8, t0 = 16 * i0;
    for (int e = tid; e < 144 * 8; e += NTHREADS) { int t = t0 + (e >> 3); t = t < S ? t : S - 1; *(LAS v4u*)(tok + (e >> 3) * 64 + (e & 7) * 8) = *(const v4u*)(src + (size_t)t * 64 + (e & 7) * 8); }
    __syncthreads();
    { f32x4m acc0 = {0.f, 0.f, 0.f, 0.f}, acc1 = {0.f, 0.f, 0.f, 0.f};
      const int arow = col & 7;
      const u16* b0 = w1t + (size_t)(32 * wid + col) * 2048 + 8 * kg; const u16* b1 = b0 + (size_t)16 * 2048;
#pragma unroll 4
      for (int ks = 0; ks < 64; ++ks) { const int k = 32 * ks + 8 * kg, lq = k >> 6, d = k & 63;
          const bf16x8_t af = *(const LAS bf16x8_t*)(tok + (16 * arow + lq) * 64 + d);
          const bf16x8_t bf0 = *(const bf16x8_t*)(b0 + 32 * ks), bf1 = *(const bf16x8_t*)(b1 + 32 * ks);
          acc0 = __builtin_amdgcn_mfma_f32_16x16x32_bf16(af, bf0, acc0, 0, 0, 0); acc1 = __builtin_amdgcn_mfma_f32_16x16x32_bf16(af, bf1, acc1, 0, 0, 0); }
      if (kg < 2) {
#pragma unroll
          for (int e = 0; e < 4; ++e) { const int r = 4 * kg + e, n0 = 32 * wid + col; hid[r * 256 + n0] = gelu_tanh(acc0[e] + c1[n0]); hid[r * 256 + n0 + 16] = gelu_tanh(acc1[e] + c1[n0 + 16]); } } }
    __syncthreads();
    { const int r = tid >> 6, d = tid & 63; float acc = 0.f;
#pragma unroll 8
      for (int n = 0; n < 256; ++n) acc += hid[r * 256 + n] * w2[n * 64 + d];
      if (i0 + r < 1023) dst[(size_t)(i0 + r) * 64 + d] = (u16)f2bf(acc); }
    __syncthreads();
}

struct NsaBufs { const u16* NQ; const u16* KC; const u16* VC; const u16* KSEL; const u16* VSELT; const float* LUTN; const float* GATE;
                 const u16* ODIL; const float* LSED; const u16* OWIN; u16* OCMP; u16* OSEL; u16* OA; };
constexpr int NSA_IMP = 49152, NSA_SEL = 149504;
constexpr int NSS_STATE = 0, NSS_STAGE = 73728, NSS_STAGE_BYTES = 36864, NSS_MASK = 147456;
#ifndef PROBE_NSA
#define PROBE_NSA 0u
#endif
#define NSA_T() (PROBE_NSA ? __builtin_amdgcn_s_memrealtime() : 0ull)
#define NSA_SPIN(bit, tsa) do { if (PROBE_NSA & (bit)) { const unsigned long long t1_ = __builtin_amdgcn_s_memrealtime(), te_ = t1_ + (t1_ - (tsa)); while (__builtin_amdgcn_s_memrealtime() < te_) __builtin_amdgcn_s_sleep(8); } } while (0)
__device__ __forceinline__ void nsa_unit(LAS unsigned char* lds, const NsaBufs& B, int t0, int tid) {
    const unsigned long long tsA = NSA_T();
    const int lane = tid & 63, wid = __builtin_amdgcn_readfirstlane(tid >> 6), r32 = lane & 31, hi = lane >> 5;
    LAS unsigned* imp = (LAS unsigned*)(lds + NSA_IMP);
    LAS int* sel = (LAS int*)(lds + NSA_SEL);
    const int hrow = r32 >> 3, tq = t0 + 8 * wid + (r32 & 7), imax = tq >= 31 ? ((tq - 31) >> 4) : -1;
    const int tmaxu = t0 + 63, ntile = tmaxu >= 31 ? ((((tmaxu - 31) >> 4)) >> 6) + 1 : 0;
    const int iwmax = (t0 + 8 * wid + 7) >= 31 ? ((t0 + 8 * wid + 7 - 31) >> 4) : -1;
    const int iwmin = (t0 + 8 * wid) >= 31 ? ((t0 + 8 * wid - 31) >> 4) : -1;
    bf16x8_t qf[4];
#pragma unroll
    for (int d0 = 0; d0 < 4; ++d0) qf[d0] = *(const bf16x8_t*)(B.NQ + (size_t)tq * 256 + hrow * 64 + 16 * d0 + 8 * hi);
    for (int e = tid; e < 64 * 257; e += NTHREADS) imp[e] = 0u;
    const int kc = tid & 7, kkey = tid >> 3, vdt = (tid & 7) >> 2, vkey = tid >> 3, vpart = tid & 3;
    const int kdst = kc * 1024 + ((kkey + 2 * kc) & 63) * 16, vdst = 12288 + vdt * 4096 + vkey * 64 + vpart * 16;
    int kfo[4];
#pragma unroll
    for (int d0 = 0; d0 < 4; ++d0) kfo[d0] = (2 * d0 + hi) * 1024 + ((r32 + 4 * d0 + 2 * hi) & 63) * 16;
    const int vfo = 12288 + (4 * hi + ((lane & 15) >> 2)) * 64 + ((lane >> 4) & 1) * 32 + (lane & 3) * 8;
    float m = -INFINITY, l = 0.f, invl = 0.f;
    v4u kreg, vreg;
#define CMP_LOAD(kt) do { kreg = *(const v4u*)(B.KC + (size_t)((kt) * 64 + kkey) * 64 + kc * 8); vreg = *(const v4u*)(B.VC + (size_t)((kt) * 64 + vkey) * 64 + vdt * 32 + vpart * 8); } while (0)
#define CMP_STORE(buf) do { LAS unsigned char* b_ = lds + (buf) * ATT_BUF; *(LAS v4u*)(b_ + kdst) = kreg; *(LAS v4u*)(b_ + vdst) = vreg; } while (0)
#define CMP_SCORES() f32x16 p0, p1; _Pragma("unroll") for (int r = 0; r < 16; ++r) { p0[r] = 0.f; p1[r] = 0.f; } \
        _Pragma("unroll") for (int d0 = 0; d0 < 4; ++d0) { const bf16x8_t k0 = *(const LAS bf16x8_t*)(bf + kfo[d0]), k1 = *(const LAS bf16x8_t*)(bf + (kfo[d0] ^ 512)); \
            p0 = __builtin_amdgcn_mfma_f32_32x32x16_bf16(k0, qf[d0], p0, 0, 0, 0); p1 = __builtin_amdgcn_mfma_f32_32x32x16_bf16(k1, qf[d0], p1, 0, 0, 0); } \
        if (kbase + 63 > iwmin) { asm volatile("" ::: "memory");     \
        _Pragma("unroll") for (int r = 0; r < 16; ++r) { const int key = kbase + (r & 3) + 8 * (r >> 2) + 4 * hi; if (key > imax) p0[r] = -INFINITY; if (key + 32 > imax) p1[r] = -INFINITY; } }
    if (ntile > 0) {
        f32x16 o0, o1;
#pragma unroll
        for (int r = 0; r < 16; ++r) { o0[r] = 0.f; o1[r] = 0.f; }
        CMP_LOAD(0); CMP_STORE(0);
        __syncthreads();
        for (int kt = 0; kt < ntile; ++kt) {
            const LAS unsigned char* bf = lds + (kt & 1) * ATT_BUF;
            if (kt + 1 < ntile) CMP_LOAD(kt + 1);
            const int kbase = 64 * kt;
            if (kbase <= iwmax) {
                CMP_SCORES();
                float mx = fmaxf(p0[0], p1[0]);
#pragma unroll
                for (int r = 1; r < 16; ++r) mx = fmaxf(mx, fmaxf(p0[r], p1[r]));
                mx = xhalf_max(mx);
                const float mn = fmaxf(m, mx), msub = (mn == -INFINITY) ? 0.f : mn, alpha = __builtin_amdgcn_exp2f(m - msub); m = mn;
                float ps = 0.f;
#pragma unroll
                for (int r = 0; r < 16; ++r) { p0[r] = __builtin_amdgcn_exp2f(p0[r] - msub); p1[r] = __builtin_amdgcn_exp2f(p1[r] - msub); ps += p0[r] + p1[r]; }
                l = l * alpha + ps;
#pragma unroll
                for (int r = 0; r < 16; ++r) { o0[r] *= alpha; o1[r] *= alpha; }
                bf16x8_t pw[4];
#pragma unroll
                for (int ks = 0; ks < 4; ++ks) { v4u w;
                    if (ks < 2) { w.x = pk2(p0[8 * ks], p0[8 * ks + 1]); w.y = pk2(p0[8 * ks + 2], p0[8 * ks + 3]); w.z = pk2(p0[8 * ks + 4], p0[8 * ks + 5]); w.w = pk2(p0[8 * ks + 6], p0[8 * ks + 7]); }
                    else { const int k2 = ks - 2; w.x = pk2(p1[8 * k2], p1[8 * k2 + 1]); w.y = pk2(p1[8 * k2 + 2], p1[8 * k2 + 3]); w.z = pk2(p1[8 * k2 + 4], p1[8 * k2 + 5]); w.w = pk2(p1[8 * k2 + 6], p1[8 * k2 + 7]); }
                    pw[ks] = __builtin_bit_cast(bf16x8_t, w); }
#pragma unroll
                for (int ks = 0; ks < 4; ++ks) {
#pragma unroll
                    for (int dt = 0; dt < 2; ++dt) { const s16x4_t a = lds_tr16(bf + vfo + dt * 4096 + ks * 1024), b = lds_tr16(bf + vfo + dt * 4096 + ks * 1024 + 512);
                        bf16x8_t vf; vf[0] = a[0]; vf[1] = a[1]; vf[2] = a[2]; vf[3] = a[3]; vf[4] = b[0]; vf[5] = b[1]; vf[6] = b[2]; vf[7] = b[3];
                        if (dt == 0) o0 = __builtin_amdgcn_mfma_f32_32x32x16_bf16(vf, pw[ks], o0, 0, 0, 0); else o1 = __builtin_amdgcn_mfma_f32_32x32x16_bf16(vf, pw[ks], o1, 0, 0, 0); } }
            }
            if (kt + 1 < ntile) CMP_STORE((kt + 1) & 1);
            __syncthreads();
        }
        const float lt = xhalf_sum(l); invl = lt > 0.f ? 1.f / lt : 0.f;
        { u16* orow = B.OCMP + (size_t)tq * 256 + hrow * 64;
#pragma unroll
          for (int a4 = 0; a4 < 4; ++a4) { v2u w0, w1; w0.x = pk2(o0[4 * a4] * invl, o0[4 * a4 + 1] * invl); w0.y = pk2(o0[4 * a4 + 2] * invl, o0[4 * a4 + 3] * invl);
              w1.x = pk2(o1[4 * a4] * invl, o1[4 * a4 + 1] * invl); w1.y = pk2(o1[4 * a4 + 2] * invl, o1[4 * a4 + 3] * invl);
              *(v2u*)(orow + 8 * a4 + 4 * hi) = w0; *(v2u*)(orow + 32 + 8 * a4 + 4 * hi) = w1; } }
        const float msub2 = (m == -INFINITY) ? 0.f : m;
        LAS unsigned* impq = imp + (8 * wid + (r32 & 7)) * 257;
        CMP_LOAD(0); CMP_STORE(0);
        __syncthreads();
        for (int kt = 0; kt < ntile; ++kt) {
            const LAS unsigned char* bf = lds + (kt & 1) * ATT_BUF;
            if (kt + 1 < ntile) CMP_LOAD(kt + 1);
            const int kbase = 64 * kt;
            if (kbase <= iwmax) {
                CMP_SCORES();
#pragma unroll
                for (int r = 0; r < 16; ++r) { p0[r] = __builtin_amdgcn_exp2f(p0[r] - msub2) * invl; p1[r] = __builtin_amdgcn_exp2f(p1[r] - msub2) * invl; }
#pragma unroll
                for (int a4 = 0; a4 < 4; ++a4) {
                    float g0 = (p0[4 * a4] + p0[4 * a4 + 1]) + (p0[4 * a4 + 2] + p0[4 * a4 + 3]), e0 = p0[4 * a4 + 3];
                    float g1 = (p1[4 * a4] + p1[4 * a4 + 1]) + (p1[4 * a4 + 2] + p1[4 * a4 + 3]), e1 = p1[4 * a4 + 3];
                    g0 += __shfl_xor(g0, 8); e0 += __shfl_xor(e0, 8); g1 += __shfl_xor(g1, 8); e1 += __shfl_xor(e1, 8);
                    g0 += __shfl_xor(g0, 16); e0 += __shfl_xor(e0, 16); g1 += __shfl_xor(g1, 16); e1 += __shfl_xor(e1, 16);
                    if (hrow == 0) {
                        { const int jg = (kbase >> 2) + 2 * a4 + hi;
                          __hip_atomic_fetch_add(impq + jg, (unsigned)(g0 * 67108864.f + 0.5f), __ATOMIC_RELAXED, __HIP_MEMORY_SCOPE_WORKGROUP);
                          if (jg + 1 < 256) __hip_atomic_fetch_add(impq + jg + 1, (unsigned)(e0 * 67108864.f + 0.5f), __ATOMIC_RELAXED, __HIP_MEMORY_SCOPE_WORKGROUP); }
                        { const int jg = (kbase >> 2) + 8 + 2 * a4 + hi;
                          __hip_atomic_fetch_add(impq + jg, (unsigned)(g1 * 67108864.f + 0.5f), __ATOMIC_RELAXED, __HIP_MEMORY_SCOPE_WORKGROUP);
                          if (jg + 1 < 256) __hip_atomic_fetch_add(impq + jg + 1, (unsigned)(e1 * 67108864.f + 0.5f), __ATOMIC_RELAXED, __HIP_MEMORY_SCOPE_WORKGROUP); } } }
            }
            if (kt + 1 < ntile) CMP_STORE((kt + 1) & 1);
            __syncthreads();
        }
    } else {
        u16* orow = B.OCMP + (size_t)tq * 256 + hrow * 64;
#pragma unroll
        for (int a4 = 0; a4 < 4; ++a4) { *(v2u*)(orow + 8 * a4 + 4 * hi) = (v2u){0u, 0u}; *(v2u*)(orow + 32 + 8 * a4 + 4 * hi) = (v2u){0u, 0u}; }
        __syncthreads();
    }
#undef CMP_LOAD
#undef CMP_STORE
#undef CMP_SCORES
    NSA_SPIN(1u, tsA); const unsigned long long tsB = NSA_T();
    for (int qi = 0; qi < 8; ++qi) { const int q = 8 * wid + qi, t = t0 + q, tb = t >> 6; unsigned sc[4];
#pragma unroll
        for (int k = 0; k < 4; ++k) { const int j = lane + 64 * k; const unsigned v = imp[q * 257 + j]; const bool forced = (j == 0) || (j == tb) || (j == tb - 1);
            sc[k] = forced ? 0xFFFFFFFFu : (j <= tb ? (v < 0xFFFFFFF0u ? v : 0xFFFFFFF0u) + 2u : 1u); }
        unsigned cand = 0u;
        for (int bit = 31; bit >= 0; --bit) { const unsigned tr = cand | (1u << bit);
            const int cnt = __builtin_popcountll(__ballot(sc[0] >= tr)) + __builtin_popcountll(__ballot(sc[1] >= tr)) + __builtin_popcountll(__ballot(sc[2] >= tr)) + __builtin_popcountll(__ballot(sc[3] >= tr));
            if (cnt >= 16) cand = tr; }
        const unsigned long long below = (1ull << lane) - 1ull;
        int ngt = 0;
#pragma unroll
        for (int k = 0; k < 4; ++k) ngt += __builtin_popcountll(__ballot(sc[k] > cand));
        const int need = 16 - ngt; int eqseen = 0, pos = 0;
#pragma unroll
        for (int k = 0; k < 4; ++k) { const bool gt = sc[k] > cand, eq = sc[k] == cand; const unsigned long long me = __ballot(eq);
            const bool take = gt || (eq && (eqseen + __builtin_popcountll(me & below)) < need);
            const unsigned long long mt = __ballot(take);
            if (take) sel[q * 16 + pos + __builtin_popcountll(mt & below)] = lane + 64 * k;
            eqseen += __builtin_popcountll(me); pos += __builtin_popcountll(mt); }
    }
    NSA_SPIN(2u, tsB);
    __syncthreads();
    const unsigned long long tsC = NSA_T();
    { const int col = lane & 15, kg = lane >> 4, hcol = col & 3, slot = col >> 2, tb = t0 >> 6, nbq = tb + 1 < 16 ? tb + 1 : 16;
      LAS int* oaccL = (LAS int*)lds;
      LAS int* laccL = (LAS int*)(lds + 66560);
      LAS int* maxbL = (LAS int*)(lds + 66560);
      LAS float* lutL = (LAS float*)(lds + 67584);
      LAS unsigned* maskw = (LAS unsigned*)(lds + 100352);
      LAS int* goff = (LAS int*)(lds + 102400);
      for (int e = tid; e < 16640 + 256; e += NTHREADS) oaccL[e] = 0;
      ((LAS int*)(lds + 104448))[tid] = (int)0x80000000;
      for (int e = tid; e < 4 * 2048; e += NTHREADS) lutL[e] = B.LUTN[e];
      LAS unsigned char* qL = lds + 106496;
      for (int e = tid; e < 2048; e += NTHREADS) { const int pair = e >> 3, ch = e & 7; *(LAS v4u*)(qL + pair * 144 + ch * 16) = *(const v4u*)(B.NQ + (size_t)(t0 + (pair >> 2)) * 256 + (pair & 3) * 64 + ch * 8); }
      maskw[tid] = 0u;
      __syncthreads();
#pragma unroll
      for (int pp = 0; pp < 2; ++pp) { const int p = tid + 512 * pp, q = p >> 4, r = p & 15;
          if (r < nbq) { const int blk = sel[q * 16 + r]; __hip_atomic_fetch_or(maskw + blk * 2 + (q >> 5), 1u << (q & 31), __ATOMIC_RELAXED, __HIP_MEMORY_SCOPE_WORKGROUP); } }
      __syncthreads();
      if (wid == 0) {
          int ng[4], tot = 0;
#pragma unroll
          for (int k = 0; k < 4; ++k) { const int j = 4 * lane + k; ng[k] = (__builtin_popcount(maskw[2 * j]) + __builtin_popcount(maskw[2 * j + 1]) + 3) >> 2; tot += ng[k]; }
          int inc = tot;
#pragma unroll
          for (int o = 1; o < 64; o <<= 1) { const int v = __shfl_up(inc, o); if (lane >= o) inc += v; }
          int ex = inc - tot;
#pragma unroll
          for (int k = 0; k < 4; ++k) { goff[4 * lane + k] = ex; ex += ng[k]; }
          if (lane == 63) goff[256] = inc; }
      __syncthreads();
      const int NG = goff[256];
#define ITEM_DECODE(idx_, JP, BLK, QME, VAL) do { while (goff[JP + 1] <= (idx_)) ++JP; BLK = JP; const int g_ = (idx_) - goff[JP]; \
          unsigned long long mm_ = ((unsigned long long)(unsigned)__builtin_amdgcn_readfirstlane((int)maskw[2 * JP + 1]) << 32) | (unsigned)__builtin_amdgcn_readfirstlane((int)maskw[2 * JP]); \
          for (int k_ = 0; k_ < 4 * g_; ++k_) mm_ &= mm_ - 1ull; \
          int q0_ = __builtin_ctzll(mm_); mm_ &= mm_ - 1ull; int q1_ = mm_ ? __builtin_ctzll(mm_) : -1; if (mm_) mm_ &= mm_ - 1ull; int q2_ = mm_ ? __builtin_ctzll(mm_) : -1; if (mm_) mm_ &= mm_ - 1ull; int q3_ = mm_ ? __builtin_ctzll(mm_) : -1; \
          const int qs_ = slot == 0 ? q0_ : (slot == 1 ? q1_ : (slot == 2 ? q2_ : q3_)); VAL = qs_ >= 0; QME = VAL ? qs_ : q0_; } while (0)
#define SEL_LOADK(KF, blk_) do { const u16* kr = B.KSEL + (size_t)(blk_) * 4096 + kg * 512 + col * 8; \
          _Pragma("unroll") for (int mt = 0; mt < 4; ++mt) { KF[mt][0] = *(const bf16x8_t*)(kr + mt * 128); KF[mt][1] = *(const bf16x8_t*)(kr + mt * 128 + 2048); } } while (0)
#define SEL_LOADV(VF, blk_) do { const u16* vr = B.VSELT + (size_t)(blk_) * 4096 + kg * 512 + col * 8; \
          _Pragma("unroll") for (int d = 0; d < 4; ++d) _Pragma("unroll") for (int s2 = 0; s2 < 2; ++s2) VF[d][s2] = *(const bf16x8_t*)(vr + d * 128 + 2048 * s2); } while (0)
#define SEL_LOADQ(QF, q_) do { const LAS unsigned char* qr = qL + ((q_) * 4 + hcol) * 144 + 16 * kg; QF[0] = *(const LAS bf16x8_t*)qr; QF[1] = *(const LAS bf16x8_t*)(qr + 64); } while (0)
#define SEL_SCORES(KF, QF, blk_, qme_) { const int tok0 = (blk_) * 64, t = t0 + (qme_); \
          _Pragma("unroll") for (int mt = 0; mt < 4; ++mt) { c[mt] = __builtin_amdgcn_mfma_f32_16x16x32_bf16(KF[mt][0], QF[0], (f32x4m){0.f, 0.f, 0.f, 0.f}, 0, 0, 0); \
              c[mt] = __builtin_amdgcn_mfma_f32_16x16x32_bf16(KF[mt][1], QF[1], c[mt], 0, 0, 0); } \
          const LAS float* lutH = lutL + hcol * 2048; \
          if (t0 - (tok0 + 63) >= 1513) { const float bfar = lutH[2047]; _Pragma("unroll") for (int mt = 0; mt < 4; ++mt) _Pragma("unroll") for (int e = 0; e < 4; ++e) c[mt][e] += bfar; } \
          else { const int dbase = t - tok0 - 4 * kg; _Pragma("unroll") for (int mt = 0; mt < 4; ++mt) _Pragma("unroll") for (int e = 0; e < 4; ++e) { const int d = dbase - 16 * mt - e; \
              const float bsv = lutH[d < 0 ? 0 : (d > 2047 ? 2047 : d)]; c[mt][e] = d >= 0 ? c[mt][e] + bsv : -INFINITY; } } }
      bf16x8_t kA[4][2], qA[2];
      { bf16x8_t vA[4][2];
        LAS int* Mb = (LAS int*)(lds + 104448);
        int jp = 0, idx = wid, blkc = 0, qmec = 0; bool valc = false, have = idx < NG;
        if (have) { ITEM_DECODE(idx, jp, blkc, qmec, valc); SEL_LOADK(kA, blkc); SEL_LOADQ(qA, qmec); SEL_LOADV(vA, blkc); }
        const int NR = (NG + 7) >> 3;
        for (int r = 0; r < NR; ++r) {
            LAS int* Mc = Mb + (r & 1) * 256; LAS int* Mn = Mb + ((r + 1) & 1) * 256;
            f32x4m c[4];
#pragma unroll
            for (int mt = 0; mt < 4; ++mt) c[mt] = (f32x4m){0.f, 0.f, 0.f, 0.f};
            if (have) { SEL_SCORES(kA, qA, blkc, qmec);
                float mx = fmaxf(fmaxf(c[0][0], c[0][1]), fmaxf(c[0][2], c[0][3]));
#pragma unroll
                for (int mt = 1; mt < 4; ++mt) mx = fmaxf(mx, fmaxf(fmaxf(c[mt][0], c[mt][1]), fmaxf(c[mt][2], c[mt][3])));
                mx = fmaxf(mx, __shfl_xor(mx, 16)); mx = fmaxf(mx, __shfl_xor(mx, 32));
                if (kg == 0 && valc) { const int bi_ = __float_as_int(mx); __hip_atomic_fetch_max(Mc + qmec * 4 + hcol, bi_ >= 0 ? bi_ : (bi_ ^ 0x7fffffff), __ATOMIC_RELAXED, __HIP_MEMORY_SCOPE_WORKGROUP); } }
            int blkn = 0, qmen = 0; bool valn = false; const bool haven = idx + 8 < NG;
            if (haven) { ITEM_DECODE(idx + 8, jp, blkn, qmen, valn); SEL_LOADK(kA, blkn); SEL_LOADQ(qA, qmen); }
            asm volatile("s_waitcnt lgkmcnt(0)" ::: "memory"); __builtin_amdgcn_s_barrier(); asm volatile("" ::: "memory");
            { const int pair = wid * 32 + (lane & 31); const int mo = Mn[pair], mn = Mc[pair]; const bool chg = lane < 32 && mn != mo;
              if (chg) Mn[pair] = mn;
              unsigned long long need = __ballot(chg && mo != (int)0x80000000);
              while (need) { const int L = __builtin_ctzll(need); need &= need - 1ull;
                  const int mo_ = __builtin_amdgcn_readlane(mo, L), mn_ = __builtin_amdgcn_readlane(mn, L); const int pr = wid * 32 + L;
                  const float f = __builtin_amdgcn_exp2f(__int_as_float(mo_ >= 0 ? mo_ : (mo_ ^ 0x7fffffff)) - __int_as_float(mn_ >= 0 ? mn_ : (mn_ ^ 0x7fffffff)));
                  LAS int* a = oaccL + pr * 65; a[lane] = (int)rintf((float)a[lane] * f);
                  if (lane == 0) laccL[pr] = (int)rintf((float)laccL[pr] * f); } }
            asm volatile("s_waitcnt lgkmcnt(0)" ::: "memory"); __builtin_amdgcn_s_barrier(); asm volatile("" ::: "memory");
            if (have) {
                const int mb_ = Mc[qmec * 4 + hcol]; const float mrow = __int_as_float(mb_ >= 0 ? mb_ : (mb_ ^ 0x7fffffff));
                float ps = 0.f;
#pragma unroll
                for (int mt = 0; mt < 4; ++mt)
#pragma unroll
                    for (int e = 0; e < 4; ++e) { c[mt][e] = __builtin_amdgcn_exp2f(c[mt][e] - mrow); ps += c[mt][e]; }
                ps += __shfl_xor(ps, 16); ps += __shfl_xor(ps, 32);
                if (kg == 0 && valc) __hip_atomic_fetch_add(laccL + qmec * 4 + hcol, (int)(ps * 1048576.f + 0.5f), __ATOMIC_RELAXED, __HIP_MEMORY_SCOPE_WORKGROUP);
                bf16x8_t pB[2];
#pragma unroll
                for (int s2 = 0; s2 < 2; ++s2) { v4u w; w.x = pk2(c[2 * s2][0], c[2 * s2][1]); w.y = pk2(c[2 * s2][2], c[2 * s2][3]); w.z = pk2(c[2 * s2 + 1][0], c[2 * s2 + 1][1]); w.w = pk2(c[2 * s2 + 1][2], c[2 * s2 + 1][3]);
                    pB[s2] = __builtin_bit_cast(bf16x8_t, w); }
                LAS int* od_ = oaccL + (qmec * 4 + hcol) * 65 + 4 * kg;
#pragma unroll
                for (int d = 0; d < 4; ++d) { f32x4m oa_ = __builtin_amdgcn_mfma_f32_16x16x32_bf16(vA[d][0], pB[0], (f32x4m){0.f, 0.f, 0.f, 0.f}, 0, 0, 0);
                    oa_ = __builtin_amdgcn_mfma_f32_16x16x32_bf16(vA[d][1], pB[1], oa_, 0, 0, 0);
                    if (valc) {
#pragma unroll
                        for (int e = 0; e < 4; ++e) __hip_atomic_fetch_add(od_ + 16 * d + e, (int)rintf(oa_[e] * 16384.f), __ATOMIC_RELAXED, __HIP_MEMORY_SCOPE_WORKGROUP); } } }
            if (haven) SEL_LOADV(vA, blkn);
            idx += 8; blkc = blkn; qmec = qmen; valc = valn; have = haven;
        }
      }
#undef ITEM_DECODE
#undef SEL_LOADK
#undef SEL_LOADV
#undef SEL_LOADQ
#undef SEL_SCORES
      __syncthreads();
      { const int q = tid >> 3, hh = (tid & 7) >> 1, d0 = 32 * (tid & 1); const float inv = 1048576.f / (16384.f * (float)laccL[q * 4 + hh]);
        const LAS int* src = oaccL + (q * 4 + hh) * 65 + d0; u16* dst = B.OSEL + (size_t)(t0 + q) * 256 + hh * 64 + d0;
#pragma unroll
        for (int i = 0; i < 4; ++i) { v4u w; w.x = pk2((float)src[8 * i] * inv, (float)src[8 * i + 1] * inv); w.y = pk2((float)src[8 * i + 2] * inv, (float)src[8 * i + 3] * inv);
            w.z = pk2((float)src[8 * i + 4] * inv, (float)src[8 * i + 5] * inv); w.w = pk2((float)src[8 * i + 6] * inv, (float)src[8 * i + 7] * inv); *(v4u*)(dst + 8 * i) = w; } }
    }
    NSA_SPIN(4u, tsC); const unsigned long long tsD = NSA_T();
    asm volatile("s_waitcnt vmcnt(0)" ::: "memory");
    __syncthreads();
    __builtin_amdgcn_fence(__ATOMIC_ACQUIRE, "agent");
    asm volatile("s_waitcnt vmcnt(0)" ::: "memory");
    { const int tl = tid >> 3, sub = tid & 7, t = t0 + tl;
      u16* oa = B.OA + (size_t)t * 512;
      if (sub < 4) { const int hh = sub;
          const float l0 = B.LSED[((size_t)0 * S + t) * 4 + hh], l1 = B.LSED[((size_t)1 * S + t) * 4 + hh], l2 = B.LSED[((size_t)2 * S + t) * 4 + hh];
          const float lm = fmaxf(l0, fmaxf(l1, l2)); float w0 = __builtin_amdgcn_exp2f(l0 - lm), w1 = __builtin_amdgcn_exp2f(l1 - lm), w2 = __builtin_amdgcn_exp2f(l2 - lm);
          const float ws = 1.f / (w0 + w1 + w2); w0 *= ws; w1 *= ws; w2 *= ws;
          const u16* s0 = B.ODIL + ((size_t)0 * S + t) * 256 + hh * 64; const u16* s1 = B.ODIL + ((size_t)1 * S + t) * 256 + hh * 64; const u16* s2 = B.ODIL + ((size_t)2 * S + t) * 256 + hh * 64;
#pragma unroll
          for (int i = 0; i < 8; ++i) { const v4u a = *(const v4u*)(s0 + 8 * i), b = *(const v4u*)(s1 + 8 * i), c = *(const v4u*)(s2 + 8 * i); v4u o;
              o.x = pk2(w0 * bflo(a.x) + w1 * bflo(b.x) + w2 * bflo(c.x), w0 * bfhi(a.x) + w1 * bfhi(b.x) + w2 * bfhi(c.x));
              o.y = pk2(w0 * bflo(a.y) + w1 * bflo(b.y) + w2 * bflo(c.y), w0 * bfhi(a.y) + w1 * bfhi(b.y) + w2 * bfhi(c.y));
              o.z = pk2(w0 * bflo(a.z) + w1 * bflo(b.z) + w2 * bflo(c.z), w0 * bfhi(a.z) + w1 * bfhi(b.z) + w2 * bfhi(c.z));
              o.w = pk2(w0 * bflo(a.w) + w1 * bflo(b.w) + w2 * bflo(c.w), w0 * bfhi(a.w) + w1 * bfhi(b.w) + w2 * bfhi(c.w));
              *(v4u*)(oa + hh * 64 + 8 * i) = o; }
      } else { const int hh = sub - 4; const float* gp = B.GATE + (size_t)t * 16 + hh * 3; const float g0 = gp[0], g1 = gp[1], g2 = gp[2];
          const u16* s0 = B.OCMP + (size_t)t * 256 + hh * 64; const u16* s1 = B.OSEL + (size_t)t * 256 + hh * 64; const u16* s2 = B.OWIN + (size_t)t * 256 + hh * 64;
#pragma unroll
          for (int i = 0; i < 8; ++i) { const v4u a = *(const v4u*)(s0 + 8 * i), b = *(const v4u*)(s1 + 8 * i), c = *(const v4u*)(s2 + 8 * i); v4u o;
              o.x = pk2(g0 * bflo(a.x) + g1 * bflo(b.x) + g2 * bflo(c.x), g0 * bfhi(a.x) + g1 * bfhi(b.x) + g2 * bfhi(c.x));
              o.y = pk2(g0 * bflo(a.y) + g1 * bflo(b.y) + g2 * bflo(c.y), g0 * bfhi(a.y) + g1 * bfhi(b.y) + g2 * bfhi(c.y));
              o.z = pk2(g0 * bflo(a.z) + g1 * bflo(b.z) + g2 * bflo(c.z), g0 * bfhi(a.z) + g1 * bfhi(b.z) + g2 * bfhi(c.z));
              o.w = pk2(g0 * bflo(a.w) + g1 * bflo(b.w) + g2 * bflo(c.w), g0 * bfhi(a.w) + g1 * bfhi(b.w) + g2 * bfhi(c.w));
              *(v4u*)(oa + 256 + hh * 64 + 8 * i) = o; }
      } }
    NSA_SPIN(8u, tsD);
    __syncthreads();
}

struct Args { const void* in[28]; float* out; unsigned char* ws; int ph_lo, ph_hi; };
typedef const __attribute__((address_space(4))) Args* KArgP;
__device__ __forceinline__ KArgP kargs() { KArgP p = (KArgP)__builtin_amdgcn_kernarg_segment_ptr(); asm volatile("" : "+s"(p)); return p; }
#define WSP(T, off) ((T*)(ws + (off)))
#define INP(k) ((const float*)ap->in[k])

#define IN(k) (kargs()->ph_lo <= (k) && (k) < kargs()->ph_hi)
#ifndef PROBE_EVEN
#define PROBE_EVEN 0u
#endif
#ifndef PROBE_ODD
#define PROBE_ODD 0u
#endif
#define PROBE_ON ((PROBE_EVEN | PROBE_ODD) != 0u)
#define PROBE_T0() const unsigned long long ts0_ = PROBE_ON ? __builtin_amdgcn_s_memrealtime() : 0ull; (void)ts0_
#define PROBE_SPIN(k) do { if (PROBE_ON && (k) == 0 && (PROBE_EVEN & 0x1000u)) { const unsigned long long t1_ = __builtin_amdgcn_s_memrealtime(), te_ = t1_ + (t1_ - ts0_); while (__builtin_amdgcn_s_memrealtime() < te_) __builtin_amdgcn_s_sleep(8); } \
    if (PROBE_ON && (k) >= 1) { const int kk_ = ((k) - 1) % 12, par_ = (((k) - 1) / 12) & 1; if (((par_ ? PROBE_ODD : PROBE_EVEN) >> kk_) & 1u) { \
        const unsigned long long t1_ = __builtin_amdgcn_s_memrealtime(), te_ = t1_ + (t1_ - ts0_); while (__builtin_amdgcn_s_memrealtime() < te_) __builtin_amdgcn_s_sleep(8); } } } while (0)
#define SEAM(k) do { if (IN((k) + 1)) { XcdBarrier b_; b_.bar = (unsigned*)(kargs()->ws + WS_CTL) + CW_BAR; b_.x = xb_xcc_id(); b_.st = (volatile LAS unsigned*)(lds + MISC_OFF) + 8; xcd_barrier(b_); } PROBE_SPIN(k); } while (0)
#define PHASE_IDS() int tid_l = threadIdx.x, bid_l = blockIdx.x, G_l = gridDim.x; asm volatile("" : "+v"(tid_l), "+s"(bid_l), "+s"(G_l)); \
    const int tid = tid_l, bid = bid_l, G = G_l, NGW = G * NWAVES, lane = tid & 63, wave = __builtin_amdgcn_readfirstlane(tid >> 6), gw = bid * NWAVES + wave; (void)NGW; \
    LAS float* wscr = (LAS float*)(lds + wave * 16384); (void)wscr; (void)gw; (void)lane; (void)tid
#define GEMM_IDS() int bid_l = blockIdx.x, G_l = gridDim.x; asm volatile("" : "+s"(bid_l), "+s"(G_l)); const int bid = bid_l, G = G_l


template <int li> __device__ __forceinline__ void layer_body(LAS unsigned char* lds) {
    constexpr int pb = 1 + li * 12, lj = li >> 1; constexpr bool even = (li & 1) == 0;
    constexpr size_t HBC = (li & 1) ? WS_HB2 : WS_HB, HBN = (li & 1) ? WS_HB : WS_HB2;
        if (IN(pb + 0)) { PROBE_T0();
            KArgP ap = kargs(); unsigned char* ws = ap->ws; PHASE_IDS();
            u16* W_in = WSP(u16, WS_W + W_IN); u16* W_out = WSP(u16, WS_W + W_OUT);
            int cursor = 0; const int gt = bid * NTHREADS + tid, NGT = G * NTHREADS;
            const float* g_pre = INP(19) + (size_t)li * DM;
            if (even) {
                const float* W = INP(4) + (size_t)lj * DM * EV_IN;
                ap = kargs(); cvt_job(W, EV_IN, DM, 0, 256, g_pre, W_in, 0, cursor, wscr, gw, NGW, lane);
                ap = kargs(); cvt_job(W, EV_IN, DM, 256, 128, g_pre, W_in, 256, cursor, wscr, gw, NGW, lane);
                ap = kargs(); cvt_job(W, EV_IN, DM, 384, 32, g_pre, W_in, 384, cursor, wscr, gw, NGW, lane);
                ap = kargs(); cvt_job(W, EV_IN, DM, 1952, 8, g_pre, W_in, 416, cursor, wscr, gw, NGW, lane);
                ap = kargs(); cvt_job(W, EV_IN, DM, 416, 512, g_pre, W_in, 512, cursor, wscr, gw, NGW, lane);
                ap = kargs(); cvt_job(W, EV_IN, DM, 928, 512, g_pre, W_in, 1024, cursor, wscr, gw, NGW, lane);
                ap = kargs(); cvt_job(W, EV_IN, DM, 1440, 512, g_pre, W_in, 1536, cursor, wscr, gw, NGW, lane);
                for (int idx = gt; idx < (512 - 424) * DM / 8; idx += NGT) ((v4u*)(W_in + (size_t)424 * DM))[idx] = (v4u){0u, 0u, 0u, 0u};
                ap = kargs(); cvt_job(INP(10) + (size_t)lj * DM * DM, DM, DM, 0, DM, nullptr, W_out, 0, cursor, wscr, gw, NGW, lane);
                u16* W_uq = WSP(u16, WS_W + W_UQ); u16* W_ukv = WSP(u16, WS_W + W_UKV);
                const float* wuq = INP(6) + (size_t)lj * 256 * 768; const float* qn = INP(5) + lj * 256;
                for (int idx = gt; idx < 768 * 256; idx += NGT) { const int n = idx >> 8, k = idx & 255; int col;
                    if (n < 512) col = (n >> 6) * 96 + (n & 63); else { const int r = n - 512, hh = r >> 5, grp = (r & 31) >> 3, e = r & 7; col = hh * 96 + 64 + (e < 4 ? 4 * grp + e : 16 + 4 * grp + e - 4); }
                    W_uq[idx] = (u16)f2bf(wuq[(size_t)k * 768 + col] * qn[k]); }
                const float* wukv = INP(8) + (size_t)lj * 128 * 1024; const float* kvn = INP(7) + lj * 128;
                for (int idx = gt; idx < 1024 * 128; idx += NGT) { const int n = idx >> 7, k = idx & 127; int col;
                    if (n < 512) col = (n >> 6) * 128 + (n & 63); else { const int r = n - 512; col = (r >> 6) * 128 + 64 + (r & 63); }
                    W_ukv[idx] = (u16)f2bf(wukv[(size_t)k * 1024 + col] * kvn[k]); }
            } else {
                const float* W = INP(11) + (size_t)lj * DM * OD_IN;
                ap = kargs(); cvt_job(W, OD_IN, DM, 0, OD_IN, g_pre, W_in, 0, cursor, wscr, gw, NGW, lane);
                for (int idx = gt; idx < (3072 - OD_IN) * DM / 8; idx += NGT) ((v4u*)(W_in + (size_t)OD_IN * DM))[idx] = (v4u){0u, 0u, 0u, 0u};
                ap = kargs(); cvt_job(INP(18) + (size_t)lj * 512 * DM, DM, 512, 0, DM, nullptr, W_out, 0, cursor, wscr, gw, NGW, lane);
                ap = kargs(); cvt_job(INP(14) + (size_t)lj * 2048 * 256, 256, 2048, 0, 256, nullptr, WSP(u16, WS_C1), 0, cursor, wscr, gw, NGW, lane);
                ap = kargs(); cvt_job(INP(16) + (size_t)lj * 2048 * 256, 256, 2048, 0, 256, nullptr, WSP(u16, WS_C1) + 256 * 2048, 0, cursor, wscr, gw, NGW, lane);
                { ap = kargs(); float* C1 = WSP(float, WS_C1 + 2 * MiB);
                  for (int o = gw; o < 512; o += NGW) { const int c = o >> 8, n = o & 255; const float* pos = INP(c ? 13 : 12) + (size_t)lj * 2048; const float* w1 = INP(c ? 16 : 14) + (size_t)lj * 2048 * 256;
                      float acc = 0.f; for (int k = lane; k < 2048; k += 64) acc += pos[k] * w1[(size_t)k * 256 + n];
                      acc = wave_sum(acc); if (lane == 0) C1[o] = acc; } }
            }
            ap = kargs(); cvt_job(INP(23) + (size_t)li * DM * DFF, DFF, DM, 0, DFF, INP(21) + (size_t)li * DM, WSP(u16, WS_W + W_UP), 0, cursor, wscr, gw, NGW, lane);
            ap = kargs(); cvt_job(INP(24) + (size_t)li * DFF * DM, DM, DFF, 0, DM, nullptr, WSP(u16, WS_W + W_DN), 0, cursor, wscr, gw, NGW, lane);
            ap = kargs(); cvt_job(INP(26) + (size_t)li * DM * DM, DM, DM, 0, DM, INP(25) + (size_t)li * DM, WSP(u16, WS_W + W_PG), 0, cursor, wscr, gw, NGW, lane);
            ap = kargs(); cvt_job(INP(27) + (size_t)li * PLE * DM, DM, PLE, 0, DM, nullptr, WSP(u16, WS_W + W_PP), 0, cursor, wscr, gw, NGW, lane);
            const v4f* ps = (const v4f*)(INP(1) + (size_t)li * S * PLE); v2u* PB2 = WSP(v2u, WS_PB);
            for (int idx = gt; idx < S * PLE / 4; idx += NGT) { const v4f v = ps[idx]; v2u w; w.x = pk2(v.x, v.y); w.y = pk2(v.z, v.w); PB2[idx] = w; }
            SEAM(pb + 0);
        }
        if (even) {
            if (IN(pb + 1)) { PROBE_T0();
                KArgP ap = kargs(); unsigned char* ws = ap->ws; GEMM_IDS();
                pg8::Gemm g{WSP(u16, HBC), WSP(u16, WS_W + W_IN), S, 2048, DM}; pg8::StaticOrder So; So.init(S, 2048, G, bid);
                EpiEvenIn E{WSP(float, WS_MIX), WSP(u16, WS_A + A_FQ), li == 0 ? WSP(float, WS_LUT + OFF_RSA) : WSP(float, WS_RSP), li != 0};
                pg8::gemm_phase<EpiEvenIn, pg8::StaticOrder, true, true>(lds, g, So, E);
                SEAM(pb + 1);
            }
            if (IN(pb + 2)) { PROBE_T0();
                KArgP ap = kargs(); unsigned char* ws = ap->ws; PHASE_IDS();
                const float* CQKV = WSP(float, WS_MIX); const float* CS = WSP(float, WS_CS); u16* CQN = WSP(u16, WS_A + A_CQN); u16* CKVN = WSP(u16, WS_A + A_CKVN); u16* KM = WSP(u16, WS_A + A_KM);
                float* LOGF = WSP(float, WS_LUT + OFF_LOGF); float* CT = WSP(float, WS_LUT + OFF_CT);
                const float* fb = INP(9) + lj * 8;
                LAS float* lf = (LAS float*)(lds + 131072 - 4096);
                if (bid == 0 && tid < 16) WSP(unsigned, WS_LUT + OFF_QKN)[tid] = 0u;
                for (int c = bid; c < S / 64; c += G) if (tid < 16) WSP(unsigned, WS_LUT + (tid < 8 ? OFF_KNT : OFF_QNC))[c * 8 + (tid & 7)] = 0u;
                for (int c = bid; c < S / 64; c += G) {
                    for (int jr = 0; jr < 8; ++jr) { const int rl = wave * 8 + jr, t = c * 64 + rl; const float* cr = CQKV + (size_t)t * 512;
                        { const v4f v = *((const v4f*)cr + lane); const float ss = wave_sum(v.x * v.x + v.y * v.y + v.z * v.z + v.w * v.w); const float r = rsqrtf(ss * (1.f / 256) + RMS_EPS);
                          v2u w; w.x = pk2(v.x * r, v.y * r); w.y = pk2(v.z * r, v.w * r); *((v2u*)(CQN + (size_t)t * 256) + lane) = w; }
                        { const v2f v = *((const v2f*)(cr + 256) + lane); const float ss = wave_sum(v.x * v.x + v.y * v.y); const float r = rsqrtf(ss * (1.f / 128) + RMS_EPS);
                          *((unsigned*)(CKVN + (size_t)t * 128) + lane) = pk2(v.x * r, v.y * r); }
                        if (lane < 16) { const float x1 = cr[384 + lane], x2 = cr[400 + lane], cs = CS[(size_t)t * 32 + lane], sn = CS[(size_t)t * 32 + 16 + lane];
                            const u16 o1 = (u16)f2bf(x1 * cs - x2 * sn), o2 = (u16)f2bf(x2 * cs + x1 * sn);
#pragma unroll
                            for (int hh = 0; hh < 8; ++hh) { KM[(size_t)t * 768 + hh * 96 + 64 + lane] = o1; KM[(size_t)t * 768 + hh * 96 + 80 + lane] = o2; } }
                        if (lane < 8) { const float z = cr[416 + lane] + fb[lane]; lf[rl * 8 + lane] = fminf(z, 0.f) - log1pf(__expf(-fabsf(z))); } }
                    __syncthreads();
                    if (tid < 8) { float acc = 0.f; for (int r = 0; r < 64; ++r) { acc += lf[r * 8 + tid]; LOGF[(size_t)(c * 64 + r) * 8 + tid] = acc; } CT[c * 8 + tid] = acc; }
                    __syncthreads();
                }
                SEAM(pb + 2);
            }
            if (IN(pb + 3)) { PROBE_T0();
                { KArgP ap = kargs(); unsigned char* ws = ap->ws; PHASE_IDS();
                  const float* LOGF = WSP(float, WS_LUT + OFF_LOGF); const float* CT = WSP(float, WS_LUT + OFF_CT); float* CUM = WSP(float, WS_A + A_CUM);
                  const u16* FQ = WSP(u16, WS_A + A_FQ); const u16* FK = WSP(u16, WS_A + A_FK); unsigned* QKN = WSP(unsigned, WS_LUT + OFF_QKN);
                  for (int c = bid; c < S / 64; c += G) {
                      float qm = 0.f, km = 0.f;
                      for (int jr = 0; jr < 8; ++jr) { const size_t t = (size_t)c * 64 + wave * 8 + jr; const v4u a = *((const v4u*)(FQ + t * 512) + lane), b = *((const v4u*)(FK + t * 512) + lane);
                          float sq = bflo(a.x) * bflo(a.x) + bfhi(a.x) * bfhi(a.x) + bflo(a.y) * bflo(a.y) + bfhi(a.y) * bfhi(a.y) + bflo(a.z) * bflo(a.z) + bfhi(a.z) * bfhi(a.z) + bflo(a.w) * bflo(a.w) + bfhi(a.w) * bfhi(a.w);
                          float sk = bflo(b.x) * bflo(b.x) + bfhi(b.x) * bfhi(b.x) + bflo(b.y) * bflo(b.y) + bfhi(b.y) * bfhi(b.y) + bflo(b.z) * bflo(b.z) + bfhi(b.z) * bfhi(b.z) + bflo(b.w) * bflo(b.w) + bfhi(b.w) * bfhi(b.w);
                          sq += __shfl_xor(sq, 1); sq += __shfl_xor(sq, 2); sq += __shfl_xor(sq, 4); sk += __shfl_xor(sk, 1); sk += __shfl_xor(sk, 2); sk += __shfl_xor(sk, 4);
                          qm = fmaxf(qm, sq); km = fmaxf(km, sk); }
                      if ((lane & 7) == 0) { atomicMax(WSP(unsigned, WS_LUT + OFF_QNC) + c * 8 + (lane >> 3), __float_as_uint(qm)); atomicMax(WSP(unsigned, WS_LUT + OFF_KNT) + c * 8 + (lane >> 3), __float_as_uint(km)); }
                      if (wave == 0) { float pre = 0.f; const int hh = lane & 7;
                          for (int cc = lane >> 3; cc < c; cc += 8) pre += CT[cc * 8 + hh];
                          pre += __shfl_xor(pre, 8); pre += __shfl_xor(pre, 16); pre += __shfl_xor(pre, 32);
                          for (int r = lane >> 3; r < 64; r += 8) { const size_t o = (size_t)(c * 64 + r) * 8 + hh; CUM[o] = LOGF[o] + pre; } }
                  } }
                { KArgP ap = kargs(); unsigned char* ws = ap->ws; GEMM_IDS();
                  pg8::Gemm g{WSP(u16, WS_A + A_CKVN), WSP(u16, WS_W + W_UKV), S, 1024, 128}; pg8::StaticOrder So; So.init(S, 1024, G, bid); EpiUkv E{WSP(u16, WS_A + A_KM), WSP(u16, WS_A + A_VM)};
                  pg8::gemm_phase<EpiUkv, pg8::StaticOrder, true, true>(lds, g, So, E); }
                { KArgP ap = kargs(); unsigned char* ws = ap->ws; GEMM_IDS();
                  pg8::Gemm g{WSP(u16, WS_A + A_CQN), WSP(u16, WS_W + W_UQ), S, 768, 256}; pg8::StaticOrder So; So.init(S, 768, G, bid); EpiUq E{WSP(u16, WS_A + A_QM), WSP(float, WS_CS)};
                  pg8::gemm_phase<EpiUq, pg8::StaticOrder, true, true>(lds, g, So, E); }
                SEAM(pb + 3);
            }
            if (IN(pb + 4)) { PROBE_T0();
                KArgP ap = kargs(); unsigned char* ws = ap->ws; PHASE_IDS();
                const u16* FQ = WSP(u16, WS_A + A_FQ); const u16* FK = WSP(u16, WS_A + A_FK); const u16* FV = WSP(u16, WS_A + A_FV);
                const u16* QM = WSP(u16, WS_A + A_QM); const u16* KM = WSP(u16, WS_A + A_KM); const u16* VM = WSP(u16, WS_A + A_VM); u16* OA = WSP(u16, WS_A + A_OA); const float* CUM = WSP(float, WS_A + A_CUM);
                const unsigned* QKN = WSP(unsigned, WS_LUT + OFF_QKN);
                unsigned* qctr = (unsigned*)(ws + WS_CTL) + 2048 + li * 64;
                volatile LAS unsigned* qslot = (volatile LAS unsigned*)(lds + MISC_OFF) + 16;
                for (;;) {
                    if (tid == 0) *qslot = __hip_atomic_fetch_add(qctr, 1u, __ATOMIC_RELAXED, __HIP_MEMORY_SCOPE_AGENT);
                    __syncthreads();
                    const unsigned u = *qslot;
                    __syncthreads();
                    if (u >= 1024u) break;
                    const int r = (int)(u & 511u), qb = 63 - (r >> 3), hh = r & 7;
                    if (u < 512u) attn_unit<96, false>(lds, QM + hh * 96, 768, KM + hh * 96, 768, VM + hh * 64, 512, OA + hh * 64, DM, qb, nullptr, 0.f, nullptr, nullptr, tid);
                    else attn_unit<64, true>(lds, FQ + hh * 64, 512, FK + hh * 64, 512, FV + hh * 64, 512, OA + 512 + hh * 64, DM, qb, CUM + hh, 0.f, WSP(unsigned, WS_LUT + OFF_KNT) + hh, WSP(unsigned, WS_LUT + OFF_QNC) + hh, tid);
                }
                SEAM(pb + 4);
            }
            if (IN(pb + 5)) { PROBE_T0();
                KArgP ap = kargs(); unsigned char* ws = ap->ws; GEMM_IDS();
                pg8::Gemm g{WSP(u16, WS_A + A_OA), WSP(u16, WS_W + W_OUT), S, DM, DM}; pg8::StaticOrder So; So.init(S, DM, G, bid); EpiBf16 E{WSP(u16, WS_MIX), DM};
                pg8::gemm_phase<EpiBf16, pg8::StaticOrder, true, true>(lds, g, So, E);
                SEAM(pb + 5);
            }
        } else {
            if (IN(pb + 1)) { PROBE_T0();
                KArgP ap = kargs(); unsigned char* ws = ap->ws; GEMM_IDS();
                pg8::Gemm g{WSP(u16, HBC), WSP(u16, WS_W + W_IN), S, 3072, DM}; pg8::StaticOrder So; So.init(S, 3072, G, bid);
                EpiOddIn E{WSP(u16, WS_A + A_DQ), WSP(u16, WS_A + A_NQ), WSP(u16, WS_A + A_SM1), WSP(u16, WS_A + A_SM2), WSP(float, WS_A + A_GATE), WSP(float, WS_RSP), true};
                pg8::gemm_phase<EpiOddIn, pg8::StaticOrder, true, true>(lds, g, So, E);
                SEAM(pb + 1);
            }
            if (IN(pb + 2)) { PROBE_T0();
                KArgP ap = kargs(); unsigned char* ws = ap->ws; PHASE_IDS();
                for (int task = bid; task < 256; task += G) { const int c = task >> 7, grp = task & 127;
                    compress_task(lds, WSP(u16, WS_A + A_SM1) + (size_t)c * ((size_t)S * 64), WSP(u16, WS_C1) + (size_t)c * (256 * 2048), WSP(float, WS_C1 + 2 * MiB) + c * 256, INP(c ? 17 : 15) + (size_t)lj * 256 * 64,
                                  c ? WSP(u16, WS_A + A_VC) : WSP(u16, WS_A + A_KC), grp, tid); }
                const u16* DQ = WSP(u16, WS_A + A_DQ); const u16* DK = WSP(u16, WS_A + A_DK); const u16* DV = WSP(u16, WS_A + A_DV); const u16* NQ = WSP(u16, WS_A + A_NQ); const u16* SM2 = WSP(u16, WS_A + A_SM2);
                u16* ODIL = WSP(u16, WS_A + A_ODIL); float* LSED = WSP(float, WS_A + A_LSED); u16* OWIN = WSP(u16, WS_A + A_OWIN);
                const float* LUTN = WSP(float, WS_LUT + LUT_N); const float* LUTD = WSP(float, WS_LUT + LUT_D);
                for (int u = bid; u < 1024; u += G) {
                    if (u < 768) { const int g = u >> 8, rem = u & 255, hh = rem >> 6, r = rem & 63, dsh = 2 * g, d = 1 << dsh, rho = r & (d - 1), qb = r >> dsh;
                        win_unit(lds, DQ + g * 256 + hh * 64, 768, DK + g * 256 + hh * 64, 768, DV + g * 256 + hh * 64, 768, rho, d, 129, LUTD + (g * 4 + hh) * 132, qb,
                                 ODIL + (size_t)g * ((size_t)S * 256) + hh * 64, 256, LSED + (size_t)g * ((size_t)S * 4) + hh, 4, tid); }
                    else { const int hh = (u - 768) >> 6, qb = (u - 768) & 63;
                        win_unit(lds, NQ + hh * 64, 256, SM2, 256, SM2 + 64, 256, 0, 1, 512, LUTN + hh * 2048, qb, OWIN + hh * 64, 256, nullptr, 0, tid); } }
                SEAM(pb + 2);
            }
            if (IN(pb + 4)) { PROBE_T0();
                KArgP ap = kargs(); unsigned char* ws = ap->ws; PHASE_IDS();
                NsaBufs B{WSP(u16, WS_A + A_NQ), WSP(u16, WS_A + A_KC), WSP(u16, WS_A + A_VC), WSP(u16, WS_A + A_SM1) + (size_t)2 * ((size_t)S * 64), WSP(u16, WS_A + A_SM1) + (size_t)3 * ((size_t)S * 64),
                          WSP(float, WS_LUT + LUT_N), WSP(float, WS_A + A_GATE), WSP(u16, WS_A + A_ODIL), WSP(float, WS_A + A_LSED), WSP(u16, WS_A + A_OWIN), WSP(u16, WS_A + A_OCMP), WSP(u16, WS_A + A_OSEL), WSP(u16, WS_A + A_OA)};
                for (int u = bid; u < S / 64; u += G) nsa_unit(lds, B, u * 64, tid);
                SEAM(pb + 4);
            }
            if (IN(pb + 5)) { PROBE_T0();
                KArgP ap = kargs(); unsigned char* ws = ap->ws; GEMM_IDS();
                pg8::Gemm g{WSP(u16, WS_A + A_OA), WSP(u16, WS_W + W_OUT), S, DM, 512}; pg8::StaticOrder So; So.init(S, DM, G, bid); EpiBf16 E{WSP(u16, WS_MIX), DM};
                pg8::gemm_phase<EpiBf16, pg8::StaticOrder, true, true>(lds, g, So, E);
                SEAM(pb + 5);
            }
        }
        if (IN(pb + 6)) { PROBE_T0();
            KArgP ap = kargs(); unsigned char* ws = ap->ws; PHASE_IDS();
            const float* gpost = INP(20) + (size_t)li * DM; float* H = ap->out;
            for (int row = gw; row < S; row += NGW) finalize_row(H, WSP(u16, WS_MIX), gpost, WSP(u16, HBC), WSP(float, WS_LUT + OFF_RSA), row, lane);
            SEAM(pb + 6);
        }
        if (IN(pb + 7)) { PROBE_T0();
            KArgP ap = kargs(); unsigned char* ws = ap->ws; GEMM_IDS();
            pg8::Gemm g{WSP(u16, HBC), WSP(u16, WS_W + W_UP), S, DFF, DM}; pg8::StaticOrder So; So.init(S, DFF, G, bid); EpiUp E{WSP(u16, WS_A), WSP(float, WS_LUT + OFF_RSA)};
            pg8::gemm_phase<EpiUp, pg8::StaticOrder, true, true>(lds, g, So, E);
            SEAM(pb + 7);
        }
        if (IN(pb + 8)) { PROBE_T0();
            KArgP ap = kargs(); unsigned char* ws = ap->ws; GEMM_IDS();
            pg8::Gemm g{WSP(u16, WS_A), WSP(u16, WS_W + W_DN), S, DM, DFF}; pg8::StaticOrder So; So.init(S, DM, G, bid); EpiBf16 E{WSP(u16, WS_MIX), DM};
            pg8::gemm_phase<EpiBf16, pg8::StaticOrder, true, true>(lds, g, So, E);
            SEAM(pb + 8);
        }
        if (IN(pb + 9)) { PROBE_T0();
            KArgP ap = kargs(); unsigned char* ws = ap->ws; PHASE_IDS();
            const float* gpost = INP(22) + (size_t)li * DM; float* H = ap->out;
            for (int row = gw; row < S; row += NGW) finalize_row(H, WSP(u16, WS_MIX), gpost, WSP(u16, HBC), WSP(float, WS_LUT + OFF_RSA), row, lane);
        }
        if (IN(pb + 10)) { PROBE_T0();
            KArgP ap = kargs(); unsigned char* ws = ap->ws; GEMM_IDS();
            pg8::Gemm g{WSP(u16, WS_PB), WSP(u16, WS_W + W_PP), S, DM, PLE}; pg8::StaticOrder So; So.init(S, DM, G, bid); EpiBf16 E{WSP(u16, WS_A), DM};
            pg8::gemm_phase<EpiBf16, pg8::StaticOrder, true, true>(lds, g, So, E);
            SEAM(pb + 10);
        }
        if (IN(pb + 11)) { PROBE_T0();
            KArgP ap = kargs(); unsigned char* ws = ap->ws; GEMM_IDS();
            pg8::Gemm g{WSP(u16, HBC), WSP(u16, WS_W + W_PG), S, DM, DM}; pg8::StaticOrder So; So.init(S, DM, G, bid);
            EpiPleG E{ap->out, WSP(u16, HBN), WSP(u16, WS_A), WSP(float, WS_LUT + OFF_RSA), WSP(float, WS_RSP)};
            pg8::gemm_phase<EpiPleG, pg8::StaticOrder, true, true>(lds, g, So, E);
            SEAM(pb + 11);
        }
    }

__global__ void __launch_bounds__(NTHREADS, 2) fwd(Args a) {
    extern __shared__ __attribute__((aligned(16))) unsigned char lds_raw[];
    LAS unsigned char* lds = (LAS unsigned char*)lds_raw;
    volatile LAS unsigned* MISC = (volatile LAS unsigned*)(lds + MISC_OFF);
    for (int u = threadIdx.x; u < (LDS_BYTES - MISC_OFF) / 4; u += NTHREADS) ((LAS unsigned*)(lds + MISC_OFF))[u] = 0u;
    __syncthreads();
    (void)xcd_barrier_post((unsigned*)(a.ws + WS_CTL) + CW_BAR, MISC + 8);
    if (IN(0)) { PROBE_T0();
        KArgP ap = kargs(); unsigned char* ws = ap->ws; PHASE_IDS();
        const float* x = INP(0); const int* positions = (const int*)ap->in[2]; const float* t5 = INP(3);
        float* H = ap->out; float* CS = WSP(float, WS_CS); float* LUTN = WSP(float, WS_LUT + LUT_N); float* LUTD = WSP(float, WS_LUT + LUT_D); float* RSA = WSP(float, WS_LUT + OFF_RSA); u16* HB = WSP(u16, WS_HB);
        const int gt = bid * NTHREADS + tid, NGT = G * NTHREADS;
        for (int idx = gt; idx < S * 16; idx += NGT) { const int t = idx >> 4, i = idx & 15;
            const float invf = (float)pow(10000.0, -(double)i / 16.0); const float ang = (float)positions[t] * invf;
            CS[(size_t)t * 32 + i] = (float)cos((double)ang); CS[(size_t)t * 32 + 16 + i] = (float)sin((double)ang); }
        for (int idx = gt; idx < 4 * 2048; idx += NGT) { const int h = idx >> 11, n = idx & 2047; LUTN[idx] = t5[t5_bucket(n) * 16 + 12 + h] * LOG2E; }
        for (int idx = gt; idx < 12 * 132; idx += NGT) { const int gh = idx / 132, j = idx % 132, g = gh >> 2; const int d = g == 0 ? 1 : (g == 1 ? 4 : 16);
            LUTD[idx] = j <= 128 ? t5[t5_bucket(d * j) * 16 + gh] * LOG2E : 0.f; }
        for (int row = gw; row < S; row += NGW) { const v4f* xr = (const v4f*)(x + (size_t)row * DM) + lane; v4f* hr = (v4f*)(H + (size_t)row * DM) + lane; v2u* o8 = (v2u*)(HB + (size_t)row * DM) + lane; float ss = 0.f;
#pragma unroll
            for (int j = 0; j < 4; ++j) { const v4f v = xr[64 * j]; hr[64 * j] = v; ss += v.x * v.x + v.y * v.y + v.z * v.z + v.w * v.w; v2u w; w.x = pk2(v.x, v.y); w.y = pk2(v.z, v.w); o8[64 * j] = w; }
            ss = wave_sum(ss); if (lane == 0) RSA[row] = ss; }
        SEAM(0);
    }

    layer_body<0>(lds); layer_body<1>(lds); layer_body<2>(lds); layer_body<3>(lds);
}

constexpr int N_PHASES = 1 + 12 * DEPTH;
#ifndef MK_PER_PHASE
#define MK_PER_PHASE 0
#endif
extern "C" void kernel_launch(void* const* d_in, const int* in_sizes, int n_in, void* d_out, int out_size, void* d_ws, size_t ws_size, hipStream_t stream) {
    static int grid = 0;
    if (grid == 0) {
        if (n_in != 28 || out_size != S * DM || ws_size < WS_END) { fprintf(stderr, "kernel_launch: unexpected shapes (n_in %d out %d ws %zu, need %zu)\n", n_in, out_size, ws_size, (size_t)WS_END); grid = -1; return; }
        int dev = 0, cus = 0;
        if (hipGetDevice(&dev) != hipSuccess || hipDeviceGetAttribute(&cus, hipDeviceAttributeMultiprocessorCount, dev) != hipSuccess) { grid = -1; return; }
        if (hipFuncSetAttribute((const void*)fwd, hipFuncAttributeMaxDynamicSharedMemorySize, LDS_BYTES) != hipSuccess) { fprintf(stderr, "kernel_launch: hipFuncSetAttribute failed\n"); grid = -1; return; }
        int per_cu = 0;
        if (hipOccupancyMaxActiveBlocksPerMultiprocessor(&per_cu, (const void*)fwd, NTHREADS, LDS_BYTES) != hipSuccess || per_cu < 1) fprintf(stderr, "kernel_launch: occupancy query reports %d\n", per_cu);
        (void)hipGetLastError();
        grid = cus;
    }
    if (grid < 0) return;
    (void)hipMemsetAsync((char*)d_ws + WS_CTL, 0, CTL_ZERO_BYTES, stream);
    Args a{};
    for (int i = 0; i < 28; ++i) a.in[i] = d_in[i];
    a.out = (float*)d_out; a.ws = (unsigned char*)d_ws;
#if MK_PER_PHASE
    for (int ph = 0; ph < N_PHASES; ++ph) { a.ph_lo = ph; a.ph_hi = ph + 1; hipLaunchKernelGGL(fwd, dim3(grid), dim3(NTHREADS), LDS_BYTES, stream, a); }
#else
    a.ph_lo = 0; a.ph_hi = N_PHASES;
    hipLaunchKernelGGL(fwd, dim3(grid), dim3(NTHREADS), LDS_BYTES, stream, a);
#endif
}
```

```cpp
#include <hip/hip_runtime.h>
#include <cstdio>
#include <cstdint>

#define GAS __attribute__((address_space(1)))
#define LAS __attribute__((address_space(3)))
typedef unsigned short u16;
typedef unsigned v4u __attribute__((ext_vector_type(4)));
typedef unsigned v2u __attribute__((ext_vector_type(2)));
typedef float v4f __attribute__((ext_vector_type(4)));
typedef float v2f __attribute__((ext_vector_type(2)));

constexpr int S = 16384, DM = 1024, DFF = 4096, PLE = 256, DEPTH = 4;
constexpr int NWAVES = 8, NTHREADS = 512;
constexpr int EV_IN = 1960, OD_IN = 2956;
constexpr float RMS_EPS = 1e-6f, LOG2E = 1.4426950408889634f;
constexpr float QS64 = 0.125f * LOG2E;
constexpr float QS96 = 0.10206207261596575f * LOG2E;

constexpr size_t MiB = 1u << 20;
constexpr size_t WS_CTL = 0, CTL_ZERO_BYTES = 1 * MiB;
constexpr size_t WS_CS = 1 * MiB;
constexpr size_t WS_LUT = 3 * MiB;
constexpr size_t LUT_N = 0;
constexpr size_t LUT_D = 32768;
constexpr size_t OFF_RSA = 65536, OFF_RSB = 131072;
constexpr size_t OFF_LOGF = 262144;
constexpr size_t OFF_CT = 786432;
constexpr size_t OFF_KNT = 802816, OFF_QNC = 811008;
constexpr size_t OFF_QKN = 794624;
constexpr size_t WS_W = 4 * MiB;
constexpr size_t W_IN = 0, W_OUT = 6 * MiB, W_UP = 8 * MiB, W_DN = 16 * MiB, W_PG = 24 * MiB, W_PP = 26 * MiB, W_UQ = 26 * MiB + 512 * 1024, W_UKV = 27 * MiB;
constexpr size_t WS_PB = 32 * MiB;
constexpr size_t WS_HB = 40 * MiB;
constexpr size_t WS_MIX = 72 * MiB;
constexpr size_t WS_A = 136 * MiB;
constexpr size_t A_FQ = 0, A_FK = 16 * MiB, A_FV = 32 * MiB, A_CQN = 48 * MiB, A_CKVN = 56 * MiB, A_QM = 60 * MiB, A_KM = 84 * MiB, A_VM = 108 * MiB, A_OA = 124 * MiB, A_CUM = 156 * MiB;
constexpr size_t A_DQ = 0, A_DK = 24 * MiB, A_DV = 48 * MiB, A_NQ = 72 * MiB, A_SM1 = 80 * MiB, A_SM2 = 88 * MiB, A_GATE = 96 * MiB, A_KC = 97 * MiB, A_VC = 97 * MiB + 256 * 1024;
constexpr size_t A_LSED = 98 * MiB, A_ODIL = 99 * MiB, A_OWIN = 140 * MiB;
constexpr size_t A_OCMP = 0, A_OSEL = 8 * MiB;
constexpr size_t WS_HB2 = 293 * MiB;
constexpr size_t WS_RSP = 325 * MiB;
constexpr size_t WS_C1 = 326 * MiB;
constexpr size_t WS_END = 329 * MiB;
constexpr int CW_BAR = 4096;

constexpr int RING_BYTES = 131072;
constexpr int MISC_OFF = 163840 - 512;
constexpr int LDS_BYTES = 163840;

__device__ __forceinline__ unsigned f2bf(float f) { unsigned u = __builtin_bit_cast(unsigned, f); return (u + 0x7fffu + ((u >> 16) & 1u)) >> 16; }
typedef float f32x2_t __attribute__((ext_vector_type(2))); typedef __bf16 bf16x2_t __attribute__((ext_vector_type(2)));
__device__ __forceinline__ unsigned pk2(float lo, float hi) { f32x2_t v = {lo, hi}; bf16x2_t b = __builtin_convertvector(v, bf16x2_t); return __builtin_bit_cast(unsigned, b); }
__device__ __forceinline__ float bf2f(u16 h) { return __builtin_bit_cast(float, (unsigned)h << 16); }
__device__ __forceinline__ float bflo(unsigned u) { return __builtin_bit_cast(float, u << 16); }
__device__ __forceinline__ float bfhi(unsigned u) { return __builtin_bit_cast(float, u & 0xffff0000u); }
__device__ __forceinline__ float wave_sum(float v) {
#pragma unroll
    for (int o = 1; o < 64; o <<= 1) v += __shfl_xor(v, o);
    return v;
}
__device__ __forceinline__ float wave_max(float v) {
#pragma unroll
    for (int o = 1; o < 64; o <<= 1) v = fmaxf(v, __shfl_xor(v, o));
    return v;
}
__device__ __forceinline__ float rdlane_f(float v, int l) { return __builtin_bit_cast(float, __builtin_amdgcn_readlane(__builtin_bit_cast(int, v), l)); }
#define LDS_WAIT() asm volatile("s_waitcnt lgkmcnt(0)" ::: "memory")

#define XB_TMO      128
#define XB_XCNT(j)  (256  + 64 * (j))
#define XB_XSUB(j)  (1280 + 64 * (j))
#define XB_XGEN(j)  (2304 + 64 * (j))
#define XB_TOP      3328
#define XB_TOPGEN   3392
#define XCD_BAR_WORDS 3456
#define XB_SPIN_CAP (1u << 18)

__device__ __forceinline__ unsigned xb_ld(unsigned* p)              { return __hip_atomic_load(p, __ATOMIC_RELAXED, __HIP_MEMORY_SCOPE_AGENT); }
__device__ __forceinline__ unsigned xb_add(unsigned* p, unsigned v) { return __hip_atomic_fetch_add(p, v, __ATOMIC_RELAXED, __HIP_MEMORY_SCOPE_AGENT); }
__device__ __forceinline__ unsigned xb_xcc_id() { return (unsigned)__builtin_amdgcn_s_getreg((3 << 11) | 20) & 0xFu; }
#define XB_SPIN(cond, bar) do { unsigned _sp = 0; while (cond) { __builtin_amdgcn_s_sleep(1); \
    if ((++_sp & 255u) == 0u) { if (xb_ld(&(bar)[XB_TMO])) break; if (_sp > XB_SPIN_CAP) { atomicAdd(&(bar)[XB_TMO], 1u); break; } } } } while (0)

struct XcdBarrier {
    unsigned* bar; unsigned x;
    volatile LAS unsigned* st;
};

__device__ __forceinline__ XcdBarrier xcd_barrier_post(unsigned* bar, volatile LAS unsigned* st) {
    XcdBarrier b; b.bar = bar; b.x = xb_xcc_id(); b.st = st;
    if (threadIdx.x == 0) (void)xb_add(&bar[XB_XCNT(b.x)], 1u);
    return b;
}
__device__ __forceinline__ void xcd_barrier_complete(unsigned* bar, unsigned x, unsigned& nloc, unsigned& nx) {
    const unsigned G = gridDim.x * gridDim.y * gridDim.z;
    unsigned sum, cnt, mine, sp = 0u;
    for (;;) {
        sum = 0u; cnt = 0u; mine = 0u;
#pragma unroll
        for (unsigned j = 0; j < 16; ++j) { const unsigned c = xb_ld(&bar[XB_XCNT(j)]); sum += c; cnt += (c > 0u) ? 1u : 0u; mine = (j == x) ? c : mine; }
        if (sum == G) break;
        __builtin_amdgcn_s_sleep(1);
        if ((++sp & 255u) == 0u) { if (xb_ld(&bar[XB_TMO])) break; if (sp > XB_SPIN_CAP) { atomicAdd(&bar[XB_TMO], 1u); break; } }
    }
    nloc = mine > 0u ? mine : 1u; nx = cnt > 0u ? cnt : 1u;
}

__device__ __forceinline__ void xcd_barrier(const XcdBarrier& b) {
    asm volatile("s_waitcnt vmcnt(0)" ::: "memory");
    __syncthreads();
    if (threadIdx.x == 0) {
        unsigned* bar = b.bar;
        __builtin_amdgcn_s_waitcnt(0);
        unsigned nloc = b.st[0], nx = b.st[1];
        if (nloc == 0u) { xcd_barrier_complete(bar, b.x, nloc, nx); b.st[0] = nloc; b.st[1] = nx; }
        const unsigned old = xb_add(&bar[XB_XSUB(b.x)], 1u);
        const unsigned gen = old / nloc;
        if (old + 1u == (gen + 1u) * nloc) {
            __builtin_amdgcn_fence(__ATOMIC_RELEASE, "agent");
            asm volatile("s_waitcnt vmcnt(0)" ::: "memory");
            const unsigned og = xb_add(&bar[XB_TOP], 1u);
            const unsigned tg = og / nx;
            if (og + 1u == (tg + 1u) * nx) xb_add(&bar[XB_TOPGEN], 1u);
            else XB_SPIN(xb_ld(&bar[XB_TOPGEN]) == tg, bar);
            __builtin_amdgcn_fence(__ATOMIC_ACQUIRE, "agent");
            xb_add(&bar[XB_XGEN(b.x)], 1u);
            asm volatile("s_waitcnt vmcnt(0)" ::: "memory");
        } else {
            XB_SPIN(xb_ld(&bar[XB_XGEN(b.x)]) == gen, bar);
            __builtin_amdgcn_fence(__ATOMIC_ACQUIRE, "agent");
            asm volatile("s_waitcnt vmcnt(0)" ::: "memory");
        }
    }
    __syncthreads();
}

namespace pg8 {
#define PG8_LAS __attribute__((address_space(3)))
typedef unsigned short bf16_t;
typedef short bf16x8 __attribute__((ext_vector_type(8)));
typedef float f32x4 __attribute__((ext_vector_type(4)));
typedef unsigned u32x4 __attribute__((ext_vector_type(4)));
constexpr int BM = 256, BK = 64, HALF = 128, HTB = HALF * BK * 2  , STAGE_BYTES = 8 * HTB, NXCD = 8, WGM = 8;

__host__ __device__ __forceinline__ int lds_byte(int r, int c) { const int st = (r >> 4) * 2 + (c >> 5), rr = r & 15, cc = c & 31, ob = rr * 64 + cc * 2; return st * 1024 + (ob ^ (((ob >> 9) & 1) << 5)); }
__host__ __device__ __forceinline__ void stage_rc(int b, int& R, int& C) { const int st = b / 1024, sb = b % 1024, swz = sb ^ (((sb >> 9) & 1) << 5); R = (st >> 1) * 16 + swz / 64; C = (st & 1) * 32 + (swz % 64) / 2; }
__host__ __device__ __forceinline__ int perm32(int rho) { const int n = rho >> 4, i = rho & 15; return 8 * (i >> 2) + 4 * n + (i & 3); }

struct Unit { int pm, pn; };
struct Gemm { const bf16_t* A; const bf16_t* Bt; int M, N, K; };

struct StaticOrder {
    int nM, nN, nwg, G, c;
    __host__ __device__ void init(int M, int N, int G_, int c_) { nM = M / BM; nN = N / BM; nwg = nM * nN; G = G_; c = c_; }
    __host__ __device__ bool next(int i, Unit& u) const {
        const long L = (long)i * G + c; if (L >= nwg) return false;
        int wgid = (int)L; { const int q = nwg / NXCD, r = nwg % NXCD, xcd = wgid % NXCD, off = wgid / NXCD; wgid = (xcd < r ? xcd * (q + 1) : r * (q + 1) + (xcd - r) * q) + off; }
        const int nig = WGM * nN, gid = wgid / nig, fm = gid * WGM, gsz = (nM - fm) < WGM ? (nM - fm) : WGM;
        u.pm = fm + ((wgid % nig) % gsz); u.pn = (wgid % nig) / gsz; return true;
    }
    __device__ __forceinline__ void a_ready(const Unit&) const {}
    __device__ __forceinline__ void done(const Unit&) const {}
};

__device__ __forceinline__ unsigned cvt_pk_bf16(float lo, float hi) { unsigned r; asm volatile("v_cvt_pk_bf16_f32 %0, %1, %2" : "=v"(r) : "v"(lo), "v"(hi)); return r; }
typedef float f32x2 __attribute__((ext_vector_type(2)));
template <class Epi, class Sched, bool ALIGN_EPI = false, bool SP2 = false>
__device__ __forceinline__ void gemm_phase(PG8_LAS unsigned char* lds, const Gemm g, const Sched& S, const Epi& E) {
    int tid_ = threadIdx.x; asm volatile("" : "+v"(tid_));
    const int tid = tid_, wid = __builtin_amdgcn_readfirstlane(tid >> 6), lane = tid & 63, wr = wid >> 2, wc = wid & 3, fr = lane & 15, fq = lane >> 4;
    int K_ = g.K; asm volatile("" : "+s"(K_));
    const int K = K_, nt = K / BK;
    unsigned voffA[2], voffB[2];
#pragma unroll
    for (int i = 0; i < 2; ++i) { int R, C; stage_rc(tid * 16 + i * 8192, R, C); const int Rb = Epi::PERM ? ((R & ~31) + perm32(R & 31)) : R;
        voffA[i] = (unsigned)(R * K + C) * 2u; voffB[i] = (unsigned)(Rb * K + C) * 2u; }
    const size_t kstep = (size_t)(BK * 2);
    const size_t hstep = (size_t)HALF * K * 2;
    const size_t tstep = 2 * hstep;
    const unsigned ldsw = (unsigned)wid * 1024u;
    const int aoff = lds_byte(wr * 64 + fr, fq * 8), boff = lds_byte(wc * 32 + fr, fq * 8);
#define PG8_SA(b, h) (((b) * 2 + (h)) * HTB)
#define PG8_SB(b, h) ((4 + (b) * 2 + (h)) * HTB)
#define PG8_STAGE(bufoff, gbase, voff) do { _Pragma("unroll") for (int _i = 0; _i < 2; ++_i) \
        __builtin_amdgcn_global_load_lds((const unsigned*)((const char*)(gbase) + (voff)[_i]), (PG8_LAS unsigned*)(lds + (bufoff) + ldsw + _i * 8192), 16, 0, 0); } while (0)
#define PG8_LDA(dst, b, h) do { _Pragma("unroll") for (int m = 0; m < 4; ++m) _Pragma("unroll") for (int k = 0; k < 2; ++k) dst[m][k] = *(const PG8_LAS bf16x8*)(lds + PG8_SA(b, h) + aoff + m * 2048 + k * 1024); } while (0)
#define PG8_LDB(dst, b, h) do { _Pragma("unroll") for (int n = 0; n < 2; ++n) _Pragma("unroll") for (int k = 0; k < 2; ++k) dst[n][k] = *(const PG8_LAS bf16x8*)(lds + PG8_SB(b, h) + boff + n * 2048 + k * 1024); } while (0)
#define PG8_MMA(ai, bj, At, Bt) do { __builtin_amdgcn_s_setprio(1); _Pragma("unroll") for (int m = 0; m < 4; ++m) _Pragma("unroll") for (int n = 0; n < 2; ++n) _Pragma("unroll") for (int k = 0; k < 2; ++k) \
        acc[ai][bj][m][n] = __builtin_amdgcn_mfma_f32_16x16x32_bf16(Bt[n][k], At[m][k], acc[ai][bj][m][n], 0, 0, 0); __builtin_amdgcn_s_setprio(0); } while (0)
#define PG8_WAIT_V(n) asm volatile("s_waitcnt vmcnt(" #n ")" ::: "memory")
#define PG8_WAIT_L(n) asm volatile("s_waitcnt lgkmcnt(" #n ")" ::: "memory")
#define PG8_BAR __builtin_amdgcn_s_barrier()
#define PG8_SCHED __builtin_amdgcn_sched_barrier(0)
    Unit cur, nxt; int ui = 0;
    if (!S.next(0, cur)) return;
    f32x4 acc[2][2][4][2];
#pragma unroll
    for (int a = 0; a < 2; ++a)
#pragma unroll
        for (int b = 0; b < 2; ++b)
#pragma unroll
            for (int m = 0; m < 4; ++m)
#pragma unroll
                for (int n = 0; n < 2; ++n) acc[a][b][m][n] = (f32x4){0.f, 0.f, 0.f, 0.f};
    bf16x8 At[4][2], B0[2][2], B1[2][2];
    const char* cA = (const char*)g.A + (size_t)cur.pm * tstep; const char* cB = (const char*)g.Bt + (size_t)cur.pn * tstep;
    S.a_ready(cur);
    if constexpr (SP2) {
        PG8_STAGE(PG8_SB(0, 0), cB, voffB); PG8_STAGE(PG8_SB(0, 1), cB + hstep, voffB); PG8_STAGE(PG8_SA(0, 0), cA, voffA); PG8_STAGE(PG8_SA(0, 1), cA + hstep, voffA);
        if (wr == 1) PG8_BAR;
        PG8_WAIT_V(2); PG8_BAR;
        PG8_STAGE(PG8_SB(1, 0), cB + kstep, voffB); PG8_STAGE(PG8_SA(1, 0), cA + kstep, voffA); PG8_STAGE(PG8_SB(1, 1), cB + hstep + kstep, voffB);
        PG8_WAIT_V(6); PG8_BAR;
    } else {
        PG8_STAGE(PG8_SB(0, 0), cB, voffB); PG8_STAGE(PG8_SA(0, 0), cA, voffA); PG8_STAGE(PG8_SB(0, 1), cB + hstep, voffB); PG8_STAGE(PG8_SA(0, 1), cA + hstep, voffA);
        if (wr == 1) PG8_BAR;
        PG8_WAIT_V(4); PG8_BAR;
        PG8_STAGE(PG8_SB(1, 0), cB + kstep, voffB); PG8_STAGE(PG8_SA(1, 0), cA + kstep, voffA); PG8_STAGE(PG8_SB(1, 1), cB + hstep + kstep, voffB);
        PG8_WAIT_V(6); PG8_BAR;
    }
    for (;;) {
        const bool has_next = S.next(ui + 1, nxt);
        const char* nA = has_next ? (const char*)g.A + (size_t)nxt.pm * tstep : cA; const char* nB = has_next ? (const char*)g.Bt + (size_t)nxt.pn * tstep : cB;
        for (int t = 0; t < nt; t += 2) {
            const bool last = (t == nt - 2);
            const char* a1 = cA + (size_t)(t + 1) * kstep;
            const char* a2 = last ? nA : cA + (size_t)(t + 2) * kstep; const char* b2 = last ? nB : cB + (size_t)(t + 2) * kstep;
            const char* a3 = a2 + kstep; const char* b3 = b2 + kstep;
            if (last && has_next) S.a_ready(nxt);
            if constexpr (SP2) {
            PG8_LDB(B0, 0, 0); PG8_LDB(B1, 0, 1); PG8_SCHED; PG8_LDA(At, 0, 0); PG8_STAGE(PG8_SA(1, 1), a1 + hstep, voffA);
            PG8_WAIT_V(8); PG8_WAIT_L(0); PG8_BAR; PG8_MMA(0, 0, At, B0); PG8_MMA(0, 1, At, B1); PG8_BAR; PG8_SCHED;
            PG8_LDA(At, 0, 1); PG8_STAGE(PG8_SB(0, 0), b2, voffB); PG8_STAGE(PG8_SB(0, 1), b2 + hstep, voffB); PG8_STAGE(PG8_SA(0, 0), a2, voffA);
            PG8_WAIT_V(8); PG8_WAIT_L(0); PG8_BAR; PG8_MMA(1, 0, At, B0); PG8_MMA(1, 1, At, B1); PG8_BAR; PG8_SCHED;
            PG8_LDB(B0, 1, 0); PG8_LDB(B1, 1, 1); PG8_SCHED; PG8_LDA(At, 1, 0); PG8_STAGE(PG8_SA(0, 1), a2 + hstep, voffA);
            PG8_WAIT_V(8); PG8_WAIT_L(0); PG8_BAR; PG8_MMA(0, 0, At, B0); PG8_MMA(0, 1, At, B1); PG8_BAR; PG8_SCHED;
            PG8_LDA(At, 1, 1); PG8_STAGE(PG8_SB(1, 0), b3, voffB); PG8_STAGE(PG8_SB(1, 1), b3 + hstep, voffB); PG8_STAGE(PG8_SA(1, 0), a3, voffA);
            PG8_WAIT_V(8); PG8_WAIT_L(0); PG8_BAR; PG8_MMA(1, 0, At, B0); PG8_MMA(1, 1, At, B1); PG8_BAR; PG8_SCHED;
            } else {
            PG8_LDB(B0, 0, 0); PG8_SCHED; PG8_LDA(At, 0, 0); PG8_STAGE(PG8_SA(1, 1), a1 + hstep, voffA);
            PG8_WAIT_L(8); PG8_BAR; PG8_WAIT_L(0); PG8_MMA(0, 0, At, B0); PG8_BAR; PG8_SCHED;
            PG8_LDB(B1, 0, 1); PG8_STAGE(PG8_SB(0, 0), b2, voffB);
            PG8_BAR; PG8_WAIT_L(0); PG8_MMA(0, 1, At, B1); PG8_BAR;
            PG8_LDA(At, 0, 1); PG8_STAGE(PG8_SA(0, 0), a2, voffA);
            PG8_BAR; PG8_WAIT_L(0); PG8_MMA(1, 0, At, B0); PG8_BAR; PG8_SCHED;
            PG8_STAGE(PG8_SB(0, 1), b2 + hstep, voffB);
            PG8_WAIT_V(6); PG8_BAR; PG8_MMA(1, 1, At, B1); PG8_BAR;
            PG8_LDB(B0, 1, 0); PG8_SCHED; PG8_LDA(At, 1, 0); PG8_STAGE(PG8_SA(0, 1), a2 + hstep, voffA);
            PG8_WAIT_L(8); PG8_BAR; PG8_WAIT_L(0); PG8_MMA(0, 0, At, B0); PG8_BAR; PG8_SCHED;
            PG8_LDB(B1, 1, 1); PG8_STAGE(PG8_SB(1, 0), b3, voffB);
            PG8_BAR; PG8_WAIT_L(0); PG8_MMA(0, 1, At, B1); PG8_BAR;
            PG8_LDA(At, 1, 1); PG8_STAGE(PG8_SA(1, 0), a3, voffA);
            PG8_BAR; PG8_WAIT_L(0); PG8_MMA(1, 0, At, B0); PG8_BAR; PG8_SCHED;
            PG8_STAGE(PG8_SB(1, 1), b3 + hstep, voffB);
            PG8_WAIT_V(6); PG8_BAR; PG8_MMA(1, 1, At, B1); PG8_BAR;
            }
        }
        if constexpr (ALIGN_EPI) { if (wr == 0) PG8_BAR; }
        if constexpr (!Epi::AFTER_DRAIN) { E(acc, cur, wr, wc, fr, fq); S.done(cur); }
        if (!has_next) break;
#pragma unroll
        for (int a = 0; a < 2; ++a)
#pragma unroll
            for (int b = 0; b < 2; ++b)
#pragma unroll
                for (int m = 0; m < 4; ++m)
#pragma unroll
                    for (int n = 0; n < 2; ++n) acc[a][b][m][n] = (f32x4){0.f, 0.f, 0.f, 0.f};
        cur = nxt; cA = nA; cB = nB; ++ui;
        if constexpr (ALIGN_EPI) { if (wr == 1) PG8_BAR; }
    }
    PG8_WAIT_V(0);
    if constexpr (!ALIGN_EPI) { if (wr == 0) PG8_BAR; }
    PG8_BAR;
    if constexpr (Epi::AFTER_DRAIN) { E.fused(acc, cur, wr, wc, fr, fq, lds, wid, lane); S.done(cur); }
#undef PG8_SA
#undef PG8_SB
#undef PG8_STAGE
#undef PG8_LDA
#undef PG8_LDB
#undef PG8_MMA
#undef PG8_WAIT_V
#undef PG8_WAIT_L
#undef PG8_BAR
#undef PG8_SCHED
}
}

using pg8::Unit;
typedef pg8::f32x4 f32x4;
__device__ __forceinline__ float sigmoidf_(float x) { return 1.f / (1.f + __expf(-x)); }
__device__ __forceinline__ v4u pack8(f32x4 a, f32x4 b) { v4u w; w.x = pk2(a[0], a[1]); w.y = pk2(a[2], a[3]); w.z = pk2(b[0], b[1]); w.w = pk2(b[2], b[3]); return w; }

struct EpiF32 { static constexpr bool PERM = true, AFTER_DRAIN = false;
    float* O; int ldc;
    __device__ __forceinline__ void operator()(const f32x4 (&acc)[2][2][4][2], const Unit& u, int wr, int wc, int fr, int fq) const {
        const int row0 = u.pm * 256 + wr * 64 + fr, col0 = u.pn * 256 + wc * 32 + 8 * fq;
#pragma unroll
        for (int ai = 0; ai < 2; ++ai)
#pragma unroll
            for (int m = 0; m < 4; ++m) { float* rp = O + (size_t)(row0 + ai * 128 + m * 16) * ldc + col0;
#pragma unroll
                for (int bj = 0; bj < 2; ++bj) { *(f32x4*)(rp + bj * 128) = acc[ai][bj][m][0]; *(f32x4*)(rp + bj * 128 + 4) = acc[ai][bj][m][1]; } }
    }
};
__device__ __forceinline__ float row_ss(const float* RS, int row, bool slots) { if (!slots) return RS[row];
    const v4f* p = (const v4f*)(RS + (size_t)row * 16); const v4f a = p[0], b = p[1], c = p[2], d = p[3];
    return (((a.x + a.y) + (a.z + a.w)) + ((b.x + b.y) + (b.z + b.w))) + (((c.x + c.y) + (c.z + c.w)) + ((d.x + d.y) + (d.z + d.w))); }
struct EpiBf16 { static constexpr bool PERM = true, AFTER_DRAIN = false;
    u16* O; int ldc;
    __device__ __forceinline__ void operator()(const f32x4 (&acc)[2][2][4][2], const Unit& u, int wr, int wc, int fr, int fq) const {
        const int row0 = u.pm * 256 + wr * 64 + fr, col0 = u.pn * 256 + wc * 32 + 8 * fq;
#pragma unroll
        for (int ai = 0; ai < 2; ++ai)
#pragma unroll
            for (int m = 0; m < 4; ++m) { u16* rp = O + (size_t)(row0 + ai * 128 + m * 16) * ldc + col0;
#pragma unroll
                for (int bj = 0; bj < 2; ++bj) *(v4u*)(rp + bj * 128) = pack8(acc[ai][bj][m][0], acc[ai][bj][m][1]); }
    }
};
struct EpiEvenIn { static constexpr bool PERM = true, AFTER_DRAIN = false;
    float* CQKV; u16* FQ; const float* RS; bool slots;
    __device__ __forceinline__ void operator()(const f32x4 (&acc)[2][2][4][2], const Unit& u, int wr, int wc, int fr, int fq) const {
        const int row0 = u.pm * 256 + wr * 64 + fr, c0 = wc * 32 + 8 * fq;
#pragma unroll
        for (int ai = 0; ai < 2; ++ai)
#pragma unroll
            for (int m = 0; m < 4; ++m) { const int row = row0 + ai * 128 + m * 16; const float rs = rsqrtf(row_ss(RS, row, slots) * (1.f / DM) + RMS_EPS);
#pragma unroll
                for (int bj = 0; bj < 2; ++bj) { const int c = c0 + bj * 128; f32x4 v0 = acc[ai][bj][m][0] * rs, v1 = acc[ai][bj][m][1] * rs;
                    if (u.pn < 2) { float* p = CQKV + (size_t)row * 512 + u.pn * 256 + c; *(f32x4*)p = v0; *(f32x4*)(p + 4) = v1; }
                    else { const int t = u.pn - 2, which = t >> 1; const float sc = which == 0 ? QS64 : 1.f;
                        u16* p = FQ + (size_t)which * ((size_t)S * 512) + (size_t)row * 512 + (t & 1) * 256 + c; *(v4u*)p = pack8(v0 * sc, v1 * sc); } } }
    }
};
struct EpiOddIn { static constexpr bool PERM = true, AFTER_DRAIN = false;
    u16* DQ; u16* NQ; u16* SM1; u16* SM2; float* GATE; const float* RS; bool slots;
    __device__ __forceinline__ void operator()(const f32x4 (&acc)[2][2][4][2], const Unit& u, int wr, int wc, int fr, int fq) const {
        const int row0 = u.pm * 256 + wr * 64 + fr, c0 = wc * 32 + 8 * fq;
#pragma unroll
        for (int ai = 0; ai < 2; ++ai)
#pragma unroll
            for (int m = 0; m < 4; ++m) { const int row = row0 + ai * 128 + m * 16; const float rs = rsqrtf(row_ss(RS, row, slots) * (1.f / DM) + RMS_EPS);
#pragma unroll
                for (int bj = 0; bj < 2; ++bj) { const int c = c0 + bj * 128; f32x4 v0 = acc[ai][bj][m][0] * rs, v1 = acc[ai][bj][m][1] * rs;
                    if (u.pn < 9) { const int which = u.pn / 3; const float sc = which == 0 ? QS64 : 1.f;
                        u16* p = DQ + (size_t)which * ((size_t)S * 768) + (size_t)row * 768 + (u.pn - which * 3) * 256 + c; *(v4u*)p = pack8(v0 * sc, v1 * sc); }
                    else if (u.pn == 9) { *(v4u*)(NQ + (size_t)row * 256 + c) = pack8(v0 * QS64, v1 * QS64); }
                    else if (u.pn == 10) { const int seg = c >> 6, cc = c & 63;
                        if (seg < 2) *(v4u*)(SM1 + (size_t)seg * ((size_t)S * 64) + (size_t)row * 64 + cc) = pack8(v0, v1);
                        else if (seg == 2) *(v4u*)(SM1 + (size_t)2 * ((size_t)S * 64) + (size_t)(row >> 6) * 4096 + (cc >> 3) * 512 + (row & 63) * 8) = pack8(v0, v1);
                        else { const int kq = row & 63, kpos = (kq & 32) + ((kq >> 2) & 3) * 8 + ((kq >> 4) & 1) * 4 + (kq & 3);
                            u16* vt = SM1 + (size_t)3 * ((size_t)S * 64) + (size_t)(row >> 6) * 4096 + (kpos >> 3) * 512 + (kpos & 7);
#pragma unroll
                            for (int e = 0; e < 8; ++e) vt[(cc + e) * 8] = (u16)f2bf(e < 4 ? v0[e & 3] : v1[e & 3]); } }
                    else { *(v4u*)(SM2 + (size_t)row * 256 + c) = pack8(v0, v1);
                        if (c >= 128 && c < 144) {
#pragma unroll
                            for (int e = 0; e < 8; ++e) { const int gi = c + e - 128; const float v = e < 4 ? v0[e & 3] : v1[e & 3]; if (gi < 12) GATE[(size_t)row * 16 + gi] = sigmoidf_(v); } } } } }
    }
};
struct EpiUq { static constexpr bool PERM = true, AFTER_DRAIN = false;
    u16* QM; const float* CS;
    __device__ __forceinline__ void operator()(const f32x4 (&acc)[2][2][4][2], const Unit& u, int wr, int wc, int fr, int fq) const {
        const int row0 = u.pm * 256 + wr * 64 + fr, c0 = wc * 32 + 8 * fq;
#pragma unroll
        for (int ai = 0; ai < 2; ++ai)
#pragma unroll
            for (int m = 0; m < 4; ++m) { const int row = row0 + ai * 128 + m * 16;
#pragma unroll
                for (int bj = 0; bj < 2; ++bj) { const int c = c0 + bj * 128; f32x4 v0 = acc[ai][bj][m][0], v1 = acc[ai][bj][m][1];
                    if (u.pn < 2) { const int cc = u.pn * 256 + c, head = cc >> 6, d = cc & 63; *(v4u*)(QM + (size_t)row * 768 + head * 96 + d) = pack8(v0 * QS96, v1 * QS96); }
                    else { const int head = c >> 5, grp = (c & 31) >> 3;
                        const f32x4 cs = *(const f32x4*)(CS + (size_t)row * 32 + 4 * grp), sn = *(const f32x4*)(CS + (size_t)row * 32 + 16 + 4 * grp);
                        const f32x4 o1 = (v0 * cs - v1 * sn) * QS96, o2 = (v1 * cs + v0 * sn) * QS96;
                        v2u w1, w2; w1.x = pk2(o1[0], o1[1]); w1.y = pk2(o1[2], o1[3]); w2.x = pk2(o2[0], o2[1]); w2.y = pk2(o2[2], o2[3]);
                        u16* qp = QM + (size_t)row * 768 + head * 96 + 64 + 4 * grp; *(v2u*)qp = w1; *(v2u*)(qp + 16) = w2; } } }
    }
};
struct EpiUkv { static constexpr bool PERM = true, AFTER_DRAIN = false;
    u16* KM; u16* VM;
    __device__ __forceinline__ void operator()(const f32x4 (&acc)[2][2][4][2], const Unit& u, int wr, int wc, int fr, int fq) const {
        const int row0 = u.pm * 256 + wr * 64 + fr, c0 = wc * 32 + 8 * fq;
#pragma unroll
        for (int ai = 0; ai < 2; ++ai)
#pragma unroll
            for (int m = 0; m < 4; ++m) { const int row = row0 + ai * 128 + m * 16;
#pragma unroll
                for (int bj = 0; bj < 2; ++bj) { const int c = c0 + bj * 128; const v4u w = pack8(acc[ai][bj][m][0], acc[ai][bj][m][1]);
                    if (u.pn < 2) { const int cc = u.pn * 256 + c, head = cc >> 6, d = cc & 63; *(v4u*)(KM + (size_t)row * 768 + head * 96 + d) = w; }
                    else { *(v4u*)(VM + (size_t)row * 512 + (u.pn - 2) * 256 + c) = w; } } }
    }
};
struct EpiUp { static constexpr bool PERM = true, AFTER_DRAIN = false;
    u16* HID; const float* RS;
    __device__ __forceinline__ void operator()(const f32x4 (&acc)[2][2][4][2], const Unit& u, int wr, int wc, int fr, int fq) const {
        const int row0 = u.pm * 256 + wr * 64 + fr, col0 = u.pn * 256 + wc * 32 + 8 * fq;
#pragma unroll
        for (int ai = 0; ai < 2; ++ai)
#pragma unroll
            for (int m = 0; m < 4; ++m) { const int row = row0 + ai * 128 + m * 16; const float rs = rsqrtf(RS[row] * (1.f / DM) + RMS_EPS);
#pragma unroll
                for (int bj = 0; bj < 2; ++bj) { f32x4 v0 = acc[ai][bj][m][0] * rs, v1 = acc[ai][bj][m][1] * rs;
#pragma unroll
                    for (int e = 0; e < 4; ++e) { const float a = fmaxf(v0[e], 0.f), b = fmaxf(v1[e], 0.f); v0[e] = a * a; v1[e] = b * b; }
                    *(v4u*)(HID + (size_t)row * DFF + col0 + bj * 128) = pack8(v0, v1); } }
    }
};
struct EpiPleG { static constexpr bool PERM = true, AFTER_DRAIN = false;
    float* H; u16* HB; const u16* PP; const float* RS; float* RSB;
    __device__ __forceinline__ void operator()(const f32x4 (&acc)[2][2][4][2], const Unit& u, int wr, int wc, int fr, int fq) const {
        const int row0 = u.pm * 256 + wr * 64 + fr, col0 = u.pn * 256 + wc * 32 + 8 * fq;
#pragma unroll
        for (int ai = 0; ai < 2; ++ai)
#pragma unroll
            for (int m = 0; m < 4; ++m) { const int row = row0 + ai * 128 + m * 16; const float rs = rsqrtf(RS[row] * (1.f / DM) + RMS_EPS); float ssq = 0.f;
#pragma unroll
                for (int bj = 0; bj < 2; ++bj) { const size_t off = (size_t)row * DM + col0 + bj * 128;
                    f32x4 g0 = acc[ai][bj][m][0] * rs, g1 = acc[ai][bj][m][1] * rs;
                    const v4u pq = *(const v4u*)(PP + off); const f32x4 p0 = {bflo(pq.x), bfhi(pq.x), bflo(pq.y), bfhi(pq.y)}, p1 = {bflo(pq.z), bfhi(pq.z), bflo(pq.w), bfhi(pq.w)};
                    f32x4 h0 = *(const f32x4*)(H + off), h1 = *(const f32x4*)(H + off + 4);
#pragma unroll
                    for (int e = 0; e < 4; ++e) { h0[e] += sigmoidf_(g0[e]) * p0[e]; h1[e] += sigmoidf_(g1[e]) * p1[e]; ssq += h0[e] * h0[e] + h1[e] * h1[e]; }
                    *(f32x4*)(H + off) = h0; *(f32x4*)(H + off + 4) = h1; *(v4u*)(HB + off) = pack8(h0, h1); }
                ssq += __shfl_xor(ssq, 16); ssq += __shfl_xor(ssq, 32);
                if (fq == 0) RSB[(size_t)row * 16 + u.pn * 4 + wc] = ssq; }
    }
};

__device__ __forceinline__ void cvt_item(const float* __restrict__ W, int ldw, int K, int col0, int ncols, const float* __restrict__ gain, u16* __restrict__ dst, int row0,
                                         LAS float* scr, int kb, int nb, int lane) {
    const int k0 = kb * 64, n0 = nb * 32;
    { v4f v[8]; const int c4 = (lane & 7) * 4, n = n0 + c4;
#pragma unroll
      for (int i = 0; i < 8; ++i) { const int kk = 8 * i + (lane >> 3); v[i] = (n < ncols) ? *(const v4f*)(W + (size_t)(k0 + kk) * ldw + col0 + n) : (v4f){0.f, 0.f, 0.f, 0.f}; }
#pragma unroll
      for (int i = 0; i < 8; ++i) { const int kk = 8 * i + (lane >> 3); const float g = gain ? gain[k0 + kk] : 1.f; LAS float* d = scr + kk * 33 + c4;
          d[0] = v[i].x * g; d[1] = v[i].y * g; d[2] = v[i].z * g; d[3] = v[i].w * g; } }
    LDS_WAIT();
    const int c = lane & 7;
#pragma unroll
    for (int j = 0; j < 4; ++j) { const int n = (lane >> 3) + 8 * j; const LAS float* s = scr + (8 * c) * 33 + n;
        v4u o; o.x = pk2(s[0 * 33], s[1 * 33]); o.y = pk2(s[2 * 33], s[3 * 33]); o.z = pk2(s[4 * 33], s[5 * 33]); o.w = pk2(s[6 * 33], s[7 * 33]);
        if (n0 + n < ncols) *(v4u*)(dst + (size_t)(row0 + n0 + n) * K + k0 + 8 * c) = o; }
    LDS_WAIT();
}
__device__ __forceinline__ void cvt_job(const float* W, int ldw, int K, int col0, int ncols, const float* gain, u16* dst, int row0, int& cursor, LAS float* scr, int gw, int NGW, int lane) {
    const int nnb = (ncols + 31) / 32, nit = (K / 64) * nnb;
    int first = gw - cursor; if (first < 0) first += NGW;
    for (int it = first; it < nit; it += NGW) cvt_item(W, ldw, K, col0, ncols, gain, dst, row0, scr, it / nnb, it % nnb, lane);
    cursor = (cursor + nit) % NGW;
}

template <int DQK, class KF>
__device__ __forceinline__ void attn_accum(const u16* __restrict__ qrow, int count, const KF kf, const u16* __restrict__ Kb, int kstride, const u16* __restrict__ Vb, int vstride,
                                           float& m, float& l, float& o, int lane) {
    unsigned qp[DQK / 2];
#pragma unroll
    for (int i = 0; i < DQK / 8; ++i) { const v4u v = *(const v4u*)(qrow + 8 * i); qp[4 * i] = v.x; qp[4 * i + 1] = v.y; qp[4 * i + 2] = v.z; qp[4 * i + 3] = v.w; }
    for (int j0 = 0; j0 < count; j0 += 64) {
        const int j = j0 + lane; int ridx = 0; float bias = 0.f;
        const bool valid = (j < count) && kf(j, ridx, bias);
        float s = -INFINITY;
        if (valid) { const u16* kr = Kb + (size_t)ridx * kstride; float a0 = 0.f, a1 = 0.f;
#pragma unroll
            for (int i = 0; i < DQK / 8; ++i) { const v4u kk = *(const v4u*)(kr + 8 * i);
                a0 += bflo(qp[4 * i]) * bflo(kk.x) + bflo(qp[4 * i + 1]) * bflo(kk.y) + bflo(qp[4 * i + 2]) * bflo(kk.z) + bflo(qp[4 * i + 3]) * bflo(kk.w);
                a1 += bfhi(qp[4 * i]) * bfhi(kk.x) + bfhi(qp[4 * i + 1]) * bfhi(kk.y) + bfhi(qp[4 * i + 2]) * bfhi(kk.z) + bfhi(qp[4 * i + 3]) * bfhi(kk.w); }
            s = a0 + a1 + bias; }
        const float cm = wave_max(s);
        if (cm == -INFINITY) continue;
        const float mn = fmaxf(m, cm), alpha = exp2f(m - mn), p = valid ? exp2f(s - mn) : 0.f;
        l = l * alpha + wave_sum(p); o *= alpha; m = mn;
        if (!valid) ridx = 0;
#pragma unroll 2
        for (int jj = 0; jj < 64; ++jj) { const float pj = rdlane_f(p, jj);
            if (pj != 0.f) { const int rj = __builtin_amdgcn_readlane(ridx, jj); o += pj * bf2f(Vb[(size_t)rj * vstride + lane]); } }
    }
}
struct KfCausal { int t; __device__ __forceinline__ bool operator()(int j, int& r, float& b) const { r = j; b = 0.f; return j <= t; } };
struct KfFox { int t; const float* cum; int h; __device__ __forceinline__ bool operator()(int j, int& r, float& b) const { r = j; if (j <= t) b = -cum[(size_t)j * 8 + h] * LOG2E; return j <= t; } };
struct KfDil { int t, d; const float* lut; __device__ __forceinline__ bool operator()(int j, int& r, float& b) const { const int s = t - d * j; r = s; b = lut[j]; return s >= 0; } };
struct KfAll { __device__ __forceinline__ bool operator()(int j, int& r, float& b) const { r = j; b = 0.f; return true; } };
struct KfSel { int t; const LAS int* sel; const float* lut; __device__ __forceinline__ bool operator()(int j, int& r, float& b) const {
    const int tok = sel[j >> 6] * 64 + (j & 63), dist = t - tok; r = tok; b = lut[dist < 0 ? 0 : (dist > 2047 ? 2047 : dist)]; return dist >= 0; } };
struct KfWin { int t; const float* lut; __device__ __forceinline__ bool operator()(int j, int& r, float& b) const { const int s = t - j; r = s; b = lut[j]; return s >= 0; } };

__device__ __forceinline__ int t5_bucket(int n) {
    if (n < 16) return n;
    int b = 16;
    b += (n >= 22) + (n >= 30) + (n >= 40) + (n >= 54) + (n >= 73) + (n >= 99) + (n >= 134) + (n >= 182) + (n >= 246) + (n >= 332) + (n >= 450) + (n >= 609) + (n >= 825) + (n >= 1117) + (n >= 1513);
    return b;
}
__device__ __forceinline__ float gelu_tanh(float x) { return 0.5f * x * (1.f + tanhf(0.7978845608028654f * (x + 0.044715f * x * x * x))); }

__device__ __forceinline__ void finalize_row(float* __restrict__ h, const u16* __restrict__ mix, const float* __restrict__ g, u16* __restrict__ hb, float* __restrict__ rs, int row, int lane) {
    const v2u* mr = (const v2u*)(mix + (size_t)row * DM) + lane; v4f* hr = (v4f*)(h + (size_t)row * DM) + lane; const v4f* gr = (const v4f*)g + lane;
    v4f mv[4]; float ss = 0.f;
#pragma unroll
    for (int j = 0; j < 4; ++j) { const v2u q = mr[64 * j]; mv[j] = (v4f){bflo(q.x), bfhi(q.x), bflo(q.y), bfhi(q.y)}; ss += mv[j].x * mv[j].x + mv[j].y * mv[j].y + mv[j].z * mv[j].z + mv[j].w * mv[j].w; }
    const float rstd = rsqrtf(wave_sum(ss) * (1.f / DM) + RMS_EPS); float s2 = 0.f;
    v2u* o8 = (v2u*)(hb + (size_t)row * DM) + lane;
#pragma unroll
    for (int j = 0; j < 4; ++j) { v4f hv = hr[64 * j]; const v4f gv = gr[64 * j]; hv = hv + mv[j] * rstd * gv; hr[64 * j] = hv;
        s2 += hv.x * hv.x + hv.y * hv.y + hv.z * hv.z + hv.w * hv.w; v2u w; w.x = pk2(hv.x, hv.y); w.y = pk2(hv.z, hv.w); o8[64 * j] = w; }
    s2 = wave_sum(s2); if (lane == 0) rs[row] = s2;
}


typedef short bf16x8_t __attribute__((ext_vector_type(8)));
typedef short s16x4_t __attribute__((ext_vector_type(4)));
typedef float f32x16 __attribute__((ext_vector_type(16)));
__device__ __forceinline__ float max3f(float a, float b, float c) { float r; asm("v_max3_f32 %0, %1, %2, %3" : "=v"(r) : "v"(a), "v"(b), "v"(c)); return r; }
__device__ __forceinline__ s16x4_t lds_tr16(const LAS unsigned char* p) { return __builtin_bit_cast(s16x4_t, __builtin_amdgcn_ds_read_tr16_b64_v4i16((LAS s16x4_t*)p)); }
__device__ __forceinline__ float xhalf_max(float v) { auto rr = __builtin_amdgcn_permlane32_swap(__float_as_uint(v), __float_as_uint(v), false, false);
    const unsigned a = rr[0], b = rr[1]; return fmaxf(__uint_as_float(a), __uint_as_float(b)); }
__device__ __forceinline__ float xhalf_sum(float v) { auto rr = __builtin_amdgcn_permlane32_swap(__float_as_uint(v), __float_as_uint(v), false, false);
    const unsigned a = rr[0], b = rr[1]; return __uint_as_float(a) + __uint_as_float(b); }
constexpr int ATT_BUF = 24576;

template <int DQK, bool KBIAS>
__device__ __forceinline__ void attn_unit(LAS unsigned char* lds, const u16* __restrict__ Qh, int qpitch, const u16* __restrict__ Kh, int kpitch, const u16* __restrict__ Vh, int vpitch,
                                          u16* __restrict__ Oh, int opitch, int qb, const float* __restrict__ cumh, float qkbound, const unsigned* __restrict__ knt, const unsigned* __restrict__ qnc, int tid) {
    constexpr int NCH = DQK / 8, KS = DQK / 16, NKL = (64 * NCH + 511) / 512;
    const int lane = tid & 63, wid = __builtin_amdgcn_readfirstlane(tid >> 6), r32 = lane & 31, hi = lane >> 5;
    const int q0 = qb * 256, NT = 4 * (qb + 1), row0w = q0 + 32 * wid;
    int kt0 = 0;
    if (KBIAS) { const float bq0 = -cumh[(size_t)q0 * 8] * LOG2E;
        const float qn = 2.f * sqrtf(fmaxf(fmaxf(__uint_as_float(qnc[(size_t)(4 * qb) * 8]), __uint_as_float(qnc[(size_t)(4 * qb + 1) * 8])), fmaxf(__uint_as_float(qnc[(size_t)(4 * qb + 2) * 8]), __uint_as_float(qnc[(size_t)(4 * qb + 3) * 8]))));
        int ns = 0; bool open = true;
        for (int k4 = 0; k4 < NT && open; k4 += 64) { const int kt = k4 + lane, ktc = kt < NT ? kt : NT - 1;
            const bool sk = (kt < NT) && (qn * sqrtf(__uint_as_float(knt[(size_t)ktc * 8])) + (-cumh[(size_t)(64 * ktc + 63) * 8] * LOG2E) - bq0 < -48.f);
            const unsigned long long mk = __ballot(sk), nk = ~mk;
            const int lead = nk ? __builtin_ctzll(nk) : 64; ns += lead; open = (lead == 64); }
        kt0 = __builtin_amdgcn_readfirstlane(ns); (void)qkbound; }
    bf16x8_t qf[KS];
#pragma unroll
    for (int d0 = 0; d0 < KS; ++d0) qf[d0] = *(const bf16x8_t*)(Qh + (size_t)(row0w + r32) * qpitch + 16 * d0 + 8 * hi);
    f32x16 o0, o1;
#pragma unroll
    for (int r = 0; r < 16; ++r) { o0[r] = 0.f; o1[r] = 0.f; }
    float m = 0.f, l = 0.f;
    const int vdt = (tid & 7) >> 2, vkey = tid >> 3, vpart = tid & 3;
    int ksrc[NKL], kdsto[NKL];
#pragma unroll
    for (int i_ = 0; i_ < NKL; ++i_) { const int idx_ = tid + 512 * i_, key_ = idx_ / NCH, c_ = idx_ - key_ * NCH; ksrc[i_] = key_ * kpitch + c_ * 8; kdsto[i_] = c_ * 1024 + ((key_ + 2 * c_) & 63) * 16; }
    const u16* vsrc = Vh + (size_t)vkey * vpitch + vdt * 32 + vpart * 8;
    const int vdst = 12288 + vdt * 4096 + vkey * 64 + vpart * 16;
    v4u kreg[NKL]; v4u vreg; float breg = 0.f;
#define ATT_LOAD(kt) do { _Pragma("unroll") for (int i_ = 0; i_ < NKL; ++i_) { const int idx_ = tid + 512 * i_; if (idx_ < 64 * NCH) kreg[i_] = *(const v4u*)(Kh + (size_t)((kt) * 64) * kpitch + ksrc[i_]); } \
        vreg = *(const v4u*)(vsrc + (size_t)(kt) * 64 * vpitch); if (KBIAS && tid < 64) breg = -cumh[(size_t)((kt) * 64 + tid) * 8] * LOG2E; } while (0)
#define ATT_STORE(buf) do { LAS unsigned char* b_ = lds + (buf) * ATT_BUF; _Pragma("unroll") for (int i_ = 0; i_ < NKL; ++i_) { const int idx_ = tid + 512 * i_; if (idx_ < 64 * NCH) *(LAS v4u*)(b_ + kdsto[i_]) = kreg[i_]; } \
        *(LAS v4u*)(b_ + vdst) = vreg; if (KBIAS && tid < 64) *(LAS float*)(b_ + 20480 + tid * 4) = breg; } while (0)
    ATT_LOAD(kt0); ATT_STORE(0);
    __syncthreads();
    int kfo[KS];
#pragma unroll
    for (int d0 = 0; d0 < KS; ++d0) kfo[d0] = (2 * d0 + hi) * 1024 + ((r32 + 4 * d0 + 2 * hi) & 63) * 16;
    const int vfo = 12288 + (4 * hi + ((lane & 15) >> 2)) * 64 + ((lane >> 4) & 1) * 32 + (lane & 3) * 8;
    for (int kt = kt0; kt < NT; ++kt) {
        const LAS unsigned char* bf = lds + ((kt - kt0) & 1) * ATT_BUF;
        if (kt + 1 < NT) ATT_LOAD(kt + 1);
        const int kbase = 64 * kt;
        if (kbase <= row0w + 31) {
            f32x16 p0, p1;
            if (KBIAS) {
#pragma unroll
                for (int a4 = 0; a4 < 4; ++a4) { const v4f b0 = *(const LAS v4f*)(bf + 20480 + (8 * a4 + 4 * hi) * 4), b1 = *(const LAS v4f*)(bf + 20480 + (32 + 8 * a4 + 4 * hi) * 4);
                    p0[4 * a4] = b0.x; p0[4 * a4 + 1] = b0.y; p0[4 * a4 + 2] = b0.z; p0[4 * a4 + 3] = b0.w; p1[4 * a4] = b1.x; p1[4 * a4 + 1] = b1.y; p1[4 * a4 + 2] = b1.z; p1[4 * a4 + 3] = b1.w; }
            } else {
#pragma unroll
                for (int r = 0; r < 16; ++r) { p0[r] = 0.f; p1[r] = 0.f; }
            }
#pragma unroll
            for (int d0 = 0; d0 < KS; ++d0) { const bf16x8_t k0 = *(const LAS bf16x8_t*)(bf + kfo[d0]), k1 = *(const LAS bf16x8_t*)(bf + (kfo[d0] ^ 512));
                p0 = __builtin_amdgcn_mfma_f32_32x32x16_bf16(k0, qf[d0], p0, 0, 0, 0); p1 = __builtin_amdgcn_mfma_f32_32x32x16_bf16(k1, qf[d0], p1, 0, 0, 0); }
            if (kbase + 63 > row0w) {
                asm volatile("" ::: "memory");
                const int qrow = row0w + r32;
#pragma unroll
                for (int r = 0; r < 16; ++r) { const int key = kbase + (r & 3) + 8 * (r >> 2) + 4 * hi; if (key > qrow) p0[r] = -INFINITY; if (key + 32 > qrow) p1[r] = -INFINITY; }
            }
            const bool first = kt == kt0;
            v2f tA[8], tB[8]; { const v2f m2 = {m, m};
#pragma unroll
              for (int i = 0; i < 8; ++i) { tA[i] = (v2f){p0[2 * i], p0[2 * i + 1]} - m2; tB[i] = (v2f){p1[2 * i], p1[2 * i + 1]} - m2; } }
            float mx = max3f(tA[0].x, tA[0].y, tB[0].x), mx2 = max3f(tB[0].y, tA[1].x, tA[1].y);
            mx = max3f(mx, tB[1].x, tB[1].y);
#pragma unroll
            for (int i = 2; i < 8; i += 2) { mx = max3f(mx, tA[i].x, tA[i].y); mx2 = max3f(mx2, tB[i].x, tB[i].y); mx = max3f(mx, tA[i + 1].x, tA[i + 1].y); mx2 = max3f(mx2, tB[i + 1].x, tB[i + 1].y); }
            mx = xhalf_max(fmaxf(mx, mx2));
            const float dl = fmaxf(mx, first ? -INFINITY : 0.f), alpha = first ? 1.f : __builtin_amdgcn_exp2f(-dl); const bool moved = __any(dl != 0.f); m += dl;
            float ps;
            { const v2f d2 = {dl, dl}; v2f s2 = {0.f, 0.f};
#pragma unroll
              for (int i = 0; i < 8; ++i) { const v2f a = tA[i] - d2, b = tB[i] - d2;
                  p0[2 * i] = __builtin_amdgcn_exp2f(a.x); p0[2 * i + 1] = __builtin_amdgcn_exp2f(a.y); p1[2 * i] = __builtin_amdgcn_exp2f(b.x); p1[2 * i + 1] = __builtin_amdgcn_exp2f(b.y);
                  s2 += (v2f){p0[2 * i], p0[2 * i + 1]}; s2 += (v2f){p1[2 * i], p1[2 * i + 1]}; }
              ps = s2.x + s2.y; }
            l = l * alpha + ps;
            if (moved) {
#pragma unroll
                for (int r = 0; r < 16; ++r) { o0[r] *= alpha; o1[r] *= alpha; } }
            bf16x8_t pw[4];
#pragma unroll
            for (int ks = 0; ks < 4; ++ks) { v4u w;
                if (ks < 2) { w.x = pk2(p0[8 * ks], p0[8 * ks + 1]); w.y = pk2(p0[8 * ks + 2], p0[8 * ks + 3]); w.z = pk2(p0[8 * ks + 4], p0[8 * ks + 5]); w.w = pk2(p0[8 * ks + 6], p0[8 * ks + 7]); }
                else { const int k2 = ks - 2; w.x = pk2(p1[8 * k2], p1[8 * k2 + 1]); w.y = pk2(p1[8 * k2 + 2], p1[8 * k2 + 3]); w.z = pk2(p1[8 * k2 + 4], p1[8 * k2 + 5]); w.w = pk2(p1[8 * k2 + 6], p1[8 * k2 + 7]); }
                pw[ks] = __builtin_bit_cast(bf16x8_t, w); }
#pragma unroll
            for (int ks = 0; ks < 4; ++ks) {
#pragma unroll
                for (int dt = 0; dt < 2; ++dt) { const s16x4_t a = lds_tr16(bf + vfo + dt * 4096 + ks * 1024), b = lds_tr16(bf + vfo + dt * 4096 + ks * 1024 + 512);
                    bf16x8_t vf; vf[0] = a[0]; vf[1] = a[1]; vf[2] = a[2]; vf[3] = a[3]; vf[4] = b[0]; vf[5] = b[1]; vf[6] = b[2]; vf[7] = b[3];
                    if (dt == 0) o0 = __builtin_amdgcn_mfma_f32_32x32x16_bf16(vf, pw[ks], o0, 0, 0, 0); else o1 = __builtin_amdgcn_mfma_f32_32x32x16_bf16(vf, pw[ks], o1, 0, 0, 0); } }
        }
        if (kt + 1 < NT) ATT_STORE((kt + 1 - kt0) & 1);
        __syncthreads();
    }
#undef ATT_LOAD
#undef ATT_STORE
    const float inv = 1.f / xhalf_sum(l);
    u16* orow = Oh + (size_t)(row0w + r32) * opitch;
#pragma unroll
    for (int a4 = 0; a4 < 4; ++a4) { v2u w0, w1; w0.x = pk2(o0[4 * a4] * inv, o0[4 * a4 + 1] * inv); w0.y = pk2(o0[4 * a4 + 2] * inv, o0[4 * a4 + 3] * inv);
        w1.x = pk2(o1[4 * a4] * inv, o1[4 * a4 + 1] * inv); w1.y = pk2(o1[4 * a4 + 2] * inv, o1[4 * a4 + 3] * inv);
        *(v2u*)(orow + 8 * a4 + 4 * hi) = w0; *(v2u*)(orow + 32 + 8 * a4 + 4 * hi) = w1; }
}


typedef float f32x4v __attribute__((ext_vector_type(4)));
__device__ __forceinline__ void win_unit(LAS unsigned char* lds, const u16* __restrict__ Qb, int qpitch, const u16* __restrict__ Kb, int kpitch, const u16* __restrict__ Vb, int vpitch,
                                         int r0, int rs, int W, const float* __restrict__ lut, int qb, u16* __restrict__ Ob, int ldo, float* __restrict__ lse, int lse_stride, int tid) {
    const int lane = tid & 63, wid = __builtin_amdgcn_readfirstlane(tid >> 6), r32 = lane & 31, hi = lane >> 5;
    const int i0 = qb * 256, iw0 = i0 + 32 * wid, qi = iw0 + r32;
    int ktlo = i0 - (W - 1); ktlo = ktlo < 0 ? 0 : (ktlo >> 6); const int kthi = (i0 + 255) >> 6;
    const size_t qtok = (size_t)r0 + (size_t)qi * rs;
    bf16x8_t qf[4];
#pragma unroll
    for (int d0 = 0; d0 < 4; ++d0) qf[d0] = *(const bf16x8_t*)(Qb + qtok * qpitch + 16 * d0 + 8 * hi);
    LAS float* lutL = (LAS float*)(lds + 49152) + 96;
    for (int i = tid; i < W + 192; i += NTHREADS) { const int d = i - 96; lutL[d] = (d >= 0 && d < W) ? lut[d] : 0.f; }
    f32x16 o0, o1;
#pragma unroll
    for (int r = 0; r < 16; ++r) { o0[r] = 0.f; o1[r] = 0.f; }
    float m = -INFINITY, l = 0.f;
    const int kc = tid & 7, kkey = tid >> 3, vdt = (tid & 7) >> 2, vkey = tid >> 3, vpart = tid & 3;
    const int kdst = kc * 1024 + ((kkey + 2 * kc) & 63) * 16, vdst = 12288 + vdt * 4096 + vkey * 64 + vpart * 16;
    v4u kreg, vreg;
#define WIN_LOAD(kt) do { kreg = *(const v4u*)(Kb + ((size_t)r0 + (size_t)((kt) * 64 + kkey) * rs) * kpitch + kc * 8); \
        vreg = *(const v4u*)(Vb + ((size_t)r0 + (size_t)((kt) * 64 + vkey) * rs) * vpitch + vdt * 32 + vpart * 8); } while (0)
#define WIN_STORE(buf) do { LAS unsigned char* b_ = lds + (buf) * ATT_BUF; *(LAS v4u*)(b_ + kdst) = kreg; *(LAS v4u*)(b_ + vdst) = vreg; } while (0)
    WIN_LOAD(ktlo); WIN_STORE(0);
    __syncthreads();
    int kfo[4];
#pragma unroll
    for (int d0 = 0; d0 < 4; ++d0) kfo[d0] = (2 * d0 + hi) * 1024 + ((r32 + 4 * d0 + 2 * hi) & 63) * 16;
    const int vfo = 12288 + (4 * hi + ((lane & 15) >> 2)) * 64 + ((lane >> 4) & 1) * 32 + (lane & 3) * 8;
    for (int kt = ktlo; kt <= kthi; ++kt) {
        const int par = (kt - ktlo) & 1;
        const LAS unsigned char* bf = lds + par * ATT_BUF;
        if (kt < kthi) WIN_LOAD(kt + 1);
        const int kbase = 64 * kt;
        if (kbase <= iw0 + 31 && kbase + 63 >= iw0 - (W - 1)) {
            f32x16 p0, p1;
#pragma unroll
            for (int r = 0; r < 16; ++r) { p0[r] = 0.f; p1[r] = 0.f; }
#pragma unroll
            for (int d0 = 0; d0 < 4; ++d0) { const bf16x8_t k0 = *(const LAS bf16x8_t*)(bf + kfo[d0]), k1 = *(const LAS bf16x8_t*)(bf + (kfo[d0] ^ 512));
                p0 = __builtin_amdgcn_mfma_f32_32x32x16_bf16(k0, qf[d0], p0, 0, 0, 0); p1 = __builtin_amdgcn_mfma_f32_32x32x16_bf16(k1, qf[d0], p1, 0, 0, 0); }
            const int dq = qi - kbase - 4 * hi;
#pragma unroll
            for (int r = 0; r < 16; ++r) { const int d0_ = dq - ((r & 3) + 8 * (r >> 2)), d1_ = d0_ - 32;
                const float b0 = lutL[d0_], b1 = lutL[d1_];
                p0[r] = ((unsigned)d0_ < (unsigned)W) ? p0[r] + b0 : -INFINITY; p1[r] = ((unsigned)d1_ < (unsigned)W) ? p1[r] + b1 : -INFINITY; }
            float mx = fmaxf(p0[0], p1[0]);
#pragma unroll
            for (int r = 1; r < 16; ++r) mx = fmaxf(mx, fmaxf(p0[r], p1[r]));
            mx = xhalf_max(mx);
            const float mn = fmaxf(m, mx), msub = (mn == -INFINITY) ? 0.f : mn, alpha = __builtin_amdgcn_exp2f(m - msub); m = mn;
            float ps = 0.f;
#pragma unroll
            for (int r = 0; r < 16; ++r) { p0[r] = __builtin_amdgcn_exp2f(p0[r] - msub); p1[r] = __builtin_amdgcn_exp2f(p1[r] - msub); ps += p0[r] + p1[r]; }
            l = l * alpha + ps;
#pragma unroll
            for (int r = 0; r < 16; ++r) { o0[r] *= alpha; o1[r] *= alpha; }
            bf16x8_t pw[4];
#pragma unroll
            for (int ks = 0; ks < 4; ++ks) { v4u w;
                if (ks < 2) { w.x = pk2(p0[8 * ks], p0[8 * ks + 1]); w.y = pk2(p0[8 * ks + 2], p0[8 * ks + 3]); w.z = pk2(p0[8 * ks + 4], p0[8 * ks + 5]); w.w = pk2(p0[8 * ks + 6], p0[8 * ks + 7]); }
                else { const int k2 = ks - 2; w.x = pk2(p1[8 * k2], p1[8 * k2 + 1]); w.y = pk2(p1[8 * k2 + 2], p1[8 * k2 + 3]); w.z = pk2(p1[8 * k2 + 4], p1[8 * k2 + 5]); w.w = pk2(p1[8 * k2 + 6], p1[8 * k2 + 7]); }
                pw[ks] = __builtin_bit_cast(bf16x8_t, w); }
#pragma unroll
            for (int ks = 0; ks < 4; ++ks) {
#pragma unroll
                for (int dt = 0; dt < 2; ++dt) { const s16x4_t a = lds_tr16(bf + vfo + dt * 4096 + ks * 1024), b = lds_tr16(bf + vfo + dt * 4096 + ks * 1024 + 512);
                    bf16x8_t vf; vf[0] = a[0]; vf[1] = a[1]; vf[2] = a[2]; vf[3] = a[3]; vf[4] = b[0]; vf[5] = b[1]; vf[6] = b[2]; vf[7] = b[3];
                    if (dt == 0) o0 = __builtin_amdgcn_mfma_f32_32x32x16_bf16(vf, pw[ks], o0, 0, 0, 0); else o1 = __builtin_amdgcn_mfma_f32_32x32x16_bf16(vf, pw[ks], o1, 0, 0, 0); } }
        }
        if (kt < kthi) WIN_STORE(par ^ 1);
        __syncthreads();
    }
#undef WIN_LOAD
#undef WIN_STORE
    const float lt = xhalf_sum(l), inv = 1.f / lt;
    u16* orow = Ob + qtok * ldo;
#pragma unroll
    for (int a4 = 0; a4 < 4; ++a4) { v2u w0, w1; w0.x = pk2(o0[4 * a4] * inv, o0[4 * a4 + 1] * inv); w0.y = pk2(o0[4 * a4 + 2] * inv, o0[4 * a4 + 3] * inv);
        w1.x = pk2(o1[4 * a4] * inv, o1[4 * a4 + 1] * inv); w1.y = pk2(o1[4 * a4 + 2] * inv, o1[4 * a4 + 3] * inv);
        *(v2u*)(orow + 8 * a4 + 4 * hi) = w0; *(v2u*)(orow + 32 + 8 * a4 + 4 * hi) = w1; }
    if (lse != nullptr && hi == 0) lse[qtok * lse_stride] = m + __builtin_amdgcn_logf(lt);
}

typedef float f32x4m __attribute__((ext_vector_type(4)));
__device__ __forceinline__ void compress_task(LAS unsigned char* lds, const u16* __restrict__ src  , const u16* __restrict__ w1t  , const float* __restrict__ c1  ,
                                              const float* __restrict__ w2, u16* __restrict__ dst  , int grp, int tid) {
    LAS u16* tok = (LAS u16*)lds;
    LAS float* hid = (LAS float*)(lds + 18432);
    const int lane = tid & 63, wid = __builtin_amdgcn_readfirstlane(tid >> 6), col = lane & 15, kg = lane >> 4;
    const int i0 = grp * 8, t0 = 16 * i0;
    for (int e = tid; e < 144 * 8; e += NTHREADS) { int t = t0 + (e >> 3); t = t < S ? t : S - 1; *(LAS v4u*)(tok + (e >> 3) * 64 + (e & 7) * 8) = *(const v4u*)(src + (size_t)t * 64 + (e & 7) * 8); }
    __syncthreads();
    { f32x4m acc0 = {0.f, 0.f, 0.f, 0.f}, acc1 = {0.f, 0.f, 0.f, 0.f};
      const int arow = col & 7;
      const u16* b0 = w1t + (size_t)(32 * wid + col) * 2048 + 8 * kg; const u16* b1 = b0 + (size_t)16 * 2048;
#pragma unroll 4
      for (int ks = 0; ks < 64; ++ks) { const int k = 32 * ks + 8 * kg, lq = k >> 6, d = k & 63;
          const bf16x8_t af = *(const LAS bf16x8_t*)(tok + (16 * arow + lq) * 64 + d);
          const bf16x8_t bf0 = *(const bf16x8_t*)(b0 + 32 * ks), bf1 = *(const bf16x8_t*)(b1 + 32 * ks);
          acc0 = __builtin_amdgcn_mfma_f32_16x16x32_bf16(af, bf0, acc0, 0, 0, 0); acc1 = __builtin_amdgcn_mfma_f32_16x16x32_bf16(af, bf1, acc1, 0, 0, 0); }
      if (kg < 2) {
#pragma unroll
          for (int e = 0; e < 4; ++e) { const int r = 4 * kg + e, n0 = 32 * wid + col; hid[r * 256 + n0] = gelu_tanh(acc0[e] + c1[n0]); hid[r * 256 + n0 + 16] = gelu_tanh(acc1[e] + c1[n0 + 16]); } } }
    __syncthreads();
    { const int r = tid >> 6, d = tid & 63; float acc = 0.f;
#pragma unroll 8
      for (int n = 0; n < 256; ++n) acc += hid[r * 256 + n] * w2[n * 64 + d];
      if (i0 + r < 1023) dst[(size_t)(i0 + r) * 64 + d] = (u16)f2bf(acc); }
    __syncthreads();
}

struct NsaBufs { const u16* NQ; const u16* KC; const u16* VC; const u16* KSEL; const u16* VSELT; const float* LUTN; const float* GATE;
                 const u16* ODIL; const float* LSED; const u16* OWIN; u16* OCMP; u16* OSEL; u16* OA; };
constexpr int NSA_IMP = 49152, NSA_SEL = 149504;
constexpr int NSS_STATE = 0, NSS_STAGE = 73728, NSS_STAGE_BYTES = 36864, NSS_MASK = 147456;
#ifndef PROBE_NSA
#define PROBE_NSA 0u
#endif
#define NSA_T() (PROBE_NSA ? __builtin_amdgcn_s_memrealtime() : 0ull)
#define NSA_SPIN(bit, tsa) do { if (PROBE_NSA & (bit)) { const unsigned long long t1_ = __builtin_amdgcn_s_memrealtime(), te_ = t1_ + (t1_ - (tsa)); while (__builtin_amdgcn_s_memrealtime() < te_) __builtin_amdgcn_s_sleep(8); } } while (0)
__device__ __forceinline__ void nsa_unit(LAS unsigned char* lds, const NsaBufs& B, int t0, int tid) {
    const unsigned long long tsA = NSA_T();
    const int lane = tid & 63, wid = __builtin_amdgcn_readfirstlane(tid >> 6), r32 = lane & 31, hi = lane >> 5;
    LAS unsigned* imp = (LAS unsigned*)(lds + NSA_IMP);
    LAS int* sel = (LAS int*)(lds + NSA_SEL);
    const int hrow = r32 >> 3, tq = t0 + 8 * wid + (r32 & 7), imax = tq >= 31 ? ((tq - 31) >> 4) : -1;
    const int tmaxu = t0 + 63, ntile = tmaxu >= 31 ? ((((tmaxu - 31) >> 4)) >> 6) + 1 : 0;
    const int iwmax = (t0 + 8 * wid + 7) >= 31 ? ((t0 + 8 * wid + 7 - 31) >> 4) : -1;
    const int iwmin = (t0 + 8 * wid) >= 31 ? ((t0 + 8 * wid - 31) >> 4) : -1;
    bf16x8_t qf[4];
#pragma unroll
    for (int d0 = 0; d0 < 4; ++d0) qf[d0] = *(const bf16x8_t*)(B.NQ + (size_t)tq * 256 + hrow * 64 + 16 * d0 + 8 * hi);
    for (int e = tid; e < 64 * 257; e += NTHREADS) imp[e] = 0u;
    const int kc = tid & 7, kkey = tid >> 3, vdt = (tid & 7) >> 2, vkey = tid >> 3, vpart = tid & 3;
    const int kdst = kc * 1024 + ((kkey + 2 * kc) & 63) * 16, vdst = 12288 + vdt * 4096 + vkey * 64 + vpart * 16;
    int kfo[4];
#pragma unroll
    for (int d0 = 0; d0 < 4; ++d0) kfo[d0] = (2 * d0 + hi) * 1024 + ((r32 + 4 * d0 + 2 * hi) & 63) * 16;
    const int vfo = 12288 + (4 * hi + ((lane & 15) >> 2)) * 64 + ((lane >> 4) & 1) * 32 + (lane & 3) * 8;
    float m = -INFINITY, l = 0.f, invl = 0.f;
    v4u kreg, vreg;
#define CMP_LOAD(kt) do { kreg = *(const v4u*)(B.KC + (size_t)((kt) * 64 + kkey) * 64 + kc * 8); vreg = *(const v4u*)(B.VC + (size_t)((kt) * 64 + vkey) * 64 + vdt * 32 + vpart * 8); } while (0)
#define CMP_STORE(buf) do { LAS unsigned char* b_ = lds + (buf) * ATT_BUF; *(LAS v4u*)(b_ + kdst) = kreg; *(LAS v4u*)(b_ + vdst) = vreg; } while (0)
#define CMP_SCORES() f32x16 p0, p1; _Pragma("unroll") for (int r = 0; r < 16; ++r) { p0[r] = 0.f; p1[r] = 0.f; } \
        _Pragma("unroll") for (int d0 = 0; d0 < 4; ++d0) { const bf16x8_t k0 = *(const LAS bf16x8_t*)(bf + kfo[d0]), k1 = *(const LAS bf16x8_t*)(bf + (kfo[d0] ^ 512)); \
            p0 = __builtin_amdgcn_mfma_f32_32x32x16_bf16(k0, qf[d0], p0, 0, 0, 0); p1 = __builtin_amdgcn_mfma_f32_32x32x16_bf16(k1, qf[d0], p1, 0, 0, 0); } \
        if (kbase + 63 > iwmin) { asm volatile("" ::: "memory");     \
        _Pragma("unroll") for (int r = 0; r < 16; ++r) { const int key = kbase + (r & 3) + 8 * (r >> 2) + 4 * hi; if (key > imax) p0[r] = -INFINITY; if (key + 32 > imax) p1[r] = -INFINITY; } }
    if (ntile > 0) {
        f32x16 o0, o1;
#pragma unroll
        for (int r = 0; r < 16; ++r) { o0[r] = 0.f; o1[r] = 0.f; }
        CMP_LOAD(0); CMP_STORE(0);
        __syncthreads();
        for (int kt = 0; kt < ntile; ++kt) {
            const LAS unsigned char* bf = lds + (kt & 1) * ATT_BUF;
            if (kt + 1 < ntile) CMP_LOAD(kt + 1);
            const int kbase = 64 * kt;
            if (kbase <= iwmax) {
                CMP_SCORES();
                float mx = fmaxf(p0[0], p1[0]);
#pragma unroll
                for (int r = 1; r < 16; ++r) mx = fmaxf(mx, fmaxf(p0[r], p1[r]));
                mx = xhalf_max(mx);
                const float mn = fmaxf(m, mx), msub = (mn == -INFINITY) ? 0.f : mn, alpha = __builtin_amdgcn_exp2f(m - msub); m = mn;
                float ps = 0.f;
#pragma unroll
                for (int r = 0; r < 16; ++r) { p0[r] = __builtin_amdgcn_exp2f(p0[r] - msub); p1[r] = __builtin_amdgcn_exp2f(p1[r] - msub); ps += p0[r] + p1[r]; }
                l = l * alpha + ps;
#pragma unroll
                for (int r = 0; r < 16; ++r) { o0[r] *= alpha; o1[r] *= alpha; }
                bf16x8_t pw[4];
#pragma unroll
                for (int ks = 0; ks < 4; ++ks) { v4u w;
                    if (ks < 2) { w.x = pk2(p0[8 * ks], p0[8 * ks + 1]); w.y = pk2(p0[8 * ks + 2], p0[8 * ks + 3]); w.z = pk2(p0[8 * ks + 4], p0[8 * ks + 5]); w.w = pk2(p0[8 * ks + 6], p0[8 * ks + 7]); }
                    else { const int k2 = ks - 2; w.x = pk2(p1[8 * k2], p1[8 * k2 + 1]); w.y = pk2(p1[8 * k2 + 2], p1[8 * k2 + 3]); w.z = pk2(p1[8 * k2 + 4], p1[8 * k2 + 5]); w.w = pk2(p1[8 * k2 + 6], p1[8 * k2 + 7]); }
                    pw[ks] = __builtin_bit_cast(bf16x8_t, w); }
#pragma unroll
                for (int ks = 0; ks < 4; ++ks) {
#pragma unroll
                    for (int dt = 0; dt < 2; ++dt) { const s16x4_t a = lds_tr16(bf + vfo + dt * 4096 + ks * 1024), b = lds_tr16(bf + vfo + dt * 4096 + ks * 1024 + 512);
                        bf16x8_t vf; vf[0] = a[0]; vf[1] = a[1]; vf[2] = a[2]; vf[3] = a[3]; vf[4] = b[0]; vf[5] = b[1]; vf[6] = b[2]; vf[7] = b[3];
                        if (dt == 0) o0 = __builtin_amdgcn_mfma_f32_32x32x16_bf16(vf, pw[ks], o0, 0, 0, 0); else o1 = __builtin_amdgcn_mfma_f32_32x32x16_bf16(vf, pw[ks], o1, 0, 0, 0); } }
            }
            if (kt + 1 < ntile) CMP_STORE((kt + 1) & 1);
            __syncthreads();
        }
        const float lt = xhalf_sum(l); invl = lt > 0.f ? 1.f / lt : 0.f;
        { u16* orow = B.OCMP + (size_t)tq * 256 + hrow * 64;
#pragma unroll
          for (int a4 = 0; a4 < 4; ++a4) { v2u w0, w1; w0.x = pk2(o0[4 * a4] * invl, o0[4 * a4 + 1] * invl); w0.y = pk2(o0[4 * a4 + 2] * invl, o0[4 * a4 + 3] * invl);
              w1.x = pk2(o1[4 * a4] * invl, o1[4 * a4 + 1] * invl); w1.y = pk2(o1[4 * a4 + 2] * invl, o1[4 * a4 + 3] * invl);
              *(v2u*)(orow + 8 * a4 + 4 * hi) = w0; *(v2u*)(orow + 32 + 8 * a4 + 4 * hi) = w1; } }
        const float msub2 = (m == -INFINITY) ? 0.f : m;
        LAS unsigned* impq = imp + (8 * wid + (r32 & 7)) * 257;
        CMP_LOAD(0); CMP_STORE(0);
        __syncthreads();
        for (int kt = 0; kt < ntile; ++kt) {
            const LAS unsigned char* bf = lds + (kt & 1) * ATT_BUF;
            if (kt + 1 < ntile) CMP_LOAD(kt + 1);
            const int kbase = 64 * kt;
            if (kbase <= iwmax) {
                CMP_SCORES();
#pragma unroll
                for (int r = 0; r < 16; ++r) { p0[r] = __builtin_amdgcn_exp2f(p0[r] - msub2) * invl; p1[r] = __builtin_amdgcn_exp2f(p1[r] - msub2) * invl; }
#pragma unroll
                for (int a4 = 0; a4 < 4; ++a4) {
                    float g0 = (p0[4 * a4] + p0[4 * a4 + 1]) + (p0[4 * a4 + 2] + p0[4 * a4 + 3]), e0 = p0[4 * a4 + 3];
                    float g1 = (p1[4 * a4] + p1[4 * a4 + 1]) + (p1[4 * a4 + 2] + p1[4 * a4 + 3]), e1 = p1[4 * a4 + 3];
                    g0 += __shfl_xor(g0, 8); e0 += __shfl_xor(e0, 8); g1 += __shfl_xor(g1, 8); e1 += __shfl_xor(e1, 8);
                    g0 += __shfl_xor(g0, 16); e0 += __shfl_xor(e0, 16); g1 += __shfl_xor(g1, 16); e1 += __shfl_xor(e1, 16);
                    if (hrow == 0) {
                        { const int jg = (kbase >> 2) + 2 * a4 + hi;
                          __hip_atomic_fetch_add(impq + jg, (unsigned)(g0 * 67108864.f + 0.5f), __ATOMIC_RELAXED, __HIP_MEMORY_SCOPE_WORKGROUP);
                          if (jg + 1 < 256) __hip_atomic_fetch_add(impq + jg + 1, (unsigned)(e0 * 67108864.f + 0.5f), __ATOMIC_RELAXED, __HIP_MEMORY_SCOPE_WORKGROUP); }
                        { const int jg = (kbase >> 2) + 8 + 2 * a4 + hi;
                          __hip_atomic_fetch_add(impq + jg, (unsigned)(g1 * 67108864.f + 0.5f), __ATOMIC_RELAXED, __HIP_MEMORY_SCOPE_WORKGROUP);
                          if (jg + 1 < 256) __hip_atomic_fetch_add(impq + jg + 1, (unsigned)(e1 * 67108864.f + 0.5f), __ATOMIC_RELAXED, __HIP_MEMORY_SCOPE_WORKGROUP); } } }
            }
            if (kt + 1 < ntile) CMP_STORE((kt + 1) & 1);
            __syncthreads();
        }
    } else {
        u16* orow = B.OCMP + (size_t)tq * 256 + hrow * 64;
#pragma unroll
        for (int a4 = 0; a4 < 4; ++a4) { *(v2u*)(orow + 8 * a4 + 4 * hi) = (v2u){0u, 0u}; *(v2u*)(orow + 32 + 8 * a4 + 4 * hi) = (v2u){0u, 0u}; }
        __syncthreads();
    }
#undef CMP_LOAD
#undef CMP_STORE
#undef CMP_SCORES
    NSA_SPIN(1u, tsA); const unsigned long long tsB = NSA_T();
    for (int qi = 0; qi < 8; ++qi) { const int q = 8 * wid + qi, t = t0 + q, tb = t >> 6; unsigned sc[4];
#pragma unroll
        for (int k = 0; k < 4; ++k) { const int j = lane + 64 * k; const unsigned v = imp[q * 257 + j]; const bool forced = (j == 0) || (j == tb) || (j == tb - 1);
            sc[k] = forced ? 0xFFFFFFFFu : (j <= tb ? (v < 0xFFFFFFF0u ? v : 0xFFFFFFF0u) + 2u : 1u); }
        unsigned cand = 0u;
        for (int bit = 31; bit >= 0; --bit) { const unsigned tr = cand | (1u << bit);
            const int cnt = __builtin_popcountll(__ballot(sc[0] >= tr)) + __builtin_popcountll(__ballot(sc[1] >= tr)) + __builtin_popcountll(__ballot(sc[2] >= tr)) + __builtin_popcountll(__ballot(sc[3] >= tr));
            if (cnt >= 16) cand = tr; }
        const unsigned long long below = (1ull << lane) - 1ull;
        int ngt = 0;
#pragma unroll
        for (int k = 0; k < 4; ++k) ngt += __builtin_popcountll(__ballot(sc[k] > cand));
        const int need = 16 - ngt; int eqseen = 0, pos = 0;
#pragma unroll
        for (int k = 0; k < 4; ++k) { const bool gt = sc[k] > cand, eq = sc[k] == cand; const unsigned long long me = __ballot(eq);
            const bool take = gt || (eq && (eqseen + __builtin_popcountll(me & below)) < need);
            const unsigned long long mt = __ballot(take);
            if (take) sel[q * 16 + pos + __builtin_popcountll(mt & below)] = lane + 64 * k;
            eqseen += __builtin_popcountll(me); pos += __builtin_popcountll(mt); }
    }
    NSA_SPIN(2u, tsB);
    __syncthreads();
    const unsigned long long tsC = NSA_T();
    { const int col = lane & 15, kg = lane >> 4, hcol = col & 3, slot = col >> 2, tb = t0 >> 6, nbq = tb + 1 < 16 ? tb + 1 : 16;
      LAS int* oaccL = (LAS int*)lds;
      LAS int* laccL = (LAS int*)(lds + 66560);
      LAS int* maxbL = (LAS int*)(lds + 66560);
      LAS float* lutL = (LAS float*)(lds + 67584);
      LAS unsigned* maskw = (LAS unsigned*)(lds + 100352);
      LAS int* goff = (LAS int*)(lds + 102400);
      for (int e = tid; e < 16640 + 256; e += NTHREADS) oaccL[e] = 0;
      ((LAS int*)(lds + 104448))[tid] = (int)0x80000000;
      for (int e = tid; e < 4 * 2048; e += NTHREADS) lutL[e] = B.LUTN[e];
      LAS unsigned char* qL = lds + 106496;
      for (int e = tid; e < 2048; e += NTHREADS) { const int pair = e >> 3, ch = e & 7; *(LAS v4u*)(qL + pair * 144 + ch * 16) = *(const v4u*)(B.NQ + (size_t)(t0 + (pair >> 2)) * 256 + (pair & 3) * 64 + ch * 8); }
      maskw[tid] = 0u;
      __syncthreads();
#pragma unroll
      for (int pp = 0; pp < 2; ++pp) { const int p = tid + 512 * pp, q = p >> 4, r = p & 15;
          if (r < nbq) { const int blk = sel[q * 16 + r]; __hip_atomic_fetch_or(maskw + blk * 2 + (q >> 5), 1u << (q & 31), __ATOMIC_RELAXED, __HIP_MEMORY_SCOPE_WORKGROUP); } }
      __syncthreads();
      if (wid == 0) {
          int ng[4], tot = 0;
#pragma unroll
          for (int k = 0; k < 4; ++k) { const int j = 4 * lane + k; ng[k] = (__builtin_popcount(maskw[2 * j]) + __builtin_popcount(maskw[2 * j + 1]) + 3) >> 2; tot += ng[k]; }
          int inc = tot;
#pragma unroll
          for (int o = 1; o < 64; o <<= 1) { const int v = __shfl_up(inc, o); if (lane >= o) inc += v; }
          int ex = inc - tot;
#pragma unroll
          for (int k = 0; k < 4; ++k) { goff[4 * lane + k] = ex; ex += ng[k]; }
          if (lane == 63) goff[256] = inc; }
      __syncthreads();
      const int NG = goff[256];
#define ITEM_DECODE(idx_, JP, BLK, QME, VAL) do { while (goff[JP + 1] <= (idx_)) ++JP; BLK = JP; const int g_ = (idx_) - goff[JP]; \
          unsigned long long mm_ = ((unsigned long long)(unsigned)__builtin_amdgcn_readfirstlane((int)maskw[2 * JP + 1]) << 32) | (unsigned)__builtin_amdgcn_readfirstlane((int)maskw[2 * JP]); \
          for (int k_ = 0; k_ < 4 * g_; ++k_) mm_ &= mm_ - 1ull; \
          int q0_ = __builtin_ctzll(mm_); mm_ &= mm_ - 1ull; int q1_ = mm_ ? __builtin_ctzll(mm_) : -1; if (mm_) mm_ &= mm_ - 1ull; int q2_ = mm_ ? __builtin_ctzll(mm_) : -1; if (mm_) mm_ &= mm_ - 1ull; int q3_ = mm_ ? __builtin_ctzll(mm_) : -1; \
          const int qs_ = slot == 0 ? q0_ : (slot == 1 ? q1_ : (slot == 2 ? q2_ : q3_)); VAL = qs_ >= 0; QME = VAL ? qs_ : q0_; } while (0)
#define SEL_LOADK(KF, blk_) do { const u16* kr = B.KSEL + (size_t)(blk_) * 4096 + kg * 512 + col * 8; \
          _Pragma("unroll") for (int mt = 0; mt < 4; ++mt) { KF[mt][0] = *(const bf16x8_t*)(kr + mt * 128); KF[mt][1] = *(const bf16x8_t*)(kr + mt * 128 + 2048); } } while (0)
#define SEL_LOADV(VF, blk_) do { const u16* vr = B.VSELT + (size_t)(blk_) * 4096 + kg * 512 + col * 8; \
          _Pragma("unroll") for (int d = 0; d < 4; ++d) _Pragma("unroll") for (int s2 = 0; s2 < 2; ++s2) VF[d][s2] = *(const bf16x8_t*)(vr + d * 128 + 2048 * s2); } while (0)
#define SEL_LOADQ(QF, q_) do { const LAS unsigned char* qr = qL + ((q_) * 4 + hcol) * 144 + 16 * kg; QF[0] = *(const LAS bf16x8_t*)qr; QF[1] = *(const LAS bf16x8_t*)(qr + 64); } while (0)
#define SEL_SCORES(KF, QF, blk_, qme_) { const int tok0 = (blk_) * 64, t = t0 + (qme_); \
          _Pragma("unroll") for (int mt = 0; mt < 4; ++mt) { c[mt] = __builtin_amdgcn_mfma_f32_16x16x32_bf16(KF[mt][0], QF[0], (f32x4m){0.f, 0.f, 0.f, 0.f}, 0, 0, 0); \
              c[mt] = __builtin_amdgcn_mfma_f32_16x16x32_bf16(KF[mt][1], QF[1], c[mt], 0, 0, 0); } \
          const LAS float* lutH = lutL + hcol * 2048; \
          if (t0 - (tok0 + 63) >= 1513) { const float bfar = lutH[2047]; _Pragma("unroll") for (int mt = 0; mt < 4; ++mt) _Pragma("unroll") for (int e = 0; e < 4; ++e) c[mt][e] += bfar; } \
          else { const int dbase = t - tok0 - 4 * kg; _Pragma("unroll") for (int mt = 0; mt < 4; ++mt) _Pragma("unroll") for (int e = 0; e < 4; ++e) { const int d = dbase - 16 * mt - e; \
              const float bsv = lutH[d < 0 ? 0 : (d > 2047 ? 2047 : d)]; c[mt][e] = d >= 0 ? c[mt][e] + bsv : -INFINITY; } } }
      bf16x8_t kA[4][2], qA[2];
      { bf16x8_t vA[4][2];
        LAS int* Mb = (LAS int*)(lds + 104448);
        int jp = 0, idx = wid, blkc = 0, qmec = 0; bool valc = false, have = idx < NG;
        if (have) { ITEM_DECODE(idx, jp, blkc, qmec, valc); SEL_LOADK(kA, blkc); SEL_LOADQ(qA, qmec); SEL_LOADV(vA, blkc); }
        const int NR = (NG + 7) >> 3;
        for (int r = 0; r < NR; ++r) {
            LAS int* Mc = Mb + (r & 1) * 256; LAS int* Mn = Mb + ((r + 1) & 1) * 256;
            f32x4m c[4];
#pragma unroll
            for (int mt = 0; mt < 4; ++mt) c[mt] = (f32x4m){0.f, 0.f, 0.f, 0.f};
            if (have) { SEL_SCORES(kA, qA, blkc, qmec);
                float mx = fmaxf(fmaxf(c[0][0], c[0][1]), fmaxf(c[0][2], c[0][3]));
#pragma unroll
                for (int mt = 1; mt < 4; ++mt) mx = fmaxf(mx, fmaxf(fmaxf(c[mt][0], c[mt][1]), fmaxf(c[mt][2], c[mt][3])));
                mx = fmaxf(mx, __shfl_xor(mx, 16)); mx = fmaxf(mx, __shfl_xor(mx, 32));
                if (kg == 0 && valc) { const int bi_ = __float_as_int(mx); __hip_atomic_fetch_max(Mc + qmec * 4 + hcol, bi_ >= 0 ? bi_ : (bi_ ^ 0x7fffffff), __ATOMIC_RELAXED, __HIP_MEMORY_SCOPE_WORKGROUP); } }
            int blkn = 0, qmen = 0; bool valn = false; const bool haven = idx + 8 < NG;
            if (haven) { ITEM_DECODE(idx + 8, jp, blkn, qmen, valn); SEL_LOADK(kA, blkn); SEL_LOADQ(qA, qmen); }
            asm volatile("s_waitcnt lgkmcnt(0)" ::: "memory"); __builtin_amdgcn_s_barrier(); asm volatile("" ::: "memory");
            { const int pair = wid * 32 + (lane & 31); const int mo = Mn[pair], mn = Mc[pair]; const bool chg = lane < 32 && mn != mo;
              if (chg) Mn[pair] = mn;
              unsigned long long need = __ballot(chg && mo != (int)0x80000000);
              while (need) { const int L = __builtin_ctzll(need); need &= need - 1ull;
                  const int mo_ = __builtin_amdgcn_readlane(mo, L), mn_ = __builtin_amdgcn_readlane(mn, L); const int pr = wid * 32 + L;
                  const float f = __builtin_amdgcn_exp2f(__int_as_float(mo_ >= 0 ? mo_ : (mo_ ^ 0x7fffffff)) - __int_as_float(mn_ >= 0 ? mn_ : (mn_ ^ 0x7fffffff)));
                  LAS int* a = oaccL + pr * 65; a[lane] = (int)rintf((float)a[lane] * f);
                  if (lane == 0) laccL[pr] = (int)rintf((float)laccL[pr] * f); } }
            asm volatile("s_waitcnt lgkmcnt(0)" ::: "memory"); __builtin_amdgcn_s_barrier(); asm volatile("" ::: "memory");
            if (have) {
                const int mb_ = Mc[qmec * 4 + hcol]; const float mrow = __int_as_float(mb_ >= 0 ? mb_ : (mb_ ^ 0x7fffffff));
                float ps = 0.f;
#pragma unroll
                for (int mt = 0; mt < 4; ++mt)
#pragma unroll
                    for (int e = 0; e < 4; ++e) { c[mt][e] = __builtin_amdgcn_exp2f(c[mt][e] - mrow); ps += c[mt][e]; }
                ps += __shfl_xor(ps, 16); ps += __shfl_xor(ps, 32);
                if (kg == 0 && valc) __hip_atomic_fetch_add(laccL + qmec * 4 + hcol, (int)(ps * 1048576.f + 0.5f), __ATOMIC_RELAXED, __HIP_MEMORY_SCOPE_WORKGROUP);
                bf16x8_t pB[2];
#pragma unroll
                for (int s2 = 0; s2 < 2; ++s2) { v4u w; w.x = pk2(c[2 * s2][0], c[2 * s2][1]); w.y = pk2(c[2 * s2][2], c[2 * s2][3]); w.z = pk2(c[2 * s2 + 1][0], c[2 * s2 + 1][1]); w.w = pk2(c[2 * s2 + 1][2], c[2 * s2 + 1][3]);
                    pB[s2] = __builtin_bit_cast(bf16x8_t, w); }
                LAS int* od_ = oaccL + (qmec * 4 + hcol) * 65 + 4 * kg;
#pragma unroll
                for (int d = 0; d < 4; ++d) { f32x4m oa_ = __builtin_amdgcn_mfma_f32_16x16x32_bf16(vA[d][0], pB[0], (f32x4m){0.f, 0.f, 0.f, 0.f}, 0, 0, 0);
                    oa_ = __builtin_amdgcn_mfma_f32_16x16x32_bf16(vA[d][1], pB[1], oa_, 0, 0, 0);
                    if (valc) {
#pragma unroll
                        for (int e = 0; e < 4; ++e) __hip_atomic_fetch_add(od_ + 16 * d + e, (int)rintf(oa_[e] * 16384.f), __ATOMIC_RELAXED, __HIP_MEMORY_SCOPE_WORKGROUP); } } }
            if (haven) SEL_LOADV(vA, blkn);
            idx += 8; blkc = blkn; qmec = qmen; valc = valn; have = haven;
        }
      }
#undef ITEM_DECODE
#undef SEL_LOADK
#undef SEL_LOADV
#undef SEL_LOADQ
#undef SEL_SCORES
      __syncthreads();
      { const int q = tid >> 3, hh = (tid & 7) >> 1, d0 = 32 * (tid & 1); const float inv = 1048576.f / (16384.f * (float)laccL[q * 4 + hh]);
        const LAS int* src = oaccL + (q * 4 + hh) * 65 + d0; u16* dst = B.OSEL + (size_t)(t0 + q) * 256 + hh * 64 + d0;
#pragma unroll
        for (int i = 0; i < 4; ++i) { v4u w; w.x = pk2((float)src[8 * i] * inv, (float)src[8 * i + 1] * inv); w.y = pk2((float)src[8 * i + 2] * inv, (float)src[8 * i + 3] * inv);
            w.z = pk2((float)src[8 * i + 4] * inv, (float)src[8 * i + 5] * inv); w.w = pk2((float)src[8 * i + 6] * inv, (float)src[8 * i + 7] * inv); *(v4u*)(dst + 8 * i) = w; } }
    }
    NSA_SPIN(4u, tsC); const unsigned long long tsD = NSA_T();
    asm volatile("s_waitcnt vmcnt(0)" ::: "memory");
    __syncthreads();
    __builtin_amdgcn_fence(__ATOMIC_ACQUIRE, "agent");
    asm volatile("s_waitcnt vmcnt(0)" ::: "memory");
    { const int tl = tid >> 3, sub = tid & 7, t = t0 + tl;
      u16* oa = B.OA + (size_t)t * 512;
      if (sub < 4) { const int hh = sub;
          const float l0 = B.LSED[((size_t)0 * S + t) * 4 + hh], l1 = B.LSED[((size_t)1 * S + t) * 4 + hh], l2 = B.LSED[((size_t)2 * S + t) * 4 + hh];
          const float lm = fmaxf(l0, fmaxf(l1, l2)); float w0 = __builtin_amdgcn_exp2f(l0 - lm), w1 = __builtin_amdgcn_exp2f(l1 - lm), w2 = __builtin_amdgcn_exp2f(l2 - lm);
          const float ws = 1.f / (w0 + w1 + w2); w0 *= ws; w1 *= ws; w2 *= ws;
          const u16* s0 = B.ODIL + ((size_t)0 * S + t) * 256 + hh * 64; const u16* s1 = B.ODIL + ((size_t)1 * S + t) * 256 + hh * 64; const u16* s2 = B.ODIL + ((size_t)2 * S + t) * 256 + hh * 64;
#pragma unroll
          for (int i = 0; i < 8; ++i) { const v4u a = *(const v4u*)(s0 + 8 * i), b = *(const v4u*)(s1 + 8 * i), c = *(const v4u*)(s2 + 8 * i); v4u o;
              o.x = pk2(w0 * bflo(a.x) + w1 * bflo(b.x) + w2 * bflo(c.x), w0 * bfhi(a.x) + w1 * bfhi(b.x) + w2 * bfhi(c.x));
              o.y = pk2(w0 * bflo(a.y) + w1 * bflo(b.y) + w2 * bflo(c.y), w0 * bfhi(a.y) + w1 * bfhi(b.y) + w2 * bfhi(c.y));
              o.z = pk2(w0 * bflo(a.z) + w1 * bflo(b.z) + w2 * bflo(c.z), w0 * bfhi(a.z) + w1 * bfhi(b.z) + w2 * bfhi(c.z));
              o.w = pk2(w0 * bflo(a.w) + w1 * bflo(b.w) + w2 * bflo(c.w), w0 * bfhi(a.w) + w1 * bfhi(b.w) + w2 * bfhi(c.w));
              *(v4u*)(oa + hh * 64 + 8 * i) = o; }
      } else { const int hh = sub - 4; const float* gp = B.GATE + (size_t)t * 16 + hh * 3; const float g0 = gp[0], g1 = gp[1], g2 = gp[2];
          const u16* s0 = B.OCMP + (size_t)t * 256 + hh * 64; const u16* s1 = B.OSEL + (size_t)t * 256 + hh * 64; const u16* s2 = B.OWIN + (size_t)t * 256 + hh * 64;
#pragma unroll
          for (int i = 0; i < 8; ++i) { const v4u a = *(const v4u*)(s0 + 8 * i), b = *(const v4u*)(s1 + 8 * i), c = *(const v4u*)(s2 + 8 * i); v4u o;
              o.x = pk2(g0 * bflo(a.x) + g1 * bflo(b.x) + g2 * bflo(c.x), g0 * bfhi(a.x) + g1 * bfhi(b.x) + g2 * bfhi(c.x));
              o.y = pk2(g0 * bflo(a.y) + g1 * bflo(b.y) + g2 * bflo(c.y), g0 * bfhi(a.y) + g1 * bfhi(b.y) + g2 * bfhi(c.y));
              o.z = pk2(g0 * bflo(a.z) + g1 * bflo(b.z) + g2 * bflo(c.z), g0 * bfhi(a.z) + g1 * bfhi(b.z) + g2 * bfhi(c.z));
              o.w = pk2(g0 * bflo(a.w) + g1 * bflo(b.w) + g2 * bflo(c.w), g0 * bfhi(a.w) + g1 * bfhi(b.w) + g2 * bfhi(c.w));
              *(v4u*)(oa + 256 + hh * 64 + 8 * i) = o; }
      } }
    NSA_SPIN(8u, tsD);
    __syncthreads();
}

struct Args { const void* in[28]; float* out; unsigned char* ws; int ph_lo, ph_hi; };
typedef const __attribute__((address_space(4))) Args* KArgP;
__device__ __forceinline__ KArgP kargs() { KArgP p = (KArgP)__builtin_amdgcn_kernarg_segment_ptr(); asm volatile("" : "+s"(p)); return p; }
#define WSP(T, off) ((T*)(ws + (off)))
#define INP(k) ((const float*)ap->in[k])

#define IN(k) (kargs()->ph_lo <= (k) && (k) < kargs()->ph_hi)
#ifndef PROBE_EVEN
#define PROBE_EVEN 0u
#endif
#ifndef PROBE_ODD
#define PROBE_ODD 0u
#endif
#define PROBE_ON ((PROBE_EVEN | PROBE_ODD) != 0u)
#define PROBE_T0() const unsigned long long ts0_ = PROBE_ON ? __builtin_amdgcn_s_memrealtime() : 0ull; (void)ts0_
#define PROBE_SPIN(k) do { if (PROBE_ON && (k) == 0 && (PROBE_EVEN & 0x1000u)) { const unsigned long long t1_ = __builtin_amdgcn_s_memrealtime(), te_ = t1_ + (t1_ - ts0_); while (__builtin_amdgcn_s_memrealtime() < te_) __builtin_amdgcn_s_sleep(8); } \
    if (PROBE_ON && (k) >= 1) { const int kk_ = ((k) - 1) % 12, par_ = (((k) - 1) / 12) & 1; if (((par_ ? PROBE_ODD : PROBE_EVEN) >> kk_) & 1u) { \
        const unsigned long long t1_ = __builtin_amdgcn_s_memrealtime(), te_ = t1_ + (t1_ - ts0_); while (__builtin_amdgcn_s_memrealtime() < te_) __builtin_amdgcn_s_sleep(8); } } } while (0)
#define SEAM(k) do { if (IN((k) + 1)) { XcdBarrier b_; b_.bar = (unsigned*)(kargs()->ws + WS_CTL) + CW_BAR; b_.x = xb_xcc_id(); b_.st = (volatile LAS unsigned*)(lds + MISC_OFF) + 8; xcd_barrier(b_); } PROBE_SPIN(k); } while (0)
#define PHASE_IDS() int tid_l = threadIdx.x, bid_l = blockIdx.x, G_l = gridDim.x; asm volatile("" : "+v"(tid_l), "+s"(bid_l), "+s"(G_l)); \
    const int tid = tid_l, bid = bid_l, G = G_l, NGW = G * NWAVES, lane = tid & 63, wave = __builtin_amdgcn_readfirstlane(tid >> 6), gw = bid * NWAVES + wave; (void)NGW; \
    LAS float* wscr = (LAS float*)(lds + wave * 16384); (void)wscr; (void)gw; (void)lane; (void)tid
#define GEMM_IDS() int bid_l = blockIdx.x, G_l = gridDim.x; asm volatile("" : "+s"(bid_l), "+s"(G_l)); const int bid = bid_l, G = G_l


template <int li> __device__ __forceinline__ void cvt_main(KArgP ap, unsigned char* ws, int tid, int bid, int G, int lane, int gw, int NGW, LAS float* wscr) {
    constexpr int lj = li >> 1; constexpr bool even = (li & 1) == 0;
            u16* W_in = WSP(u16, WS_W + W_IN); u16* W_out = WSP(u16, WS_W + W_OUT);
            int cursor = 0; const int gt = bid * NTHREADS + tid, NGT = G * NTHREADS;
            const float* g_pre = INP(19) + (size_t)li * DM;
            if (even) {
                const float* W = INP(4) + (size_t)lj * DM * EV_IN;
                ap = kargs(); cvt_job(W, EV_IN, DM, 0, 256, g_pre, W_in, 0, cursor, wscr, gw, NGW, lane);
                ap = kargs(); cvt_job(W, EV_IN, DM, 256, 128, g_pre, W_in, 256, cursor, wscr, gw, NGW, lane);
                ap = kargs(); cvt_job(W, EV_IN, DM, 384, 32, g_pre, W_in, 384, cursor, wscr, gw, NGW, lane);
                ap = kargs(); cvt_job(W, EV_IN, DM, 1952, 8, g_pre, W_in, 416, cursor, wscr, gw, NGW, lane);
                ap = kargs(); cvt_job(W, EV_IN, DM, 416, 512, g_pre, W_in, 512, cursor, wscr, gw, NGW, lane);
                ap = kargs(); cvt_job(W, EV_IN, DM, 928, 512, g_pre, W_in, 1024, cursor, wscr, gw, NGW, lane);
                ap = kargs(); cvt_job(W, EV_IN, DM, 1440, 512, g_pre, W_in, 1536, cursor, wscr, gw, NGW, lane);
                for (int idx = gt; idx < (512 - 424) * DM / 8; idx += NGT) ((v4u*)(W_in + (size_t)424 * DM))[idx] = (v4u){0u, 0u, 0u, 0u};
                ap = kargs(); cvt_job(INP(10) + (size_t)lj * DM * DM, DM, DM, 0, DM, nullptr, W_out, 0, cursor, wscr, gw, NGW, lane);
                u16* W_uq = WSP(u16, WS_W + W_UQ); u16* W_ukv = WSP(u16, WS_W + W_UKV);
                const float* wuq = INP(6) + (size_t)lj * 256 * 768; const float* qn = INP(5) + lj * 256;
                for (int idx = gt; idx < 768 * 256; idx += NGT) { const int n = idx >> 8, k = idx & 255; int col;
                    if (n < 512) col = (n >> 6) * 96 + (n & 63); else { const int r = n - 512, hh = r >> 5, grp = (r & 31) >> 3, e = r & 7; col = hh * 96 + 64 + (e < 4 ? 4 * grp + e : 16 + 4 * grp + e - 4); }
                    W_uq[idx] = (u16)f2bf(wuq[(size_t)k * 768 + col] * qn[k]); }
                const float* wukv = INP(8) + (size_t)lj * 128 * 1024; const float* kvn = INP(7) + lj * 128;
                for (int idx = gt; idx < 1024 * 128; idx += NGT) { const int n = idx >> 7, k = idx & 127; int col;
                    if (n < 512) col = (n >> 6) * 128 + (n & 63); else { const int r = n - 512; col = (r >> 6) * 128 + 64 + (r & 63); }
                    W_ukv[idx] = (u16)f2bf(wukv[(size_t)k * 1024 + col] * kvn[k]); }
            } else {
                const float* W = INP(11) + (size_t)lj * DM * OD_IN;
                ap = kargs(); cvt_job(W, OD_IN, DM, 0, OD_IN, g_pre, W_in, 0, cursor, wscr, gw, NGW, lane);
                for (int idx = gt; idx < (3072 - OD_IN) * DM / 8; idx += NGT) ((v4u*)(W_in + (size_t)OD_IN * DM))[idx] = (v4u){0u, 0u, 0u, 0u};
                ap = kargs(); cvt_job(INP(18) + (size_t)lj * 512 * DM, DM, 512, 0, DM, nullptr, W_out, 0, cursor, wscr, gw, NGW, lane);
                ap = kargs(); cvt_job(INP(14) + (size_t)lj * 2048 * 256, 256, 2048, 0, 256, nullptr, WSP(u16, WS_C1), 0, cursor, wscr, gw, NGW, lane);
                ap = kargs(); cvt_job(INP(16) + (size_t)lj * 2048 * 256, 256, 2048, 0, 256, nullptr, WSP(u16, WS_C1) + 256 * 2048, 0, cursor, wscr, gw, NGW, lane);
                { ap = kargs(); float* C1 = WSP(float, WS_C1 + 2 * MiB);
                  for (int o = gw; o < 512; o += NGW) { const int c = o >> 8, n = o & 255; const float* pos = INP(c ? 13 : 12) + (size_t)lj * 2048; const float* w1 = INP(c ? 16 : 14) + (size_t)lj * 2048 * 256;
                      float acc = 0.f; for (int k = lane; k < 2048; k += 64) acc += pos[k] * w1[(size_t)k * 256 + n];
                      acc = wave_sum(acc); if (lane == 0) C1[o] = acc; } }
            }
            ap = kargs(); cvt_job(INP(23) + (size_t)li * DM * DFF, DFF, DM, 0, DFF, INP(21) + (size_t)li * DM, WSP(u16, WS_W + W_UP), 0, cursor, wscr, gw, NGW, lane);
            ap = kargs(); cvt_job(INP(24) + (size_t)li * DFF * DM, DM, DFF, 0, DM, nullptr, WSP(u16, WS_W + W_DN), 0, cursor, wscr, gw, NGW, lane);
}
template <int li> __device__ __forceinline__ void cvt_ple(KArgP ap, unsigned char* ws, int tid, int bid, int G, int lane, int gw, int NGW, LAS float* wscr) {
    int cursor = 0; const int gt = bid * NTHREADS + tid, NGT = G * NTHREADS;
            ap = kargs(); cvt_job(INP(26) + (size_t)li * DM * DM, DM, DM, 0, DM, INP(25) + (size_t)li * DM, WSP(u16, WS_W + W_PG), 0, cursor, wscr, gw, NGW, lane);
            ap = kargs(); cvt_job(INP(27) + (size_t)li * PLE * DM, DM, PLE, 0, DM, nullptr, WSP(u16, WS_W + W_PP), 0, cursor, wscr, gw, NGW, lane);
            const v4f* ps = (const v4f*)(INP(1) + (size_t)li * S * PLE); v2u* PB2 = WSP(v2u, WS_PB);
            for (int idx = gt; idx < S * PLE / 4; idx += NGT) { const v4f v = ps[idx]; v2u w; w.x = pk2(v.x, v.y); w.y = pk2(v.z, v.w); PB2[idx] = w; }
}
template <int li> __device__ __forceinline__ void layer_body(LAS unsigned char* lds) {
    constexpr int pb = 1 + li * 12, lj = li >> 1; constexpr bool even = (li & 1) == 0;
    constexpr size_t HBC = (li & 1) ? WS_HB2 : WS_HB, HBN = (li & 1) ? WS_HB : WS_HB2;
        if (li == 0 && IN(pb + 0)) { PROBE_T0();
            KArgP ap = kargs(); unsigned char* ws = ap->ws; PHASE_IDS();
            cvt_main<li>(ap, ws, tid, bid, G, lane, gw, NGW, wscr); ap = kargs(); ws = ap->ws; cvt_ple<li>(ap, ws, tid, bid, G, lane, gw, NGW, wscr);
            SEAM(pb + 0);
        }
        if (even) {
            if (IN(pb + 1)) { PROBE_T0();
                KArgP ap = kargs(); unsigned char* ws = ap->ws; GEMM_IDS();
                pg8::Gemm g{WSP(u16, HBC), WSP(u16, WS_W + W_IN), S, 2048, DM}; pg8::StaticOrder So; So.init(S, 2048, G, bid);
                EpiEvenIn E{WSP(float, WS_MIX), WSP(u16, WS_A + A_FQ), li == 0 ? WSP(float, WS_LUT + OFF_RSA) : WSP(float, WS_RSP), li != 0};
                pg8::gemm_phase<EpiEvenIn, pg8::StaticOrder, true, true>(lds, g, So, E);
                SEAM(pb + 1);
            }
            if (IN(pb + 2)) { PROBE_T0();
                KArgP ap = kargs(); unsigned char* ws = ap->ws; PHASE_IDS();
                const float* CQKV = WSP(float, WS_MIX); const float* CS = WSP(float, WS_CS); u16* CQN = WSP(u16, WS_A + A_CQN); u16* CKVN = WSP(u16, WS_A + A_CKVN); u16* KM = WSP(u16, WS_A + A_KM);
                float* LOGF = WSP(float, WS_LUT + OFF_LOGF); float* CT = WSP(float, WS_LUT + OFF_CT);
                const float* fb = INP(9) + lj * 8;
                LAS float* lf = (LAS float*)(lds + 131072 - 4096);
                if (bid == 0 && tid < 16) WSP(unsigned, WS_LUT + OFF_QKN)[tid] = 0u;
                for (int c = bid; c < S / 64; c += G) if (tid < 16) WSP(unsigned, WS_LUT + (tid < 8 ? OFF_KNT : OFF_QNC))[c * 8 + (tid & 7)] = 0u;
                for (int c = bid; c < S / 64; c += G) {
                    for (int jr = 0; jr < 8; ++jr) { const int rl = wave * 8 + jr, t = c * 64 + rl; const float* cr = CQKV + (size_t)t * 512;
                        { const v4f v = *((const v4f*)cr + lane); const float ss = wave_sum(v.x * v.x + v.y * v.y + v.z * v.z + v.w * v.w); const float r = rsqrtf(ss * (1.f / 256) + RMS_EPS);
                          v2u w; w.x = pk2(v.x * r, v.y * r); w.y = pk2(v.z * r, v.w * r); *((v2u*)(CQN + (size_t)t * 256) + lane) = w; }
                        { const v2f v = *((const v2f*)(cr + 256) + lane); const float ss = wave_sum(v.x * v.x + v.y * v.y); const float r = rsqrtf(ss * (1.f / 128) + RMS_EPS);
                          *((unsigned*)(CKVN + (size_t)t * 128) + lane) = pk2(v.x * r, v.y * r); }
                        if (lane < 16) { const float x1 = cr[384 + lane], x2 = cr[400 + lane], cs = CS[(size_t)t * 32 + lane], sn = CS[(size_t)t * 32 + 16 + lane];
                            const u16 o1 = (u16)f2bf(x1 * cs - x2 * sn), o2 = (u16)f2bf(x2 * cs + x1 * sn);
#pragma unroll
                            for (int hh = 0; hh < 8; ++hh) { KM[(size_t)t * 768 + hh * 96 + 64 + lane] = o1; KM[(size_t)t * 768 + hh * 96 + 80 + lane] = o2; } }
                        if (lane < 8) { const float z = cr[416 + lane] + fb[lane]; lf[rl * 8 + lane] = fminf(z, 0.f) - log1pf(__expf(-fabsf(z))); } }
                    __syncthreads();
                    if (tid < 8) { float acc = 0.f; for (int r = 0; r < 64; ++r) { acc += lf[r * 8 + tid]; LOGF[(size_t)(c * 64 + r) * 8 + tid] = acc; } CT[c * 8 + tid] = acc; }
                    __syncthreads();
                }
                SEAM(pb + 2);
            }
            if (IN(pb + 3)) { PROBE_T0();
                { KArgP ap = kargs(); unsigned char* ws = ap->ws; PHASE_IDS();
                  const float* LOGF = WSP(float, WS_LUT + OFF_LOGF); const float* CT = WSP(float, WS_LUT + OFF_CT); float* CUM = WSP(float, WS_A + A_CUM);
                  const u16* FQ = WSP(u16, WS_A + A_FQ); const u16* FK = WSP(u16, WS_A + A_FK); unsigned* QKN = WSP(unsigned, WS_LUT + OFF_QKN);
                  for (int c = bid; c < S / 64; c += G) {
                      float qm = 0.f, km = 0.f;
                      for (int jr = 0; jr < 8; ++jr) { const size_t t = (size_t)c * 64 + wave * 8 + jr; const v4u a = *((const v4u*)(FQ + t * 512) + lane), b = *((const v4u*)(FK + t * 512) + lane);
                          float sq = bflo(a.x) * bflo(a.x) + bfhi(a.x) * bfhi(a.x) + bflo(a.y) * bflo(a.y) + bfhi(a.y) * bfhi(a.y) + bflo(a.z) * bflo(a.z) + bfhi(a.z) * bfhi(a.z) + bflo(a.w) * bflo(a.w) + bfhi(a.w) * bfhi(a.w);
                          float sk = bflo(b.x) * bflo(b.x) + bfhi(b.x) * bfhi(b.x) + bflo(b.y) * bflo(b.y) + bfhi(b.y) * bfhi(b.y) + bflo(b.z) * bflo(b.z) + bfhi(b.z) * bfhi(b.z) + bflo(b.w) * bflo(b.w) + bfhi(b.w) * bfhi(b.w);
                          sq += __shfl_xor(sq, 1); sq += __shfl_xor(sq, 2); sq += __shfl_xor(sq, 4); sk += __shfl_xor(sk, 1); sk += __shfl_xor(sk, 2); sk += __shfl_xor(sk, 4);
                          qm = fmaxf(qm, sq); km = fmaxf(km, sk); }
                      if ((lane & 7) == 0) { atomicMax(WSP(unsigned, WS_LUT + OFF_QNC) + c * 8 + (lane >> 3), __float_as_uint(qm)); atomicMax(WSP(unsigned, WS_LUT + OFF_KNT) + c * 8 + (lane >> 3), __float_as_uint(km)); }
                      if (wave == 0) { float pre = 0.f; const int hh = lane & 7;
                          for (int cc = lane >> 3; cc < c; cc += 8) pre += CT[cc * 8 + hh];
                          pre += __shfl_xor(pre, 8); pre += __shfl_xor(pre, 16); pre += __shfl_xor(pre, 32);
                          for (int r = lane >> 3; r < 64; r += 8) { const size_t o = (size_t)(c * 64 + r) * 8 + hh; CUM[o] = LOGF[o] + pre; } }
                  } }
                { KArgP ap = kargs(); unsigned char* ws = ap->ws; GEMM_IDS();
                  pg8::Gemm g{WSP(u16, WS_A + A_CKVN), WSP(u16, WS_W + W_UKV), S, 1024, 128}; pg8::StaticOrder So; So.init(S, 1024, G, bid); EpiUkv E{WSP(u16, WS_A + A_KM), WSP(u16, WS_A + A_VM)};
                  pg8::gemm_phase<EpiUkv, pg8::StaticOrder, true, true>(lds, g, So, E); }
                { KArgP ap = kargs(); unsigned char* ws = ap->ws; GEMM_IDS();
                  pg8::Gemm g{WSP(u16, WS_A + A_CQN), WSP(u16, WS_W + W_UQ), S, 768, 256}; pg8::StaticOrder So; So.init(S, 768, G, bid); EpiUq E{WSP(u16, WS_A + A_QM), WSP(float, WS_CS)};
                  pg8::gemm_phase<EpiUq, pg8::StaticOrder, true, true>(lds, g, So, E); }
                SEAM(pb + 3);
            }
            if (IN(pb + 4)) { PROBE_T0();
                KArgP ap = kargs(); unsigned char* ws = ap->ws; PHASE_IDS();
                const u16* FQ = WSP(u16, WS_A + A_FQ); const u16* FK = WSP(u16, WS_A + A_FK); const u16* FV = WSP(u16, WS_A + A_FV);
                const u16* QM = WSP(u16, WS_A + A_QM); const u16* KM = WSP(u16, WS_A + A_KM); const u16* VM = WSP(u16, WS_A + A_VM); u16* OA = WSP(u16, WS_A + A_OA); const float* CUM = WSP(float, WS_A + A_CUM);
                const unsigned* QKN = WSP(unsigned, WS_LUT + OFF_QKN);
                unsigned* qctr = (unsigned*)(ws + WS_CTL) + 2048 + li * 64;
                volatile LAS unsigned* qslot = (volatile LAS unsigned*)(lds + MISC_OFF) + 16;
                for (;;) {
                    if (tid == 0) *qslot = __hip_atomic_fetch_add(qctr, 1u, __ATOMIC_RELAXED, __HIP_MEMORY_SCOPE_AGENT);
                    __syncthreads();
                    const unsigned u = *qslot;
                    __syncthreads();
                    if (u >= 1024u) break;
                    const int r = (int)(u & 511u), qb = 63 - (r >> 3), hh = r & 7;
                    if (u < 512u) attn_unit<96, false>(lds, QM + hh * 96, 768, KM + hh * 96, 768, VM + hh * 64, 512, OA + hh * 64, DM, qb, nullptr, 0.f, nullptr, nullptr, tid);
                    else attn_unit<64, true>(lds, FQ + hh * 64, 512, FK + hh * 64, 512, FV + hh * 64, 512, OA + 512 + hh * 64, DM, qb, CUM + hh, 0.f, WSP(unsigned, WS_LUT + OFF_KNT) + hh, WSP(unsigned, WS_LUT + OFF_QNC) + hh, tid);
                }
                SEAM(pb + 4);
            }
            if (IN(pb + 5)) { PROBE_T0();
                KArgP ap = kargs(); unsigned char* ws = ap->ws; GEMM_IDS();
                pg8::Gemm g{WSP(u16, WS_A + A_OA), WSP(u16, WS_W + W_OUT), S, DM, DM}; pg8::StaticOrder So; So.init(S, DM, G, bid); EpiBf16 E{WSP(u16, WS_MIX), DM};
                pg8::gemm_phase<EpiBf16, pg8::StaticOrder, true, true>(lds, g, So, E);
                SEAM(pb + 5);
            }
        } else {
            if (IN(pb + 1)) { PROBE_T0();
                KArgP ap = kargs(); unsigned char* ws = ap->ws; GEMM_IDS();
                pg8::Gemm g{WSP(u16, HBC), WSP(u16, WS_W + W_IN), S, 3072, DM}; pg8::StaticOrder So; So.init(S, 3072, G, bid);
                EpiOddIn E{WSP(u16, WS_A + A_DQ), WSP(u16, WS_A + A_NQ), WSP(u16, WS_A + A_SM1), WSP(u16, WS_A + A_SM2), WSP(float, WS_A + A_GATE), WSP(float, WS_RSP), true};
                pg8::gemm_phase<EpiOddIn, pg8::StaticOrder, true, true>(lds, g, So, E);
                SEAM(pb + 1);
            }
            if (IN(pb + 2)) { PROBE_T0();
                KArgP ap = kargs(); unsigned char* ws = ap->ws; PHASE_IDS();
                for (int task = bid; task < 256; task += G) { const int c = task >> 7, grp = task & 127;
                    compress_task(lds, WSP(u16, WS_A + A_SM1) + (size_t)c * ((size_t)S * 64), WSP(u16, WS_C1) + (size_t)c * (256 * 2048), WSP(float, WS_C1 + 2 * MiB) + c * 256, INP(c ? 17 : 15) + (size_t)lj * 256 * 64,
                                  c ? WSP(u16, WS_A + A_VC) : WSP(u16, WS_A + A_KC), grp, tid); }
                const u16* DQ = WSP(u16, WS_A + A_DQ); const u16* DK = WSP(u16, WS_A + A_DK); const u16* DV = WSP(u16, WS_A + A_DV); const u16* NQ = WSP(u16, WS_A + A_NQ); const u16* SM2 = WSP(u16, WS_A + A_SM2);
                u16* ODIL = WSP(u16, WS_A + A_ODIL); float* LSED = WSP(float, WS_A + A_LSED); u16* OWIN = WSP(u16, WS_A + A_OWIN);
                const float* LUTN = WSP(float, WS_LUT + LUT_N); const float* LUTD = WSP(float, WS_LUT + LUT_D);
                for (int u = bid; u < 1024; u += G) {
                    if (u < 768) { const int g = u >> 8, rem = u & 255, hh = rem >> 6, r = rem & 63, dsh = 2 * g, d = 1 << dsh, rho = r & (d - 1), qb = r >> dsh;
                        win_unit(lds, DQ + g * 256 + hh * 64, 768, DK + g * 256 + hh * 64, 768, DV + g * 256 + hh * 64, 768, rho, d, 129, LUTD + (g * 4 + hh) * 132, qb,
                                 ODIL + (size_t)g * ((size_t)S * 256) + hh * 64, 256, LSED + (size_t)g * ((size_t)S * 4) + hh, 4, tid); }
                    else { const int hh = (u - 768) >> 6, qb = (u - 768) & 63;
                        win_unit(lds, NQ + hh * 64, 256, SM2, 256, SM2 + 64, 256, 0, 1, 512, LUTN + hh * 2048, qb, OWIN + hh * 64, 256, nullptr, 0, tid); } }
                SEAM(pb + 2);
            }
            if (IN(pb + 4)) { PROBE_T0();
                KArgP ap = kargs(); unsigned char* ws = ap->ws; PHASE_IDS();
                NsaBufs B{WSP(u16, WS_A + A_NQ), WSP(u16, WS_A + A_KC), WSP(u16, WS_A + A_VC), WSP(u16, WS_A + A_SM1) + (size_t)2 * ((size_t)S * 64), WSP(u16, WS_A + A_SM1) + (size_t)3 * ((size_t)S * 64),
                          WSP(float, WS_LUT + LUT_N), WSP(float, WS_A + A_GATE), WSP(u16, WS_A + A_ODIL), WSP(float, WS_A + A_LSED), WSP(u16, WS_A + A_OWIN), WSP(u16, WS_A + A_OCMP), WSP(u16, WS_A + A_OSEL), WSP(u16, WS_A + A_OA)};
                for (int u = bid; u < S / 64; u += G) nsa_unit(lds, B, u * 64, tid);
                SEAM(pb + 4);
            }
            if (IN(pb + 5)) { PROBE_T0();
                KArgP ap = kargs(); unsigned char* ws = ap->ws; GEMM_IDS();
                pg8::Gemm g{WSP(u16, WS_A + A_OA), WSP(u16, WS_W + W_OUT), S, DM, 512}; pg8::StaticOrder So; So.init(S, DM, G, bid); EpiBf16 E{WSP(u16, WS_MIX), DM};
                pg8::gemm_phase<EpiBf16, pg8::StaticOrder, true, true>(lds, g, So, E);
                SEAM(pb + 5);
            }
        }
        if (IN(pb + 6)) { PROBE_T0();
            KArgP ap = kargs(); unsigned char* ws = ap->ws; PHASE_IDS();
            const float* gpost = INP(20) + (size_t)li * DM; float* H = ap->out;
            for (int row = gw; row < S; row += NGW) finalize_row(H, WSP(u16, WS_MIX), gpost, WSP(u16, HBC), WSP(float, WS_LUT + OFF_RSA), row, lane);
            if (li > 0) { ap = kargs(); ws = ap->ws; cvt_ple<li>(ap, ws, tid, bid, G, lane, gw, NGW, wscr); }
            SEAM(pb + 6);
        }
        if (IN(pb + 7)) { PROBE_T0();
            KArgP ap = kargs(); unsigned char* ws = ap->ws; GEMM_IDS();
            pg8::Gemm g{WSP(u16, HBC), WSP(u16, WS_W + W_UP), S, DFF, DM}; pg8::StaticOrder So; So.init(S, DFF, G, bid); EpiUp E{WSP(u16, WS_A), WSP(float, WS_LUT + OFF_RSA)};
            pg8::gemm_phase<EpiUp, pg8::StaticOrder, true, true>(lds, g, So, E);
            SEAM(pb + 7);
        }
        if (IN(pb + 8)) { PROBE_T0();
            KArgP ap = kargs(); unsigned char* ws = ap->ws; GEMM_IDS();
            pg8::Gemm g{WSP(u16, WS_A), WSP(u16, WS_W + W_DN), S, DM, DFF}; pg8::StaticOrder So; So.init(S, DM, G, bid); EpiBf16 E{WSP(u16, WS_MIX), DM};
            pg8::gemm_phase<EpiBf16, pg8::StaticOrder, true, true>(lds, g, So, E);
            SEAM(pb + 8);
        }
        if (IN(pb + 9)) { PROBE_T0();
            KArgP ap = kargs(); unsigned char* ws = ap->ws; PHASE_IDS();
            const float* gpost = INP(22) + (size_t)li * DM; float* H = ap->out;
            for (int row = gw; row < S; row += NGW) finalize_row(H, WSP(u16, WS_MIX), gpost, WSP(u16, HBC), WSP(float, WS_LUT + OFF_RSA), row, lane);
            if (li + 1 < DEPTH) { ap = kargs(); ws = ap->ws; cvt_main<(li + 1 < DEPTH ? li + 1 : li)>(ap, ws, tid, bid, G, lane, gw, NGW, wscr);
                __syncthreads(); }
        }
        if (IN(pb + 10)) { PROBE_T0();
            KArgP ap = kargs(); unsigned char* ws = ap->ws; GEMM_IDS();
            pg8::Gemm g{WSP(u16, WS_PB), WSP(u16, WS_W + W_PP), S, DM, PLE}; pg8::StaticOrder So; So.init(S, DM, G, bid); EpiBf16 E{WSP(u16, WS_A), DM};
            pg8::gemm_phase<EpiBf16, pg8::StaticOrder, true, true>(lds, g, So, E);
            SEAM(pb + 10);
        }
        if (IN(pb + 11)) { PROBE_T0();
            KArgP ap = kargs(); unsigned char* ws = ap->ws; GEMM_IDS();
            pg8::Gemm g{WSP(u16, HBC), WSP(u16, WS_W + W_PG), S, DM, DM}; pg8::StaticOrder So; So.init(S, DM, G, bid);
            EpiPleG E{ap->out, WSP(u16, HBN), WSP(u16, WS_A), WSP(float, WS_LUT + OFF_RSA), WSP(float, WS_RSP)};
            pg8::gemm_phase<EpiPleG, pg8::StaticOrder, true, true>(lds, g, So, E);
            SEAM(pb + 11);
        }
    }

__global__ void __launch_bounds__(NTHREADS, 2) fwd(Args a) {
    extern __shared__ __attribute__((aligned(16))) unsigned char lds_raw[];
    LAS unsigned char* lds = (LAS unsigned char*)lds_raw;
    volatile LAS unsigned* MISC = (volatile LAS unsigned*)(lds + MISC_OFF);
    for (int u = threadIdx.x; u < (LDS_BYTES - MISC_OFF) / 4; u += NTHREADS) ((LAS unsigned*)(lds + MISC_OFF))[u] = 0u;
    __syncthreads();
    (void)xcd_barrier_post((unsigned*)(a.ws + WS_CTL) + CW_BAR, MISC + 8);
    if (IN(0)) { PROBE_T0();
        KArgP ap = kargs(); unsigned char* ws = ap->ws; PHASE_IDS();
        const float* x = INP(0); const int* positions = (const int*)ap->in[2]; const float* t5 = INP(3);
        float* H = ap->out; float* CS = WSP(float, WS_CS); float* LUTN = WSP(float, WS_LUT + LUT_N); float* LUTD = WSP(float, WS_LUT + LUT_D); float* RSA = WSP(float, WS_LUT + OFF_RSA); u16* HB = WSP(u16, WS_HB);
        const int gt = bid * NTHREADS + tid, NGT = G * NTHREADS;
        for (int idx = gt; idx < S * 16; idx += NGT) { const int t = idx >> 4, i = idx & 15;
            const float invf = (float)pow(10000.0, -(double)i / 16.0); const float ang = (float)positions[t] * invf;
            CS[(size_t)t * 32 + i] = (float)cos((double)ang); CS[(size_t)t * 32 + 16 + i] = (float)sin((double)ang); }
        for (int idx = gt; idx < 4 * 2048; idx += NGT) { const int h = idx >> 11, n = idx & 2047; LUTN[idx] = t5[t5_bucket(n) * 16 + 12 + h] * LOG2E; }
        for (int idx = gt; idx < 12 * 132; idx += NGT) { const int gh = idx / 132, j = idx % 132, g = gh >> 2; const int d = g == 0 ? 1 : (g == 1 ? 4 : 16);
            LUTD[idx] = j <= 128 ? t5[t5_bucket(d * j) * 16 + gh] * LOG2E : 0.f; }
        for (int row = gw; row < S; row += NGW) { const v4f* xr = (const v4f*)(x + (size_t)row * DM) + lane; v4f* hr = (v4f*)(H + (size_t)row * DM) + lane; v2u* o8 = (v2u*)(HB + (size_t)row * DM) + lane; float ss = 0.f;
#pragma unroll
            for (int j = 0; j < 4; ++j) { const v4f v = xr[64 * j]; hr[64 * j] = v; ss += v.x * v.x + v.y * v.y + v.z * v.z + v.w * v.w; v2u w; w.x = pk2(v.x, v.y); w.y = pk2(v.z, v.w); o8[64 * j] = w; }
            ss = wave_sum(ss); if (lane == 0) RSA[row] = ss; }
        SEAM(0);
    }

    layer_body<0>(lds); layer_body<1>(lds); layer_body<2>(lds); layer_body<3>(lds);
}

constexpr int N_PHASES = 1 + 12 * DEPTH;
#ifndef MK_PER_PHASE
#define MK_PER_PHASE 0
#endif
extern "C" void kernel_launch(void* const* d_in, const int* in_sizes, int n_in, void* d_out, int out_size, void* d_ws, size_t ws_size, hipStream_t stream) {
    static int grid = 0;
    if (grid == 0) {
        if (n_in != 28 || out_size != S * DM || ws_size < WS_END) { fprintf(stderr, "kernel_launch: unexpected shapes (n_in %d out %d ws %zu, need %zu)\n", n_in, out_size, ws_size, (size_t)WS_END); grid = -1; return; }
        int dev = 0, cus = 0;
        if (hipGetDevice(&dev) != hipSuccess || hipDeviceGetAttribute(&cus, hipDeviceAttributeMultiprocessorCount, dev) != hipSuccess) { grid = -1; return; }
        if (hipFuncSetAttribute((const void*)fwd, hipFuncAttributeMaxDynamicSharedMemorySize, LDS_BYTES) != hipSuccess) { fprintf(stderr, "kernel_launch: hipFuncSetAttribute failed\n"); grid = -1; return; }
        int per_cu = 0;
        if (hipOccupancyMaxActiveBlocksPerMultiprocessor(&per_cu, (const void*)fwd, NTHREADS, LDS_BYTES) != hipSuccess || per_cu < 1) fprintf(stderr, "kernel_launch: occupancy query reports %d\n", per_cu);
        (void)hipGetLastError();
        grid = cus;
    }
    if (grid < 0) return;
    (void)hipMemsetAsync((char*)d_ws + WS_CTL, 0, CTL_ZERO_BYTES, stream);
    Args a{};
    for (int i = 0; i < 28; ++i) a.in[i] = d_in[i];
    a.out = (float*)d_out; a.ws = (unsigned char*)d_ws;
#if MK_PER_PHASE
    for (int ph = 0; ph < N_PHASES; ++ph) { a.ph_lo = ph; a.ph_hi = ph + 1; hipLaunchKernelGGL(fwd, dim3(grid), dim3(NTHREADS), LDS_BYTES, stream, a); }
#else
    a.ph_lo = 0; a.ph_hi = N_PHASES;
    hipLaunchKernelGGL(fwd, dim3(grid), dim3(NTHREADS), LDS_BYTES, stream, a);
#endif
}
```
